# Optimizing an MI355X kernel written in HIP

```python
import math
import jax, jax.numpy as jnp
from jax import lax
import numpy as np

D_MODEL = 2048
BATCH = 4
SEQ = 4096
DEPTH = 1

GRID_W = 64
CTX_LEN = 256
MIX_WIDTH = D_MODEL
FOURIER_WIDTH = MIX_WIDTH // 2
FOURIER_GROUPS = 8
FOURIER_GROUP_DIM = FOURIER_WIDTH // FOURIER_GROUPS
GDN_WIDTH = MIX_WIDTH - FOURIER_WIDTH
GDN_HEADS = 8
GDN_HEAD_DIM = GDN_WIDTH // GDN_HEADS
CONV_K = 5
CHUNK = 64
N_DIR = 2
IN_COLS = FOURIER_WIDTH + 4 * GDN_WIDTH + 2 * N_DIR * GDN_HEADS
N_EXPERTS = 16
CAPACITY_FACTOR = 2
EXPERT_FF = 3 * D_MODEL // 4
EPS = 1e-6

kernel_name = 'hybrid_fourier_gdn_ecmoe_dit'


def rmsnorm(x, g):
    xf = x.astype(jnp.float32)
    y = xf * lax.rsqrt(jnp.mean(xf * xf, axis=-1, keepdims=True) + EPS)
    return y.astype(x.dtype) * g


def l2norm(t):
    tf = t.astype(jnp.float32)
    return tf * lax.rsqrt(jnp.sum(tf * tf, axis=-1, keepdims=True) + EPS)


def modulate(x, g, shift, scale):
    return rmsnorm(x, g) * (1 + scale) + shift


def short_conv(x, w):
    half = CONV_K // 2
    L = x.shape[2]
    xp = jnp.pad(x, ((0, 0), (0, 0), (half, half), (0, 0)))
    return sum(xp[:, :, j:j + L] * w[j] for j in range(CONV_K))


def fourier_mix(f):
    B, N, _ = f.shape
    fg = f.reshape(B, N, FOURIER_GROUPS, FOURIER_GROUP_DIM).astype(jnp.float32)
    y = jnp.fft.fft2(fg, axes=(1, 3), norm='ortho').real
    return y.reshape(B, N, FOURIER_WIDTH).astype(f.dtype)


def gated_delta_chunked(q, k, v, g, beta, s0):
    B, T, H, K = q.shape
    V = v.shape[-1]
    n = T // CHUNK

    def blocks(t):
        t = t.astype(jnp.float32).reshape((B, n, CHUNK) + t.shape[2:])
        return jnp.moveaxis(t, 2, 3)

    q, k, v, g, beta = (blocks(t) for t in (q, k, v, g, beta))
    gc = jnp.cumsum(g, axis=-1)
    lower = jnp.tril(jnp.ones((CHUNK, CHUNK), bool))
    strict = jnp.tril(jnp.ones((CHUNK, CHUNK), bool), -1)
    diff = gc[..., :, None] - gc[..., None, :]
    decay = jnp.where(lower, jnp.exp(jnp.where(lower, diff, 0.0)), 0.0)
    kb = k * beta[..., None]
    m = jnp.where(strict, jnp.einsum('bnhik,bnhjk->bnhij', kb, k) * decay, 0.0)
    eye = jnp.eye(CHUNK, dtype=jnp.float32)
    t_inv = lax.linalg.triangular_solve(m + eye, jnp.broadcast_to(eye, m.shape),
                                        left_side=True, lower=True, unit_diagonal=True)
    u = jnp.einsum('bnhij,bnhjv->bnhiv', t_inv, v * beta[..., None])
    w = jnp.einsum('bnhij,bnhjk->bnhik', t_inv, kb * jnp.exp(gc)[..., None])
    qk = jnp.einsum('bnhik,bnhjk->bnhij', q, k) * decay
    q_dec = q * jnp.exp(gc)[..., None]
    k_dec = k * jnp.exp(gc[..., -1:] - gc)[..., None]
    g_tot = jnp.exp(gc[..., -1])

    def step(s, xs):
        u_c, w_c, qk_c, qd_c, kd_c, gt_c = xs
        v_new = u_c - jnp.einsum('bhck,bhkv->bhcv', w_c, s)
        o_c = jnp.einsum('bhck,bhkv->bhcv', qd_c, s) + jnp.einsum('bhij,bhjv->bhiv', qk_c, v_new)
        s = s * gt_c[..., None, None] + jnp.einsum('bhck,bhcv->bhkv', kd_c, v_new)
        return s, o_c

    xs = tuple(jnp.moveaxis(t, 1, 0) for t in (u, w, qk, q_dec, k_dec, g_tot))
    s_final, o = lax.scan(step, s0.astype(jnp.float32), xs)
    o = jnp.transpose(o, (1, 0, 3, 2, 4)).reshape(B, T, H, V)
    return o, s_final


def bidirectional_gated_delta(q, k, v, a, b, a_log, dt_bias, s0_fwd, s0_bwd):
    g = -jnp.exp(a_log.astype(jnp.float32)) * jax.nn.softplus(a.astype(jnp.float32) + dt_bias.astype(jnp.float32))
    beta = jax.nn.sigmoid(b.astype(jnp.float32))
    o_f, s_f = gated_delta_chunked(q, k, v, g[:, :, 0], beta[:, :, 0], s0_fwd)
    rev = lambda t: jnp.flip(t, axis=1)
    o_b, s_b = gated_delta_chunked(rev(q), rev(k), rev(v), rev(g[:, :, 1]), rev(beta[:, :, 1]), s0_bwd)
    return o_f + rev(o_b), s_f, s_b


def token_mixer(h, w_in, conv_w, a_log, dt_bias, gdn_norm_w, w_out, s0_fwd, s0_bwd, n_rows, with_output):
    B, N, _ = h.shape
    p = h @ w_in
    cuts = [FOURIER_WIDTH, FOURIER_WIDTH + 3 * GDN_WIDTH, FOURIER_WIDTH + 4 * GDN_WIDTH,
            FOURIER_WIDTH + 4 * GDN_WIDTH + N_DIR * GDN_HEADS]
    f_in, qkv, z, a, b = jnp.split(p, cuts, axis=-1)
    qkv = jax.nn.silu(short_conv(qkv.reshape(B, n_rows, N // n_rows, 3 * GDN_WIDTH), conv_w))
    qkv = qkv.reshape(B, N, 3, GDN_HEADS, GDN_HEAD_DIM)
    q = l2norm(qkv[:, :, 0]) * GDN_HEAD_DIM ** -0.5
    k = l2norm(qkv[:, :, 1])
    v = qkv[:, :, 2]
    o, s_f, s_b = bidirectional_gated_delta(q, k, v, a.reshape(B, N, N_DIR, GDN_HEADS),
                                            b.reshape(B, N, N_DIR, GDN_HEADS), a_log, dt_bias, s0_fwd, s0_bwd)
    if not with_output:
        return None, s_f, s_b
    zg = jax.nn.silu(z.astype(jnp.float32).reshape(B, N, GDN_HEADS, GDN_HEAD_DIM))
    o = (rmsnorm(o, gdn_norm_w.astype(jnp.float32)) * zg).astype(h.dtype)
    out = jnp.concatenate([fourier_mix(f_in), o.reshape(B, N, GDN_WIDTH)], axis=-1) @ w_out
    return out, s_f, s_b


def expert_choice_ffn(h, w_router, w_gate, w_up, w_down):
    B, N, D = h.shape
    cap = CAPACITY_FACTOR * N // N_EXPERTS
    aff = jax.nn.softmax((h @ w_router).astype(jnp.float32), axis=-1)
    vals, idx = lax.top_k(jnp.swapaxes(aff, 1, 2), cap)
    xg = jax.vmap(lambda hb, ib: hb[ib])(h, idx)
    hid = jax.nn.silu(jnp.einsum('becd,edf->becf', xg, w_gate)) * jnp.einsum('becd,edf->becf', xg, w_up)
    y = jnp.einsum('becf,efd->becd', hid, w_down) * vals[..., None].astype(h.dtype)
    return jax.vmap(lambda yb, ib: jnp.zeros((N, D), yb.dtype).at[ib.reshape(-1)].add(yb.reshape(-1, D)))(y, idx)


def setup_inputs(seed: int = 0) -> dict:
    key = jax.random.key(seed)
    ks = jax.random.split(key, 20)
    f32 = jnp.float32
    D = D_MODEL

    def nrm(k, shape, scale):
        return jax.random.normal(k, shape, f32) * scale

    dt = jnp.exp(jax.random.uniform(ks[10], (DEPTH, N_DIR, GDN_HEADS), f32, math.log(1e-3), math.log(1e-1)))
    return {
        'x': nrm(ks[0], (BATCH, SEQ, D), 1.0),
        'c': nrm(ks[1], (BATCH, D), 1.0),
        'ctx': nrm(ks[2], (BATCH, CTX_LEN, D), 1.0),
        'c_ctx': nrm(ks[3], (D,), 1.0),
        'w_mod': nrm(ks[4], (DEPTH, D, 6 * D), D ** -0.5),
        'b_mod': nrm(ks[5], (DEPTH, 6 * D), 0.01),
        'norm1_g': 1.0 + nrm(ks[6], (DEPTH, D), 0.02),
        'norm2_g': 1.0 + nrm(ks[7], (DEPTH, D), 0.02),
        'w_in': nrm(ks[8], (DEPTH, D, IN_COLS), D ** -0.5),
        'conv_w': nrm(ks[9], (DEPTH, CONV_K, 3 * GDN_WIDTH), CONV_K ** -0.5),
        'a_log': jnp.log(jax.random.uniform(ks[11], (DEPTH, N_DIR, GDN_HEADS), f32, 1.0, 16.0)),
        'dt_bias': dt + jnp.log(-jnp.expm1(-dt)),
        'gdn_norm_w': 1.0 + nrm(ks[12], (DEPTH, GDN_HEAD_DIM), 0.02),
        'w_out': nrm(ks[13], (DEPTH, MIX_WIDTH, D), MIX_WIDTH ** -0.5),
        'w_router': nrm(ks[14], (DEPTH, D, N_EXPERTS), D ** -0.5),
        'w_gate': nrm(ks[15], (DEPTH, N_EXPERTS, D, EXPERT_FF), D ** -0.5),
        'w_up': nrm(ks[16], (DEPTH, N_EXPERTS, D, EXPERT_FF), D ** -0.5),
        'w_down': nrm(ks[17], (DEPTH, N_EXPERTS, EXPERT_FF, D), EXPERT_FF ** -0.5),
        'norm_f': 1.0 + nrm(ks[18], (D,), 0.02),
    }


def reference(x, c, ctx, c_ctx, w_mod, b_mod, norm1_g, norm2_g, w_in, conv_w, a_log, dt_bias,
              gdn_norm_w, w_out, w_router, w_gate, w_up, w_down, norm_f):
    B, N, _ = x.shape
    rows = N // GRID_W
    zero_state = jnp.zeros((B, GDN_HEADS, GDN_HEAD_DIM, GDN_HEAD_DIM), jnp.float32)
    for i in range(DEPTH):
        last = i == DEPTH - 1
        sh1_x, sc1_x, gt1_x, sh2_x, sc2_x, gt2_x = jnp.split(
            (jax.nn.silu(c) @ w_mod[i] + b_mod[i])[:, None, :], 6, axis=-1)
        sh1_c, sc1_c, gt1_c, sh2_c, sc2_c, gt2_c = jnp.split(
            jax.nn.silu(c_ctx) @ w_mod[i] + b_mod[i], 6, axis=-1)
        mix_w = (w_in[i], conv_w[i], a_log[i], dt_bias[i], gdn_norm_w[i], w_out[i])
        hc = modulate(ctx, norm1_g[i], sh1_c, sc1_c)
        ctx_mix, s_f, s_b = token_mixer(hc, *mix_w, zero_state, zero_state, 1, not last)
        hx = modulate(x, norm1_g[i], sh1_x, sc1_x)
        x_mix, _, _ = token_mixer(hx, *mix_w, s_f, s_b, rows, True)
        x = x + gt1_x * x_mix
        hx = modulate(x, norm2_g[i], sh2_x, sc2_x)
        x = x + gt2_x * expert_choice_ffn(hx, w_router[i], w_gate[i], w_up[i], w_down[i])
        if not last:
            ctx = ctx + gt1_c * ctx_mix
            hc = modulate(ctx, norm2_g[i], sh2_c, sc2_c)
            ctx = ctx + gt2_c * expert_choice_ffn(hc, w_router[i], w_gate[i], w_up[i], w_down[i])
    return rmsnorm(x, norm_f)
```

```cpp
#include <hip/hip_runtime.h>
#include <cstdio>
#include <cstdint>

#define GAS __attribute__((address_space(1)))
#define LAS __attribute__((address_space(3)))
typedef unsigned short bf16_t;
typedef short bf16x8 __attribute__((ext_vector_type(8)));
typedef short s16x4 __attribute__((ext_vector_type(4)));
typedef float f32x2 __attribute__((ext_vector_type(2)));
typedef float f32x4 __attribute__((ext_vector_type(4)));
typedef float f32x16 __attribute__((ext_vector_type(16)));
typedef unsigned u32x2 __attribute__((ext_vector_type(2)));
typedef unsigned u32x4 __attribute__((ext_vector_type(4)));
typedef __bf16 bf16x2_t __attribute__((ext_vector_type(2)));

constexpr int NWAVES = 8, NTHREADS = 512;
constexpr int D_MODEL = 2048, BATCH = 4, SEQ = 4096, MTOK = BATCH * SEQ, CTX = 256, MCTX = BATCH * CTX, MALL = MTOK + MCTX;
constexpr int FW = 1024, GDW = 1024, NH = 8, HD = 128, INC = 5152, INC_PAD = 5376;
constexpr int NE = 16, CAP = 512, FF = 1536;
constexpr float EPS = 1e-6f;

constexpr size_t MiB = 1u << 20;
constexpr size_t WS_CTL = 0, CTL_ZERO_BYTES = 1 * MiB;
constexpr size_t WS_MOD = 1 * MiB;
constexpr size_t WS_TW = WS_MOD + 256 * 1024;
constexpr size_t WS_DA = WS_TW + 32 * 1024;
constexpr size_t WS_DB = WS_DA + 16 * 1024;
constexpr size_t WS_DC = WS_DB + 32 * 1024;
constexpr size_t WS_WIN = 2 * MiB;
constexpr size_t WS_WOUT = WS_WIN + (size_t)INC_PAD * D_MODEL * 2;
constexpr size_t WS_WGU = WS_WOUT + (size_t)D_MODEL * D_MODEL * 2;
constexpr size_t WS_WDN = WS_WGU + (size_t)NE * 2 * FF * D_MODEL * 2;
constexpr size_t WS_PF = WS_WDN + (size_t)NE * D_MODEL * FF * 2;
constexpr size_t WS_PQKV = WS_PF + (size_t)MTOK * FW * 2;
constexpr size_t WS_PZ = WS_PQKV + (size_t)MALL * 3 * GDW * 2;
constexpr size_t WS_PAB = WS_PZ + (size_t)MTOK * GDW * 2;
constexpr size_t WS_G = WS_PAB + (size_t)MALL * 32 * 4;
constexpr size_t WS_HX2 = WS_G;
constexpr size_t WS_HID = WS_HX2 + (size_t)MTOK * D_MODEL * 2;
constexpr size_t WS_YB = WS_HID + (size_t)BATCH * NE * CAP * FF * 2;
constexpr size_t WS_AFF = WS_YB + (size_t)BATCH * NE * CAP * D_MODEL * 2;
constexpr size_t WS_IDX = WS_AFF + (size_t)BATCH * NE * SEQ * 4;
constexpr size_t WS_VAL = WS_IDX + (size_t)BATCH * NE * CAP * 4;
constexpr size_t WS_SLOT = WS_VAL + (size_t)BATCH * NE * CAP * 4;
constexpr size_t WS_A2 = WS_PF;
constexpr size_t WS_END = 800 * MiB;
static_assert(WS_SLOT + (size_t)MTOK * NE * 4 <= WS_END, "ws map");


constexpr int RING_BYTES = 131072;
constexpr int TAB_OFF = RING_BYTES;
constexpr int MISC_OFF = TAB_OFF + 16384;
constexpr int LDS_BYTES = MISC_OFF + 256;

constexpr int CW_BAR = 4096;

__device__ __forceinline__ unsigned f2bf(float f) { unsigned u = __builtin_bit_cast(unsigned, f); return (u + 0x7fffu + ((u >> 16) & 1u)) >> 16; }
__device__ __forceinline__ float bf2f(unsigned h) { return __builtin_bit_cast(float, h << 16); }
__device__ __forceinline__ unsigned pk2(float lo, float hi) { f32x2 v = {lo, hi}; bf16x2_t b = __builtin_convertvector(v, bf16x2_t); return __builtin_bit_cast(unsigned, b); }
__device__ __forceinline__ float wave_sum(float v) {
#pragma unroll
    for (int o = 1; o < 64; o <<= 1) v += __shfl_xor(v, o);
    return v;
}
__device__ __forceinline__ float silu_f(float v) { return v / (1.f + __expf(-v)); }
#define LDS_WAIT() asm volatile("s_waitcnt lgkmcnt(0)" ::: "memory")

#define XB_TMO      128
#define XB_XCNT(j)  (256  + 64 * (j))
#define XB_XSUB(j)  (1280 + 64 * (j))
#define XB_XGEN(j)  (2304 + 64 * (j))
#define XB_TOP      3328
#define XB_TOPGEN   3392
#define XCD_BAR_WORDS 3456
#define XB_SPIN_CAP (1u << 18)
__device__ __forceinline__ unsigned xb_ld(unsigned* p)              { return __hip_atomic_load(p, __ATOMIC_RELAXED, __HIP_MEMORY_SCOPE_AGENT); }
__device__ __forceinline__ unsigned xb_add(unsigned* p, unsigned v) { return __hip_atomic_fetch_add(p, v, __ATOMIC_RELAXED, __HIP_MEMORY_SCOPE_AGENT); }
__device__ __forceinline__ unsigned xb_xcc_id() { return (unsigned)__builtin_amdgcn_s_getreg((3 << 11) | 20) & 0xFu; }
#define XB_SPIN(cond, bar) do { unsigned _sp = 0; while (cond) { __builtin_amdgcn_s_sleep(1); \
    if ((++_sp & 255u) == 0u) { if (xb_ld(&(bar)[XB_TMO])) break; if (_sp > XB_SPIN_CAP) { atomicAdd(&(bar)[XB_TMO], 1u); break; } } } } while (0)
struct XcdBarrier { unsigned* bar; unsigned x; volatile LAS unsigned* st; };
__device__ __forceinline__ XcdBarrier xcd_barrier_post(unsigned* bar, volatile LAS unsigned* st) {
    XcdBarrier b; b.bar = bar; b.x = xb_xcc_id(); b.st = st;
    if (threadIdx.x == 0) (void)xb_add(&bar[XB_XCNT(b.x)], 1u);
    return b;
}
__device__ __forceinline__ void xcd_barrier_complete(unsigned* bar, unsigned x, unsigned& nloc, unsigned& nx) {
    const unsigned G = gridDim.x * gridDim.y * gridDim.z;
    unsigned sum, cnt, mine, sp = 0u;
    for (;;) {
        sum = 0u; cnt = 0u; mine = 0u;
#pragma unroll
        for (unsigned j = 0; j < 16; ++j) { const unsigned c = xb_ld(&bar[XB_XCNT(j)]); sum += c; cnt += (c > 0u) ? 1u : 0u; mine = (j == x) ? c : mine; }
        if (sum == G) break;
        __builtin_amdgcn_s_sleep(1);
        if ((++sp & 255u) == 0u) { if (xb_ld(&bar[XB_TMO])) break; if (sp > XB_SPIN_CAP) { atomicAdd(&bar[XB_TMO], 1u); break; } }
    }
    nloc = mine > 0u ? mine : 1u; nx = cnt > 0u ? cnt : 1u;
}
__device__ __forceinline__ void xcd_barrier(const XcdBarrier& b) {
    asm volatile("s_waitcnt vmcnt(0)" ::: "memory");
    __syncthreads();
    if (threadIdx.x == 0) {
        unsigned* bar = b.bar;
        __builtin_amdgcn_s_waitcnt(0);
        unsigned nloc = b.st[0], nx = b.st[1];
        if (nloc == 0u) { xcd_barrier_complete(bar, b.x, nloc, nx); b.st[0] = nloc; b.st[1] = nx; }
        const unsigned old = xb_add(&bar[XB_XSUB(b.x)], 1u);
        const unsigned gen = old / nloc;
        if (old + 1u == (gen + 1u) * nloc) {
            __builtin_amdgcn_fence(__ATOMIC_RELEASE, "agent");
            asm volatile("s_waitcnt vmcnt(0)" ::: "memory");
            const unsigned og = xb_add(&bar[XB_TOP], 1u);
            const unsigned tg = og / nx;
            if (og + 1u == (tg + 1u) * nx) xb_add(&bar[XB_TOPGEN], 1u);
            else XB_SPIN(xb_ld(&bar[XB_TOPGEN]) == tg, bar);
            __builtin_amdgcn_fence(__ATOMIC_ACQUIRE, "agent");
            xb_add(&bar[XB_XGEN(b.x)], 1u);
            asm volatile("s_waitcnt vmcnt(0)" ::: "memory");
        } else {
            XB_SPIN(xb_ld(&bar[XB_XGEN(b.x)]) == gen, bar);
            __builtin_amdgcn_fence(__ATOMIC_ACQUIRE, "agent");
            asm volatile("s_waitcnt vmcnt(0)" ::: "memory");
        }
    }
    __syncthreads();
}

namespace pg8 {
constexpr int BM = 256, BK = 64, HALF = 128, HTB = HALF * BK * 2, STAGE_BYTES = 8 * HTB, NXCD = 8, WGM = 8;
__host__ __device__ __forceinline__ int lds_byte(int r, int c) { const int st = (r >> 4) * 2 + (c >> 5), rr = r & 15, cc = c & 31, ob = rr * 64 + cc * 2; return st * 1024 + (ob ^ (((ob >> 9) & 1) << 5)); }
__host__ __device__ __forceinline__ void stage_rc(int b, int& R, int& C) { const int st = b / 1024, sb = b % 1024, swz = sb ^ (((sb >> 9) & 1) << 5); R = (st >> 1) * 16 + swz / 64; C = (st & 1) * 32 + (swz % 64) / 2; }
__host__ __device__ __forceinline__ int perm32(int rho) { const int n = rho >> 4, i = rho & 15; return 8 * (i >> 2) + 4 * n + (i & 3); }

struct Unit { const char* a; const char* b; const int* gidx; int pm, pn, aux; };

template <class Epi, class Sched, bool GATHER>
__device__ __forceinline__ void gemm_phase(LAS unsigned char* lds, LAS unsigned* tab, const int K, const Sched& S, const Epi& E) {
    const int tid = threadIdx.x, wid = __builtin_amdgcn_readfirstlane(tid >> 6), lane = tid & 63, wr = wid >> 2, wc = wid & 3, fr = lane & 15, fq = lane >> 4;
    const int nt = K / BK;
    unsigned voffA[2], voffB[2];
#pragma unroll
    for (int i = 0; i < 2; ++i) { int R, C; stage_rc(tid * 16 + i * 8192, R, C); const int Rb = Epi::PERM ? ((R & ~31) + perm32(R & 31)) : R;
        voffA[i] = (unsigned)(R * K + C) * 2u; voffB[i] = (unsigned)(Rb * K + C) * 2u; }
    const size_t kstep = (size_t)(BK * 2);
    const size_t hstep = (size_t)HALF * K * 2;
    const unsigned ldsw = (unsigned)wid * 1024u;
    const int aoff = lds_byte(wr * 64 + fr, fq * 8), boff = lds_byte(wc * 32 + fr, fq * 8);
#define PG8_SA(b, h) (((b) * 2 + (h)) * HTB)
#define PG8_SB(b, h) ((4 + (b) * 2 + (h)) * HTB)
#define PG8_STAGE(bufoff, gbase, voff) do { _Pragma("unroll") for (int _i = 0; _i < 2; ++_i) \
        __builtin_amdgcn_global_load_lds((const unsigned*)((const char*)(gbase) + (voff)[_i]), (LAS unsigned*)(lds + (bufoff) + ldsw + _i * 8192), 16, 0, 0); } while (0)
#define PG8_STAGE_A(bufoff, gbase, par, h) do { if constexpr (GATHER) { _Pragma("unroll") for (int _i = 0; _i < 2; ++_i) { const unsigned _o = tab[(((par) * 2 + (h)) * 2 + _i) * 512 + tid]; \
            __builtin_amdgcn_global_load_lds((const unsigned*)((const char*)(gbase) + _o), (LAS unsigned*)(lds + (bufoff) + ldsw + _i * 8192), 16, 0, 0); } } \
        else { PG8_STAGE(bufoff, (gbase) + (h) * hstep, voffA); } } while (0)
#define PG8_LDA(dst, b, h) do { _Pragma("unroll") for (int m = 0; m < 4; ++m) _Pragma("unroll") for (int k = 0; k < 2; ++k) dst[m][k] = *(const LAS bf16x8*)(lds + PG8_SA(b, h) + aoff + m * 2048 + k * 1024); } while (0)
#define PG8_LDB(dst, b, h) do { _Pragma("unroll") for (int n = 0; n < 2; ++n) _Pragma("unroll") for (int k = 0; k < 2; ++k) dst[n][k] = *(const LAS bf16x8*)(lds + PG8_SB(b, h) + boff + n * 2048 + k * 1024); } while (0)
#define PG8_MMA(ai, bj, At, Bt) do { __builtin_amdgcn_s_setprio(1); _Pragma("unroll") for (int m = 0; m < 4; ++m) _Pragma("unroll") for (int n = 0; n < 2; ++n) _Pragma("unroll") for (int k = 0; k < 2; ++k) \
        acc[ai][bj][m][n] = __builtin_amdgcn_mfma_f32_16x16x32_bf16(Bt[n][k], At[m][k], acc[ai][bj][m][n], 0, 0, 0); __builtin_amdgcn_s_setprio(0); } while (0)
#define PG8_WAIT_V(n) asm volatile("s_waitcnt vmcnt(" #n ")" ::: "memory")
#define PG8_WAIT_L(n) asm volatile("s_waitcnt lgkmcnt(" #n ")" ::: "memory")
#define PG8_BAR __builtin_amdgcn_s_barrier()
#define PG8_SCHED __builtin_amdgcn_sched_barrier(0)
#define PG8_FILL(par, u) do { if constexpr (GATHER) { _Pragma("unroll") for (int _h = 0; _h < 2; ++_h) _Pragma("unroll") for (int _i = 0; _i < 2; ++_i) { int R_, C_; stage_rc(tid * 16 + _i * 8192, R_, C_); \
        const int row_ = (u).gidx[_h * HALF + R_]; tab[(((par) * 2 + _h) * 2 + _i) * 512 + tid] = (unsigned)(row_ * K + C_) * 2u; } } } while (0)
    Unit cur, nxt; int ui = 0; int par = 0;
    if (!S.next(0, cur)) return;
    f32x4 acc[2][2][4][2];
#pragma unroll
    for (int a = 0; a < 2; ++a)
#pragma unroll
        for (int b = 0; b < 2; ++b)
#pragma unroll
            for (int m = 0; m < 4; ++m)
#pragma unroll
                for (int n = 0; n < 2; ++n) acc[a][b][m][n] = (f32x4){0.f, 0.f, 0.f, 0.f};
    bf16x8 At[4][2], B0[2][2], B1[2][2];
    const char* cA = cur.a; const char* cB = cur.b;
    PG8_FILL(0, cur);
    PG8_STAGE(PG8_SB(0, 0), cB, voffB); PG8_STAGE(PG8_SB(0, 1), cB + hstep, voffB); PG8_STAGE_A(PG8_SA(0, 0), cA, 0, 0); PG8_STAGE_A(PG8_SA(0, 1), cA, 0, 1);
    if (wr == 1) PG8_BAR;
    PG8_WAIT_V(2); PG8_BAR;
    PG8_STAGE(PG8_SB(1, 0), cB + kstep, voffB); PG8_STAGE_A(PG8_SA(1, 0), cA + kstep, 0, 0); PG8_STAGE(PG8_SB(1, 1), cB + hstep + kstep, voffB);
    PG8_WAIT_V(6); PG8_BAR;
    for (;;) {
        const bool has_next = S.next(ui + 1, nxt);
        const char* nA = has_next ? nxt.a : cA; const char* nB = has_next ? nxt.b : cB;
        const int npar = has_next ? (par ^ 1) : par;
        for (int t = 0; t < nt; t += 2) {
            const bool last = (t == nt - 2);
            const char* a1 = cA + (size_t)(t + 1) * kstep;
            const char* a2 = last ? nA : cA + (size_t)(t + 2) * kstep; const char* b2 = last ? nB : cB + (size_t)(t + 2) * kstep;
            const char* a3 = a2 + kstep; const char* b3 = b2 + kstep;
            const int p2 = last ? npar : par;
            if (last && has_next) PG8_FILL(npar, nxt);
            PG8_LDB(B0, 0, 0); PG8_LDB(B1, 0, 1); PG8_SCHED; PG8_LDA(At, 0, 0); PG8_STAGE_A(PG8_SA(1, 1), a1, par, 1);
            PG8_WAIT_V(8); PG8_WAIT_L(0); PG8_BAR; PG8_MMA(0, 0, At, B0); PG8_MMA(0, 1, At, B1); PG8_BAR; PG8_SCHED;
            PG8_LDA(At, 0, 1); PG8_STAGE(PG8_SB(0, 0), b2, voffB); PG8_STAGE(PG8_SB(0, 1), b2 + hstep, voffB); PG8_STAGE_A(PG8_SA(0, 0), a2, p2, 0);
            PG8_WAIT_V(8); PG8_WAIT_L(0); PG8_BAR; PG8_MMA(1, 0, At, B0); PG8_MMA(1, 1, At, B1); PG8_BAR; PG8_SCHED;
            PG8_LDB(B0, 1, 0); PG8_LDB(B1, 1, 1); PG8_SCHED; PG8_LDA(At, 1, 0); PG8_STAGE_A(PG8_SA(0, 1), a2, p2, 1);
            PG8_WAIT_V(8); PG8_WAIT_L(0); PG8_BAR; PG8_MMA(0, 0, At, B0); PG8_MMA(0, 1, At, B1); PG8_BAR; PG8_SCHED;
            PG8_LDA(At, 1, 1); PG8_STAGE(PG8_SB(1, 0), b3, voffB); PG8_STAGE(PG8_SB(1, 1), b3 + hstep, voffB); PG8_STAGE_A(PG8_SA(1, 0), a3, p2, 0);
            PG8_WAIT_V(8); PG8_WAIT_L(0); PG8_BAR; PG8_MMA(1, 0, At, B0); PG8_MMA(1, 1, At, B1); PG8_BAR; PG8_SCHED;
        }
        if (wr == 0) PG8_BAR;
        E(acc, cur, wr, wc, fr, fq);
        if (!has_next) break;
#pragma unroll
        for (int a = 0; a < 2; ++a)
#pragma unroll
            for (int b = 0; b < 2; ++b)
#pragma unroll
                for (int m = 0; m < 4; ++m)
#pragma unroll
                    for (int n = 0; n < 2; ++n) acc[a][b][m][n] = (f32x4){0.f, 0.f, 0.f, 0.f};
        cur = nxt; cA = nA; cB = nB; par = npar; ++ui;
        if (wr == 1) PG8_BAR;
    }
    PG8_WAIT_V(0);
    PG8_BAR;
#undef PG8_SA
#undef PG8_SB
#undef PG8_STAGE
#undef PG8_STAGE_A
#undef PG8_LDA
#undef PG8_LDB
#undef PG8_MMA
#undef PG8_WAIT_V
#undef PG8_WAIT_L
#undef PG8_BAR
#undef PG8_SCHED
#undef PG8_FILL
}
}

__device__ __forceinline__ bf16x8 frag_row(const LAS bf16_t* base, int ld, int r0, int k0, int lane) {
    return *(const LAS bf16x8*)(base + (r0 + (lane & 31)) * ld + k0 + 8 * (lane >> 5));
}
__device__ __forceinline__ bf16x8 frag_tr(const LAS bf16_t* base, int ld, int r0, int k0, int lane) {
    const int h = lane >> 5, blk = (lane >> 4) & 1, q = (lane & 15) >> 2, p = lane & 3;
    const LAS bf16_t* a0 = base + (k0 + 8 * h + q) * ld + r0 + 16 * blk + 4 * p;
    const s16x4 lo = __builtin_bit_cast(s16x4, __builtin_amdgcn_ds_read_tr16_b64_v4i16((LAS s16x4*)a0));
    const s16x4 hi = __builtin_bit_cast(s16x4, __builtin_amdgcn_ds_read_tr16_b64_v4i16((LAS s16x4*)(a0 + 4 * ld)));
    return (bf16x8){lo[0], lo[1], lo[2], lo[3], hi[0], hi[1], hi[2], hi[3]};
}
__device__ __forceinline__ int crow(int r, int lane) { return (r & 3) + 8 * (r >> 2) + 4 * (lane >> 5); }
#define MFMA32(a, b, c) __builtin_amdgcn_mfma_f32_32x32x16_bf16((a), (b), (c), 0, 0, 0)
constexpr f32x16 Z16 = {0.f, 0.f, 0.f, 0.f, 0.f, 0.f, 0.f, 0.f, 0.f, 0.f, 0.f, 0.f, 0.f, 0.f, 0.f, 0.f};


constexpr int REC_W = 0, REC_UT = 16384, REC_QD = 32768, REC_KDT = 49152, REC_QK = 65536, REC_GT = 73728, REC_BYTES = 73984;
constexpr int NREC_X = BATCH * NH * 2 * 64, NREC = NREC_X + BATCH * NH * 2 * 4;
__device__ __forceinline__ size_t rec_index(bool isctx, int b, int h, int d, int c) { return isctx ? (size_t)(NREC_X + ((b * NH + h) * 2 + d) * 4 + c) : (size_t)(((b * NH + h) * 2 + d) * 64 + c); }
__device__ __forceinline__ float softplus_f(float v) { return v > 20.f ? v : log1pf(__expf(v)); }

__device__ __forceinline__ void gdn_chunk_item(LAS unsigned char* L, int item, const bf16_t* PQKV, const float* PAB, const float* convw, const float* a_log, const float* dt_bias, unsigned char* GREC) {
    const int tid = threadIdx.x, lane = tid & 63, wave = __builtin_amdgcn_readfirstlane(tid >> 6);
    constexpr int LD = 136, LDT_ = 72;
    LAS bf16_t* QN = (LAS bf16_t*)L; LAS bf16_t* KN = (LAS bf16_t*)(L + 17408); LAS bf16_t* VI = (LAS bf16_t*)(L + 34816);
    LAS bf16_t* RAW = (LAS bf16_t*)(L + 52224);
    LAS float* KKf = (LAS float*)(L + 52224); LAS float* QKf = (LAS float*)(L + 68864);
    LAS bf16_t* TB = (LAS bf16_t*)(L + 52224); LAS bf16_t* TBG = (LAS bf16_t*)(L + 70656);
    LAS float* MP = (LAS float*)(L + 89088);
    LAS float* GC = (LAS float*)(L + 122880); LAS float* BETA = GC + 128; LAS float* EGC = GC + 256; LAS float* GTOT = GC + 384;
    bool isctx; int b, h, c, rowbase, vlo, vhi;
    if (item < BATCH * NH * 64) { isctx = false; b = item >> 9; h = (item >> 6) & 7; c = item & 63; rowbase = b * SEQ + c * 64; vlo = 0; vhi = 64; }
    else { const int j = item - BATCH * NH * 64; isctx = true; b = j >> 5; h = (j >> 2) & 7; c = j & 3; rowbase = MTOK + b * CTX + c * 64; vlo = -c * 64; vhi = CTX - c * 64; }
    for (int idx = tid; idx < 3 * 68 * 16; idx += NTHREADS) { const int ch = idx & 15, rr = (idx >> 4) % 68, t = (idx >> 4) / 68; const int rel = rr - 2;
        u32x4 v = {0u, 0u, 0u, 0u};
        if (rel >= vlo && rel < vhi) v = *(const GAS u32x4*)(PQKV + (size_t)(rowbase + rel) * (3 * GDW) + t * GDW + h * HD + ch * 8);
        *(LAS u32x4*)(RAW + (t * 68 + rr) * LD + ch * 8) = v; }
    if (wave < 2) { const int d = wave; const int i = d ? 63 - lane : lane; const int m = rowbase + i;
        const float a = PAB[(size_t)m * 32 + d * 8 + h], bb = PAB[(size_t)m * 32 + 16 + d * 8 + h];
        const float g = -__expf(a_log[d * 8 + h]) * softplus_f(a + dt_bias[d * 8 + h]);
        float s = g;
#pragma unroll
        for (int o = 1; o < 64; o <<= 1) { const float t = __shfl_up(s, o); if (lane >= o) s += t; }
        GC[d * 64 + i] = s; EGC[d * 64 + i] = __expf(s); BETA[d * 64 + i] = 1.f / (1.f + __expf(-bb));
        if (lane == 63) GTOT[d] = s; }
    __syncthreads();
    { const int tok = tid >> 3, part = tid & 7;
#pragma unroll
        for (int t = 0; t < 3; ++t) { float y[16]; float ss = 0.f;
#pragma unroll
            for (int e = 0; e < 16; ++e) y[e] = 0.f;
#pragma unroll
            for (int j = 0; j < 5; ++j) { const LAS bf16_t* rp = RAW + (t * 68 + tok + j) * LD + part * 16; const float* wp = convw + j * (3 * GDW) + t * GDW + h * HD + part * 16;
                const u32x4 r0 = *(const LAS u32x4*)rp, r1 = *(const LAS u32x4*)(rp + 8);
                const unsigned rw[8] = {r0.x, r0.y, r0.z, r0.w, r1.x, r1.y, r1.z, r1.w};
#pragma unroll
                for (int e = 0; e < 8; ++e) { y[2 * e] += wp[2 * e] * bf2f(rw[e] & 0xffffu); y[2 * e + 1] += wp[2 * e + 1] * bf2f(rw[e] >> 16); } }
#pragma unroll
            for (int e = 0; e < 16; ++e) { y[e] = silu_f(y[e]); ss += y[e] * y[e]; }
            float sc = 1.f;
            if (t < 2) { ss += __shfl_xor(ss, 1); ss += __shfl_xor(ss, 2); ss += __shfl_xor(ss, 4); sc = 1.f / sqrtf(ss + EPS); if (t == 0) sc *= 0.08838834764831845f; }
            LAS bf16_t* dst = (t == 0 ? QN : (t == 1 ? KN : VI)) + tok * LD + part * 16;
            u32x4 o0, o1; o0.x = pk2(y[0] * sc, y[1] * sc); o0.y = pk2(y[2] * sc, y[3] * sc); o0.z = pk2(y[4] * sc, y[5] * sc); o0.w = pk2(y[6] * sc, y[7] * sc);
            o1.x = pk2(y[8] * sc, y[9] * sc); o1.y = pk2(y[10] * sc, y[11] * sc); o1.z = pk2(y[12] * sc, y[13] * sc); o1.w = pk2(y[14] * sc, y[15] * sc);
            *(LAS u32x4*)dst = o0; *(LAS u32x4*)(dst + 8) = o1; }
    }
    __syncthreads();
    { const int which = wave >> 2, ti = (wave >> 1) & 1, tj = wave & 1; f32x16 acc = Z16;
#pragma unroll
        for (int ks = 0; ks < 8; ++ks) acc = MFMA32(frag_row(which ? QN : KN, LD, 32 * ti, 16 * ks, lane), frag_row(KN, LD, 32 * tj, 16 * ks, lane), acc);
        LAS float* dst = which ? QKf : KKf;
#pragma unroll
        for (int r = 0; r < 16; ++r) dst[(32 * ti + crow(r, lane)) * 65 + 32 * tj + (lane & 31)] = acc[r]; }
    __syncthreads();
    { int tt = tid; asm volatile("" : "+v"(tt)); const int d = tt >> 8, t2 = tt & 255; const LAS float* gc = GC + d * 64; const LAS float* be = BETA + d * 64;
        unsigned char* rec = GREC + rec_index(isctx, b, h, d, c) * REC_BYTES;
#pragma unroll 4
        for (int e = 0; e < 16; ++e) { const int idx = t2 + 256 * e, il = idx >> 6, jl = idx & 63; const int i = d ? 63 - il : il, j = d ? 63 - jl : jl;
            float v = 0.f; if (jl < il) v = be[i] * KKf[i * 65 + j] * __expf(gc[i] - gc[j]);
            MP[((d * 64 + il) * 4 + (jl & 3)) * 16 + (jl >> 2)] = v; }
#pragma unroll
        for (int e = 0; e < 2; ++e) { const int idx = t2 + 256 * e, i = idx >> 3, cj = idx & 7; float o[8];
#pragma unroll
            for (int q = 0; q < 8; ++q) { const int j = 8 * cj + q; const bool ok = d ? (j >= i) : (j <= i); o[q] = ok ? QKf[i * 65 + j] * __expf(gc[i] - gc[j]) : 0.f; }
            u32x4 w; w.x = pk2(o[0], o[1]); w.y = pk2(o[2], o[3]); w.z = pk2(o[4], o[5]); w.w = pk2(o[6], o[7]);
            *(GAS u32x4*)(rec + REC_QK + (i * 64 + 8 * cj) * 2) = w; }
        if (t2 == 0) *(float*)(rec + REC_GT) = __expf(GTOT[d]);
    }
    __syncthreads();
    { const int d = wave >> 2, wq = wave & 3; const int cc = 16 * wq + (lane >> 2), r = lane & 3; float T[16];
#pragma unroll
        for (int q = 0; q < 16; ++q) T[q] = 0.f;
#pragma unroll
        for (int il = 0; il < 64; ++il) { float acc = 0.f; const int nq = (((il + 3) >> 2) + 3) >> 2;
#pragma unroll
            for (int q = 0; q < 4; ++q) if (q < nq) { const f32x4 m4 = *(const LAS f32x4*)(MP + ((d * 64 + il) * 4 + r) * 16 + 4 * q);
                acc += m4.x * T[4 * q] + m4.y * T[4 * q + 1] + m4.z * T[4 * q + 2] + m4.w * T[4 * q + 3]; }
            acc += __shfl_xor(acc, 1); acc += __shfl_xor(acc, 2);
            const float t = (il == cc ? 1.f : 0.f) - acc;
            if (r == (il & 3)) T[il >> 2] = t; }
        __syncthreads();
        const int j = d ? 63 - cc : cc; const float bj = BETA[d * 64 + j], bgj = bj * EGC[d * 64 + j];
#pragma unroll
        for (int q = 0; q < 16; ++q) { const int il = 4 * q + r; const int i = d ? 63 - il : il;
            TB[(d * 64 + i) * LDT_ + j] = (bf16_t)f2bf(T[q] * bj); TBG[(d * 64 + i) * LDT_ + j] = (bf16_t)f2bf(T[q] * bgj); } }
    __syncthreads();
    { const int d = wave >> 2, wq = wave & 3; unsigned char* rec = GREC + rec_index(isctx, b, h, d, c) * REC_BYTES;
        bf16_t* uT = (bf16_t*)(rec + REC_UT); bf16_t* wout = (bf16_t*)(rec + REC_W);
#pragma unroll
        for (int it = 0; it < 2; ++it) { f32x16 au = Z16, aw = Z16;
#pragma unroll
            for (int ks = 0; ks < 4; ++ks) { au = MFMA32(frag_row(TB + d * 64 * LDT_, LDT_, 32 * it, 16 * ks, lane), frag_tr(VI, LD, 32 * wq, 16 * ks, lane), au);
                aw = MFMA32(frag_tr(KN, LD, 32 * wq, 16 * ks, lane), frag_row(TBG + d * 64 * LDT_, LDT_, 32 * it, 16 * ks, lane), aw); }
#pragma unroll
            for (int g4 = 0; g4 < 4; ++g4) { u32x2 pu, pw; pu.x = pk2(au[4 * g4], au[4 * g4 + 1]); pu.y = pk2(au[4 * g4 + 2], au[4 * g4 + 3]); pw.x = pk2(aw[4 * g4], aw[4 * g4 + 1]); pw.y = pk2(aw[4 * g4 + 2], aw[4 * g4 + 3]);
                *(GAS u32x2*)(uT + (32 * wq + (lane & 31)) * 64 + 32 * it + 8 * g4 + 4 * (lane >> 5)) = pu;
                *(GAS u32x2*)(wout + (32 * it + (lane & 31)) * 128 + 32 * wq + 8 * g4 + 4 * (lane >> 5)) = pw; } }
    }
    { int tt = tid; asm volatile("" : "+v"(tt)); const int d = tt >> 8, t2 = tt & 255; unsigned char* rec = GREC + rec_index(isctx, b, h, d, c) * REC_BYTES; const float gtot = GTOT[d];
#pragma unroll
        for (int e = 0; e < 4; ++e) { const int idx = t2 + 256 * e, i = idx >> 4, ch = idx & 15; const float sc = EGC[d * 64 + i];
            const u32x4 v = *(const LAS u32x4*)(QN + i * LD + ch * 8); const unsigned rw[4] = {v.x, v.y, v.z, v.w}; u32x4 o; unsigned ow[4];
#pragma unroll
            for (int q = 0; q < 4; ++q) ow[q] = pk2(bf2f(rw[q] & 0xffffu) * sc, bf2f(rw[q] >> 16) * sc);
            o.x = ow[0]; o.y = ow[1]; o.z = ow[2]; o.w = ow[3];
            *(GAS u32x4*)(rec + REC_QD + (i * 128 + ch * 8) * 2) = o; }
#pragma unroll
        for (int e = 0; e < 4; ++e) { const int idx = t2 + 256 * e, k = idx >> 3, ci = idx & 7; float o[8];
#pragma unroll
            for (int q = 0; q < 8; ++q) { const int i = 8 * ci + q; o[q] = bf2f(KN[i * LD + k]) * __expf(gtot - GC[d * 64 + i]); }
            u32x4 w; w.x = pk2(o[0], o[1]); w.y = pk2(o[2], o[3]); w.z = pk2(o[4], o[5]); w.w = pk2(o[6], o[7]);
            *(GAS u32x4*)(rec + REC_KDT + (k * 64 + 8 * ci) * 2) = w; }
    }
    __syncthreads();
}

__device__ __forceinline__ void gdn_scan_unit(LAS unsigned char* L, int unit, const unsigned char* GREC, bf16_t* OF, bf16_t* OB) {
    const int tid = threadIdx.x, lane = tid & 63, wave = __builtin_amdgcn_readfirstlane(tid >> 6);
    constexpr int LD = 136, LDS_ = 72;
    LAS bf16_t* ST = (LAS bf16_t*)L;
    LAS bf16_t* Wl = (LAS bf16_t*)(L + 34816);
    LAS bf16_t* QDl = (LAS bf16_t*)(L + 52224);
    LAS bf16_t* KDTl = (LAS bf16_t*)(L + 69632);
    LAS bf16_t* QKl = (LAS bf16_t*)(L + 88064);
    LAS bf16_t* VNT = (LAS bf16_t*)(L + 97280);
    const int b = unit >> 4, h = (unit >> 1) & 7, d = unit & 1;
    bf16_t* O = d ? OB : OF;
    for (int i = tid; i < 128 * LD / 8; i += NTHREADS) *(LAS u32x4*)(ST + i * 8) = (u32x4){0u, 0u, 0u, 0u};
    f32x16 S0 = Z16, S1 = Z16;
    const int kt = wave >> 1, vt0 = 2 * (wave & 1);
    u32x4 rg[7];
    auto rec_of = [&](int s) -> const unsigned char* { const bool isctx = s < 4; const int cs = isctx ? s : s - 4; const int c = isctx ? (d ? 3 - cs : cs) : (d ? 63 - cs : cs);
        return GREC + rec_index(isctx, b, h, d, c) * REC_BYTES; };
    auto load_ops = [&](const unsigned char* rec, bool withq) {
#pragma unroll
        for (int e = 0; e < 2; ++e) { const int idx = tid + 512 * e; rg[e] = *(const GAS u32x4*)(rec + REC_W + idx * 16); rg[4 + e] = *(const GAS u32x4*)(rec + REC_KDT + idx * 16); }
        if (withq) {
#pragma unroll
            for (int e = 0; e < 2; ++e) { const int idx = tid + 512 * e; rg[2 + e] = *(const GAS u32x4*)(rec + REC_QD + idx * 16); }
            rg[6] = *(const GAS u32x4*)(rec + REC_QK + tid * 16); }
    };
    load_ops(rec_of(0), false);
    for (int s = 0; s < 68; ++s) {
        const bool isctx = s < 4; const unsigned char* rec = rec_of(s);
#pragma unroll
        for (int e = 0; e < 2; ++e) { const int idx = tid + 512 * e; *(LAS u32x4*)(Wl + (idx >> 4) * LD + (idx & 15) * 8) = rg[e]; *(LAS u32x4*)(KDTl + (idx >> 3) * LDS_ + (idx & 7) * 8) = rg[4 + e]; }
        if (!isctx) {
#pragma unroll
            for (int e = 0; e < 2; ++e) { const int idx = tid + 512 * e; *(LAS u32x4*)(QDl + (idx >> 4) * LD + (idx & 15) * 8) = rg[2 + e]; }
            *(LAS u32x4*)(QKl + (tid >> 3) * LDS_ + (tid & 7) * 8) = rg[6]; }
        const float gt = *(const float*)(rec + REC_GT);
        __syncthreads();
        if (s + 1 < 68) load_ops(rec_of(s + 1), s + 1 >= 4);
        { const int it = wave >> 2, vt = wave & 3; f32x16 acc = Z16;
#pragma unroll
            for (int ks = 0; ks < 8; ++ks) acc = MFMA32(frag_row(Wl, LD, 32 * it, 16 * ks, lane), frag_row(ST, LD, 32 * vt, 16 * ks, lane), acc);
            const bf16_t* uT = (const bf16_t*)(rec + REC_UT) + (32 * vt + (lane & 31)) * 64 + 32 * it + 4 * (lane >> 5);
#pragma unroll
            for (int g4 = 0; g4 < 4; ++g4) { const u32x2 uu = *(const GAS u32x2*)(uT + 8 * g4);
                const float v0 = bf2f(uu.x & 0xffffu) - acc[4 * g4], v1 = bf2f(uu.x >> 16) - acc[4 * g4 + 1], v2 = bf2f(uu.y & 0xffffu) - acc[4 * g4 + 2], v3 = bf2f(uu.y >> 16) - acc[4 * g4 + 3];
                u32x2 p; p.x = pk2(v0, v1); p.y = pk2(v2, v3);
                *(LAS u32x2*)(VNT + (32 * vt + (lane & 31)) * LDS_ + 32 * it + 8 * g4 + 4 * (lane >> 5)) = p; } }
        __syncthreads();
        if (!isctx) { const int it = wave >> 2, vt = wave & 3; f32x16 acc = Z16;
#pragma unroll
            for (int ks = 0; ks < 8; ++ks) acc = MFMA32(frag_row(ST, LD, 32 * vt, 16 * ks, lane), frag_row(QDl, LD, 32 * it, 16 * ks, lane), acc);
#pragma unroll
            for (int ks = 0; ks < 4; ++ks) acc = MFMA32(frag_row(VNT, LDS_, 32 * vt, 16 * ks, lane), frag_row(QKl, LDS_, 32 * it, 16 * ks, lane), acc);
            const int cs = s - 4, c = d ? 63 - cs : cs;
            bf16_t* op = O + (size_t)(b * SEQ + c * 64 + 32 * it + (lane & 31)) * GDW + h * HD + 32 * vt + 4 * (lane >> 5);
#pragma unroll
            for (int g4 = 0; g4 < 4; ++g4) { u32x2 p; p.x = pk2(acc[4 * g4], acc[4 * g4 + 1]); p.y = pk2(acc[4 * g4 + 2], acc[4 * g4 + 3]); *(GAS u32x2*)(op + 8 * g4) = p; } }
        { S0 = S0 * gt; S1 = S1 * gt;
#pragma unroll
            for (int ks = 0; ks < 4; ++ks) { const bf16x8 af = frag_row(KDTl, LDS_, 32 * kt, 16 * ks, lane);
                S0 = MFMA32(af, frag_row(VNT, LDS_, 32 * vt0, 16 * ks, lane), S0);
                S1 = MFMA32(af, frag_row(VNT, LDS_, 32 * (vt0 + 1), 16 * ks, lane), S1); } }
        __syncthreads();
#pragma unroll
        for (int g4 = 0; g4 < 4; ++g4) { u32x2 p0, p1; p0.x = pk2(S0[4 * g4], S0[4 * g4 + 1]); p0.y = pk2(S0[4 * g4 + 2], S0[4 * g4 + 3]); p1.x = pk2(S1[4 * g4], S1[4 * g4 + 1]); p1.y = pk2(S1[4 * g4 + 2], S1[4 * g4 + 3]);
            *(LAS u32x2*)(ST + (32 * vt0 + (lane & 31)) * LD + 32 * kt + 8 * g4 + 4 * (lane >> 5)) = p0;
            *(LAS u32x2*)(ST + (32 * (vt0 + 1) + (lane & 31)) * LD + 32 * kt + 8 * g4 + 4 * (lane >> 5)) = p1; }
    }
    __syncthreads();
}

struct Args { const float* in[19]; float* out; unsigned char* ws; int ph_lo, ph_hi; };
enum { I_X = 0, I_C, I_CTX, I_CCTX, I_WMOD, I_BMOD, I_N1G, I_N2G, I_WIN, I_CONVW, I_ALOG, I_DTB, I_GNW, I_WOUT, I_WROUTER, I_WGATE, I_WUP, I_WDOWN, I_NORMF };

struct XposeItem { const float* src; int ldn, ncols, k0, n0; bf16_t* dst; int dstK; int mode; };
__device__ __forceinline__ int xpose_row(const XposeItem& it, int n) { return it.mode == 0 ? n : (256 * (n >> 7) + 128 * (it.mode - 1) + (n & 127)); }
__device__ __forceinline__ void xpose_load(const XposeItem& it, f32x4 (&r)[8], int tid) {
    const int n = it.n0 + 4 * (tid & 63);
#pragma unroll
    for (int j = 0; j < 8; ++j) { const int k = it.k0 + (tid >> 6) + 8 * j;
        if (n + 3 < it.ncols) r[j] = *(const GAS f32x4*)(it.src + (size_t)k * it.ldn + n);
        else { f32x4 v = {0.f, 0.f, 0.f, 0.f}; const float* p = it.src + (size_t)k * it.ldn; if (n < it.ncols) v.x = p[n]; if (n + 1 < it.ncols) v.y = p[n + 1]; if (n + 2 < it.ncols) v.z = p[n + 2]; r[j] = v; } }
}
__device__ __forceinline__ void xpose_store_lds(LAS float* T, const f32x4 (&r)[8], int tid) {
#pragma unroll
    for (int j = 0; j < 8; ++j) *(LAS f32x4*)(T + ((tid >> 6) + 8 * j) * 260 + 4 * (tid & 63)) = r[j];
}
__device__ __forceinline__ void xpose_emit(const XposeItem& it, const LAS float* T, int tid) {
    const int kc = tid & 7;
#pragma unroll
    for (int j = 0; j < 4; ++j) { const int nl = (tid >> 3) + 64 * j, n = it.n0 + nl;
        const LAS float* s = T + (8 * kc) * 260 + nl;
        u32x4 o; o.x = pk2(s[0], s[260]); o.y = pk2(s[2 * 260], s[3 * 260]); o.z = pk2(s[4 * 260], s[5 * 260]); o.w = pk2(s[6 * 260], s[7 * 260]);
        if (n < it.ncols) *(GAS u32x4*)(it.dst + (size_t)xpose_row(it, n) * it.dstK + it.k0 + 8 * kc) = o; }
}

struct SchedIn {
    const char* A; const char* B; int G, c;
    __device__ __forceinline__ bool next(int i, pg8::Unit& u) const {
        const int L = i * G + c; constexpr int NX = 64 * 21, NC = 4 * 13;
        if (L >= NX + NC) return false;
        int pm, pn;
        if (L < NX) { int wgid = L; { const int q = NX / 8, xcd = wgid % 8, off = wgid / 8; wgid = xcd * q + off; }
            const int nig = 8 * 21, gid = wgid / nig, fm = gid * 8; pm = fm + ((wgid % nig) % 8); pn = (wgid % nig) / 8; }
        else { const int r = L - NX; pm = 64 + r / 13; const int j = r % 13; pn = j < 12 ? 4 + j : 20; }
        u.pm = pm; u.pn = pn; u.aux = 0; u.gidx = nullptr;
        u.a = A + (size_t)pm * 256 * D_MODEL * 2; u.b = B + (size_t)pn * 256 * D_MODEL * 2; return true;
    }
};

struct EpiIn {
    static constexpr bool PERM = true;
    bf16_t* pf; bf16_t* pqkv; bf16_t* pz; float* pab;
    __device__ __forceinline__ void operator()(const f32x4 (&acc)[2][2][4][2], const pg8::Unit& u, int wr, int wc, int fr, int fq) const {
        const int row0 = u.pm * 256 + wr * 64 + fr; const int pn = u.pn;
        if (pn == 20) {
            if (wc == 0) {
#pragma unroll
                for (int ai = 0; ai < 2; ++ai)
#pragma unroll
                    for (int m = 0; m < 4; ++m) { float* rp = pab + (size_t)(row0 + ai * 128 + m * 16) * 32 + 8 * fq;
                        *(GAS f32x4*)rp = acc[ai][0][m][0]; *(GAS f32x4*)(rp + 4) = acc[ai][0][m][1]; }
            }
            return;
        }
        bf16_t* base; int ld, c0;
        if (pn < 4) { base = pf; ld = FW; c0 = pn * 256; } else if (pn < 16) { base = pqkv; ld = 3 * GDW; c0 = (pn - 4) * 256; } else { base = pz; ld = GDW; c0 = (pn - 16) * 256; }
        const int col0 = c0 + wc * 32 + 8 * fq;
#pragma unroll
        for (int ai = 0; ai < 2; ++ai)
#pragma unroll
            for (int m = 0; m < 4; ++m) { bf16_t* rowp = base + (size_t)(row0 + ai * 128 + m * 16) * ld + col0;
#pragma unroll
                for (int bj = 0; bj < 2; ++bj) { const f32x4 v0 = acc[ai][bj][m][0], v1 = acc[ai][bj][m][1];
                    u32x4 w; w.x = pk2(v0[0], v0[1]); w.y = pk2(v0[2], v0[3]); w.z = pk2(v1[0], v1[1]); w.w = pk2(v1[2], v1[3]);
                    *(GAS u32x4*)(rowp + bj * 128) = w; } }
    }
};

struct SchedOut {
    const char* A; const char* B; int G, c;
    __device__ __forceinline__ bool next(int i, pg8::Unit& u) const {
        const int Lq = i * G + c; constexpr int NU = 64 * 8;
        if (Lq >= NU) return false;
        int wgid = Lq; { const int q = NU / 8, xcd = wgid % 8, off = wgid / 8; wgid = xcd * q + off; }
        const int nig = 8 * 8, gid = wgid / nig, fm = gid * 8; const int pm = fm + ((wgid % nig) % 8), pn = (wgid % nig) / 8;
        u.pm = pm; u.pn = pn; u.aux = 0; u.gidx = nullptr;
        u.a = A + (size_t)pm * 256 * D_MODEL * 2; u.b = B + (size_t)pn * 256 * D_MODEL * 2; return true;
    }
};

struct EpiOut {
    static constexpr bool PERM = false;
    const float* x; const float* mod; float* x2;
    __device__ __forceinline__ void operator()(const f32x4 (&acc)[2][2][4][2], const pg8::Unit& u, int wr, int wc, int fr, int fq) const {
        const int row0 = u.pm * 256 + wr * 64 + fr, col0 = u.pn * 256 + wc * 32 + 4 * fq;
        const float* gt = mod + (u.pm >> 4) * 12288 + 2 * 2048;
        f32x4 gv[2][2];
#pragma unroll
        for (int bj = 0; bj < 2; ++bj)
#pragma unroll
            for (int n = 0; n < 2; ++n) gv[bj][n] = *(const GAS f32x4*)(gt + col0 + bj * 128 + n * 16);
#pragma unroll
        for (int ai = 0; ai < 2; ++ai)
#pragma unroll
            for (int m = 0; m < 4; ++m) { const size_t off = (size_t)(row0 + ai * 128 + m * 16) * D_MODEL + col0;
#pragma unroll
                for (int bj = 0; bj < 2; ++bj)
#pragma unroll
                    for (int n = 0; n < 2; ++n) { const f32x4 xv = *(const GAS f32x4*)(x + off + bj * 128 + n * 16);
                        *(GAS f32x4*)(x2 + off + bj * 128 + n * 16) = xv + gv[bj][n] * acc[ai][bj][m][n]; } }
    }
};


struct SchedGU {
    const char* HX2; const char* W; const int* IDX; int G, c;
    __device__ __forceinline__ bool next(int i, pg8::Unit& u) const {
        const int L = i * G + c; if (L >= 1536) return false;
        int wt, rt;
        if (G == 256) { const int xcd = c & 7, j = c >> 3; wt = (i * 8 + xcd) * 4 + (j >> 3); rt = j & 7; } else { wt = L >> 3; rt = L & 7; }
        const int e = wt / 12, pn = wt % 12, b = rt >> 1, mt = rt & 1;
        u.pm = (b * NE + e) * 2 + mt; u.pn = pn; u.aux = 0;
        u.a = HX2 + (size_t)b * SEQ * D_MODEL * 2; u.gidx = IDX + (b * NE + e) * CAP + mt * 256;
        u.b = W + ((size_t)e * 2 * FF + (size_t)pn * 256) * D_MODEL * 2; return true;
    }
};
struct EpiGU {
    static constexpr bool PERM = true;
    bf16_t* hid;
    __device__ __forceinline__ void operator()(const f32x4 (&acc)[2][2][4][2], const pg8::Unit& u, int wr, int wc, int fr, int fq) const {
        const int row0 = u.pm * 256 + wr * 64 + fr, col0 = u.pn * 128 + wc * 32 + 8 * fq;
#pragma unroll
        for (int ai = 0; ai < 2; ++ai)
#pragma unroll
            for (int m = 0; m < 4; ++m) { const f32x4 g0 = acc[ai][0][m][0], g1 = acc[ai][0][m][1], u0 = acc[ai][1][m][0], u1 = acc[ai][1][m][1];
                u32x4 w; w.x = pk2(silu_f(g0[0]) * u0[0], silu_f(g0[1]) * u0[1]); w.y = pk2(silu_f(g0[2]) * u0[2], silu_f(g0[3]) * u0[3]);
                w.z = pk2(silu_f(g1[0]) * u1[0], silu_f(g1[1]) * u1[1]); w.w = pk2(silu_f(g1[2]) * u1[2], silu_f(g1[3]) * u1[3]);
                *(GAS u32x4*)(hid + (size_t)(row0 + ai * 128 + m * 16) * FF + col0) = w; }
    }
};
struct SchedDN {
    const char* HID; const char* W; int G, c;
    __device__ __forceinline__ bool next(int i, pg8::Unit& u) const {
        const int L = i * G + c; if (L >= 1024) return false;
        int wt, rt;
        if (G == 256) { const int xcd = c & 7, j = c >> 3; wt = (i * 8 + xcd) * 4 + (j >> 3); rt = j & 7; } else { wt = L >> 3; rt = L & 7; }
        const int e = wt >> 3, pn = wt & 7, b = rt >> 1, mt = rt & 1;
        u.pm = (b * NE + e) * 2 + mt; u.pn = pn; u.aux = 0; u.gidx = nullptr;
        u.a = HID + (size_t)u.pm * 256 * FF * 2; u.b = W + ((size_t)e * D_MODEL + (size_t)pn * 256) * FF * 2; return true;
    }
};
struct EpiDN {
    static constexpr bool PERM = true;
    bf16_t* yb; const float* val;
    __device__ __forceinline__ void operator()(const f32x4 (&acc)[2][2][4][2], const pg8::Unit& u, int wr, int wc, int fr, int fq) const {
        const int row0 = u.pm * 256 + wr * 64 + fr, col0 = u.pn * 256 + wc * 32 + 8 * fq;
#pragma unroll
        for (int ai = 0; ai < 2; ++ai)
#pragma unroll
            for (int m = 0; m < 4; ++m) { const int row = row0 + ai * 128 + m * 16; const float vv = val[row]; bf16_t* rowp = yb + (size_t)row * D_MODEL + col0;
#pragma unroll
                for (int bj = 0; bj < 2; ++bj) { const f32x4 v0 = acc[ai][bj][m][0] * vv, v1 = acc[ai][bj][m][1] * vv;
                    u32x4 w; w.x = pk2(v0[0], v0[1]); w.y = pk2(v0[2], v0[3]); w.z = pk2(v1[0], v1[1]); w.w = pk2(v1[2], v1[3]);
                    *(GAS u32x4*)(rowp + bj * 128) = w; } }
    }
};

__device__ __forceinline__ unsigned block_excl_scan(unsigned v, LAS unsigned* scr, int tid, int lane, int wave, unsigned& total) {
    unsigned s = v;
#pragma unroll
    for (int o = 1; o < 64; o <<= 1) { const unsigned t = __shfl_up(s, o); if (lane >= o) s += t; }
    if (lane == 63) scr[wave] = s;
    __syncthreads();
    unsigned base = 0, tot = 0;
#pragma unroll
    for (int w = 0; w < NWAVES; ++w) { const unsigned x = scr[w]; if (w < wave) base += x; tot += x; }
    __syncthreads();
    total = tot; return base + s - v;
}
__device__ __forceinline__ void topk_unit(LAS unsigned char* L, int unit, const float* AFF, int* IDX, float* VAL, int* SLOT) {
    const int tid = threadIdx.x, lane = tid & 63, wave = __builtin_amdgcn_readfirstlane(tid >> 6);
    LAS unsigned* HIST = (LAS unsigned*)L; LAS unsigned* SH = HIST + 256; LAS unsigned* SCR = SH + 8;
    const int b = unit >> 4, e = unit & 15;
    unsigned key[8];
    { const u32x4 k0 = *(const GAS u32x4*)(AFF + (size_t)unit * SEQ + tid * 8), k1 = *(const GAS u32x4*)(AFF + (size_t)unit * SEQ + tid * 8 + 4);
        key[0] = k0.x; key[1] = k0.y; key[2] = k0.z; key[3] = k0.w; key[4] = k1.x; key[5] = k1.y; key[6] = k1.z; key[7] = k1.w; }
    unsigned prefix = 0, need = CAP;
#pragma unroll 1
    for (int pass = 0; pass < 4; ++pass) { const int shift = 24 - 8 * pass;
        if (tid < 256) HIST[tid] = 0u;
        __syncthreads();
#pragma unroll
        for (int q = 0; q < 8; ++q) if (pass == 0 || (key[q] >> (shift + 8)) == prefix) atomicAdd((unsigned*)&HIST[(key[q] >> shift) & 255u], 1u);
        __syncthreads();
        if (tid == 0) { unsigned cum = 0; int bin = 255; for (; bin > 0; --bin) { const unsigned hh = HIST[bin]; if (cum + hh >= need) break; cum += hh; } SH[0] = (unsigned)bin; SH[1] = need - cum; }
        __syncthreads();
        prefix = (prefix << 8) | SH[0]; need = SH[1];
        __syncthreads();
    }
    const unsigned T = prefix;
    unsigned eq = 0;
#pragma unroll
    for (int q = 0; q < 8; ++q) eq += (key[q] == T) ? 1u : 0u;
    unsigned tot; unsigned eqbase = block_excl_scan(eq, SCR, tid, lane, wave, tot);
    unsigned selmask = 0, cnt = 0;
#pragma unroll
    for (int q = 0; q < 8; ++q) { bool sel = key[q] > T; if (key[q] == T) { sel = eqbase < need; ++eqbase; } if (sel) { selmask |= 1u << q; ++cnt; } }
    unsigned slot = block_excl_scan(cnt, SCR, tid, lane, wave, tot);
#pragma unroll
    for (int q = 0; q < 8; ++q) { const int t = tid * 8 + q; int sl = -1;
        if (selmask & (1u << q)) { sl = (int)slot; ++slot; if (sl < CAP) { IDX[unit * CAP + sl] = t; VAL[unit * CAP + sl] = __uint_as_float(key[q]); } else sl = -1; }
        SLOT[((size_t)b * SEQ + t) * NE + e] = sl; }
    __syncthreads();
}
__global__ void __launch_bounds__(NTHREADS, 2) fwd_kernel(Args args) {
    extern __shared__ __attribute__((aligned(16))) unsigned char lds_raw[];
    LAS unsigned char* L = (LAS unsigned char*)lds_raw;
    volatile LAS unsigned* MISC = (volatile LAS unsigned*)(L + MISC_OFF);
    LAS unsigned* TAB = (LAS unsigned*)(L + TAB_OFF);
    const int tid = threadIdx.x, lane = tid & 63, wave = __builtin_amdgcn_readfirstlane(tid >> 6);
    const int G = gridDim.x, bid = blockIdx.x;
    if (tid < 64) MISC[tid] = 0u;
    __syncthreads();
    unsigned char* ws = args.ws;
    unsigned* ctl = (unsigned*)(ws + WS_CTL);
    XcdBarrier bar = xcd_barrier_post(ctl + CW_BAR, MISC + 8);
    const int gw = bid * NWAVES + wave, NGW = G * NWAVES;
    const int lo = args.ph_lo, hi = args.ph_hi;
#define IN(k) (lo <= (k) && (k) < hi)
#define SEAM(k) do { if (IN(k) && IN((k) + 1)) xcd_barrier(bar); } while (0)

    float* MOD = (float*)(ws + WS_MOD);
    float* TW = (float*)(ws + WS_TW);
    bf16_t* DA = (bf16_t*)(ws + WS_DA); bf16_t* DB = (bf16_t*)(ws + WS_DB); bf16_t* DC = (bf16_t*)(ws + WS_DC);
    bf16_t* WIN = (bf16_t*)(ws + WS_WIN); bf16_t* WOUT = (bf16_t*)(ws + WS_WOUT);
    bf16_t* PF = (bf16_t*)(ws + WS_PF); bf16_t* PQKV = (bf16_t*)(ws + WS_PQKV); bf16_t* PZ = (bf16_t*)(ws + WS_PZ); float* PAB = (float*)(ws + WS_PAB);
    bf16_t* A2 = (bf16_t*)(ws + WS_A2);
    bf16_t* OF = (bf16_t*)(ws + WS_A2 + (size_t)MTOK * D_MODEL * 2); bf16_t* OB = OF + (size_t)MTOK * GDW;
    bf16_t* HX = (bf16_t*)args.out;
    bf16_t* YB = (bf16_t*)args.out;
    float* X2 = args.out;

    if (IN(0)) {
        if (bid < 192) {
            LAS float* SC = (LAS float*)L;
            LAS float* RED = (LAS float*)(L + 5 * 2048 * 4);
            for (int i = tid; i < 5 * 2048; i += NTHREADS) { const int r = i >> 11, k = i & 2047; const float v = r < 4 ? args.in[I_C][r * 2048 + k] : args.in[I_CCTX][k]; SC[i] = silu_f(v); }
            __syncthreads();
            for (int s = bid; s < 192; s += G) {
                const float* wp = args.in[I_WMOD] + (size_t)(wave * 256) * 12288 + s * 64 + lane;
                float a0 = 0.f, a1 = 0.f, a2 = 0.f, a3 = 0.f, a4 = 0.f;
                for (int k = 0; k < 256; k += 8) {
                    float wv[8];
#pragma unroll
                    for (int j = 0; j < 8; ++j) wv[j] = wp[(size_t)(k + j) * 12288];
#pragma unroll
                    for (int j = 0; j < 8; ++j) { const int kk = wave * 256 + k + j;
                        a0 += SC[kk] * wv[j]; a1 += SC[2048 + kk] * wv[j]; a2 += SC[4096 + kk] * wv[j]; a3 += SC[6144 + kk] * wv[j]; a4 += SC[8192 + kk] * wv[j]; }
                }
                RED[(wave * 5 + 0) * 64 + lane] = a0; RED[(wave * 5 + 1) * 64 + lane] = a1; RED[(wave * 5 + 2) * 64 + lane] = a2; RED[(wave * 5 + 3) * 64 + lane] = a3; RED[(wave * 5 + 4) * 64 + lane] = a4;
                __syncthreads();
                if (tid < 320) { const int r = tid >> 6, c = tid & 63; float v = 0.f;
#pragma unroll
                    for (int w = 0; w < 8; ++w) v += RED[(w * 5 + r) * 64 + c];
                    MOD[r * 12288 + s * 64 + c] = v + args.in[I_BMOD][s * 64 + c]; }
                __syncthreads();
            }
        }
        if (bid == G - 1) {
            for (int i = tid; i < 4096; i += NTHREADS) { float s, c; sincosf(6.283185307179586f * (float)i / 4096.f, &s, &c); TW[2 * i] = c; TW[2 * i + 1] = s; }
            for (int i = tid; i < 128 * 64; i += NTHREADS) { const int r = i >> 6, n1 = i & 63, a = r & 63; const int m = (a * n1) & 63; float s, c; sincosf(6.283185307179586f * (float)m / 64.f, &s, &c);
                DA[i] = (bf16_t)f2bf(r < 64 ? c : -s); }
        }
        if (bid == G - 2) {
            for (int i = tid; i < 128 * 128; i += NTHREADS) { const int r = i >> 7, rho = i & 127, k2 = r & 63, n2 = rho >> 1, ri = rho & 1; const int m = (k2 * n2) & 63; float s, c; sincosf(6.283185307179586f * (float)m / 64.f, &s, &c);
                const float v = r < 64 ? (ri == 0 ? c : s) : (ri == 0 ? -s : c); DB[i] = (bf16_t)f2bf(v); }
        }
        if (bid == G - 3) {
            const float scale = 0.0013810679320049757f;
            for (int i = tid; i < 128 * 256; i += NTHREADS) { const int cp = i >> 8, kap = i & 255, ri = kap >> 7, c = kap & 127; const int m = (c * cp) & 127; float s, co; sincosf(6.283185307179586f * (float)m / 128.f, &s, &co);
                DC[i] = (bf16_t)f2bf((ri == 0 ? co : s) * scale); }
        }
        for (size_t i = (size_t)bid * NTHREADS + tid; i < (size_t)(INC_PAD - INC) * D_MODEL / 8; i += (size_t)G * NTHREADS) *(GAS u32x4*)(WIN + (size_t)INC * D_MODEL + i * 8) = (u32x4){0u, 0u, 0u, 0u};
        {
            __syncthreads();
            LAS float* T = (LAS float*)L;
            constexpr int N_IN = 32 * 21, N_OUT = 32 * 8, NIT = N_IN + N_OUT;
            const int vb = (bid + G - 192) % G;
            auto mk = [&](int it) { XposeItem x; if (it < N_IN) { x.src = args.in[I_WIN]; x.ldn = INC; x.ncols = INC; x.k0 = 64 * (it / 21); x.n0 = 256 * (it % 21); x.dst = WIN; x.dstK = D_MODEL; x.mode = 0; }
                else { const int r = it - N_IN; x.src = args.in[I_WOUT]; x.ldn = D_MODEL; x.ncols = D_MODEL; x.k0 = 64 * (r / 8); x.n0 = 256 * (r % 8); x.dst = WOUT; x.dstK = D_MODEL; x.mode = 0; } return x; };
            f32x4 r[8];
            int it = vb;
            if (it < NIT) { XposeItem x = mk(it); xpose_load(x, r, tid); }
            while (it < NIT) {
                XposeItem x = mk(it);
                xpose_store_lds(T, r, tid);
                __syncthreads();
                const int nx = it + G;
                if (nx < NIT) { XposeItem y = mk(nx); xpose_load(y, r, tid); }
                xpose_emit(x, T, tid);
                __syncthreads();
                it = nx;
            }
        }
    }
    SEAM(0);

    if (IN(1)) {
        const float* g1 = args.in[I_N1G];
        for (int m = gw; m < MALL; m += NGW) {
            const float* src = m < MTOK ? args.in[I_X] + (size_t)m * D_MODEL : args.in[I_CTX] + (size_t)(m - MTOK) * D_MODEL;
            const int mr = m < MTOK ? (m >> 12) : 4;
            const float* sh = MOD + mr * 12288; const float* sc = sh + 2048;
            const GAS f32x4* xr = (const GAS f32x4*)src + lane;
            f32x4 v[8]; float s = 0.f;
#pragma unroll
            for (int j = 0; j < 8; ++j) { v[j] = xr[64 * j]; s += (v[j].x * v[j].x + v[j].y * v[j].y) + (v[j].z * v[j].z + v[j].w * v[j].w); }
            const float rstd = 1.f / sqrtf(wave_sum(s) * (1.f / D_MODEL) + EPS);
            GAS u32x2* o = (GAS u32x2*)(HX + (size_t)m * D_MODEL) + lane;
#pragma unroll
            for (int j = 0; j < 8; ++j) { const f32x4 gg = *((const GAS f32x4*)g1 + lane + 64 * j), s1 = *((const GAS f32x4*)sc + lane + 64 * j), h1 = *((const GAS f32x4*)sh + lane + 64 * j);
                const f32x4 y = v[j] * rstd * gg * (s1 + 1.f) + h1; u32x2 w; w.x = pk2(y.x, y.y); w.y = pk2(y.z, y.w); o[64 * j] = w; }
        }
    }
    SEAM(1);

    if (IN(2)) {
        SchedIn S{(const char*)HX, (const char*)WIN, G, bid};
        EpiIn E{PF, PQKV, PZ, PAB};
        pg8::gemm_phase<EpiIn, SchedIn, false>(L, TAB, D_MODEL, S, E);
    }
    SEAM(2);

    if (IN(3)) {
        for (int it = bid; it < BATCH * NH * 64 + BATCH * NH * 4; it += G)
            gdn_chunk_item(L, it, PQKV, PAB, args.in[I_CONVW], args.in[I_ALOG], args.in[I_DTB], ws + WS_G);
        constexpr int LDF = 136, LDA_ = 72, LDO = 136;
        LAS bf16_t* DAl = (LAS bf16_t*)L;
        LAS bf16_t* Fi = (LAS bf16_t*)(L + 128 * LDA_ * 2);
        LAS bf16_t* Oi = (LAS bf16_t*)(L + 128 * LDA_ * 2 + 64 * LDF * 2);
        for (int i = tid; i < 128 * 64; i += NTHREADS) DAl[(i >> 6) * LDA_ + (i & 63)] = DA[i];
        __syncthreads();
        for (int it = bid; it < BATCH * 64 * 8; it += G) {
            const int g = it & 7, n2 = (it >> 3) & 63, b = it >> 9;
#pragma unroll
            for (int j = 0; j < 2; ++j) { const int idx = tid + 512 * j, row = idx >> 4, ch = idx & 15;
                const u32x4 v = *(const GAS u32x4*)(PF + (size_t)(b * SEQ + 64 * row + n2) * FW + g * 128 + ch * 8);
                *(LAS u32x4*)(Fi + row * LDF + ch * 8) = v; }
            __syncthreads();
            const int ct = wave & 3, kt = wave >> 2;
            f32x16 are = Z16, aim = Z16;
#pragma unroll
            for (int ks = 0; ks < 4; ++ks) { const bf16x8 bfr = frag_tr(Fi, LDF, 32 * ct, 16 * ks, lane);
                are = MFMA32(frag_row(DAl, LDA_, 32 * kt, 16 * ks, lane), bfr, are);
                aim = MFMA32(frag_row(DAl, LDA_, 64 + 32 * kt, 16 * ks, lane), bfr, aim); }
#pragma unroll
            for (int r = 0; r < 16; ++r) { const int k1 = 32 * kt + crow(r, lane); const int m = (n2 * k1) & 4095; const float c = TW[2 * m], s = TW[2 * m + 1];
                const float re = are[r] * c + aim[r] * s, im = aim[r] * c - are[r] * s;
                Oi[k1 * LDO + 32 * ct + (lane & 31)] = (bf16_t)f2bf(re); Oi[(64 + k1) * LDO + 32 * ct + (lane & 31)] = (bf16_t)f2bf(im); }
            __syncthreads();
#pragma unroll
            for (int j = 0; j < 4; ++j) { const int idx = tid + 512 * j, row = idx >> 4, ch = idx & 15, ri = row >> 6, k1 = row & 63;
                const u32x4 v = *(const LAS u32x4*)(Oi + row * LDO + ch * 8);
                *(GAS u32x4*)(YB + ((size_t)((b * 64 + k1) * 64 + n2) * 2 + ri) * FW + g * 128 + ch * 8) = v; }
        }
    }
    SEAM(3);

    if (IN(4) && bid < 64) {
        for (int u = bid; u < 64; u += G) gdn_scan_unit(L, u, ws + WS_G, OF, OB);
    }
    if (IN(4) && bid >= 64) {
        const int fb = bid - 64, FG_ = G - 64;
        constexpr int LDB_ = 136, LDT = 136, LDZ = 264, LDO2 = 136;
        LAS bf16_t* DBl = (LAS bf16_t*)L;
        LAS bf16_t* DCl = (LAS bf16_t*)(L + 34816);
        LAS bf16_t* W0 = (LAS bf16_t*)(L + 34816 + 65536);
        for (int i = tid; i < 128 * 128; i += NTHREADS) DBl[(i >> 7) * LDB_ + (i & 127)] = DB[i];
        for (int i = tid; i < 128 * 32; i += NTHREADS) { const int row = i >> 5, ch = i & 31; *(LAS u32x4*)(DCl + row * 256 + ((ch ^ (row & 15)) * 8)) = *(const GAS u32x4*)(DC + row * 256 + ch * 8); }
        __syncthreads();
        for (int it = fb; it < BATCH * 64 * 8; it += FG_) {
            const int g = it & 7, k1 = (it >> 3) & 63, b = it >> 9;
#pragma unroll
            for (int j = 0; j < 4; ++j) { const int idx = tid + 512 * j, row = idx >> 4, ch = idx & 15;
                const u32x4 v = *(const GAS u32x4*)(YB + ((size_t)(b * 64 + k1) * 128 + row) * FW + g * 128 + ch * 8);
                *(LAS u32x4*)(W0 + row * LDT + ch * 8) = v; }
            __syncthreads();
            const int ct = wave & 3, kt = wave >> 2;
            f32x16 zre = Z16, zim = Z16;
#pragma unroll
            for (int ks = 0; ks < 8; ++ks) { const bf16x8 bfr = frag_tr(W0, LDT, 32 * ct, 16 * ks, lane);
                zre = MFMA32(frag_row(DBl, LDB_, 32 * kt, 16 * ks, lane), bfr, zre);
                zim = MFMA32(frag_row(DBl, LDB_, 64 + 32 * kt, 16 * ks, lane), bfr, zim); }
            __syncthreads();
#pragma unroll
            for (int r = 0; r < 16; ++r) { const int k2 = 32 * kt + crow(r, lane); const int c = 32 * ct + (lane & 31);
                W0[k2 * LDZ + c] = (bf16_t)f2bf(zre[r]); W0[k2 * LDZ + 128 + c] = (bf16_t)f2bf(zim[r]); }
            __syncthreads();
            f32x16 yo = Z16;
            { const int mt = wave >> 2, nt2 = wave & 3; const int rowc = 32 * nt2 + (lane & 31);
#pragma unroll
                for (int ks = 0; ks < 16; ++ks) { const int chunk = 2 * ks + (lane >> 5);
                    const bf16x8 bfr = *(const LAS bf16x8*)(DCl + rowc * 256 + ((chunk ^ (rowc & 15)) * 8));
                    yo = MFMA32(frag_row(W0, LDZ, 32 * mt, 16 * ks, lane), bfr, yo); } }
            __syncthreads();
            { const int mt = wave >> 2, nt2 = wave & 3;
#pragma unroll
                for (int r = 0; r < 16; ++r) W0[(32 * mt + crow(r, lane)) * LDO2 + 32 * nt2 + (lane & 31)] = (bf16_t)f2bf(yo[r]); }
            __syncthreads();
#pragma unroll
            for (int j = 0; j < 2; ++j) { const int idx = tid + 512 * j, k2 = idx >> 4, ch = idx & 15;
                *(GAS u32x4*)(A2 + (size_t)(b * SEQ + k1 + 64 * k2) * D_MODEL + g * 128 + ch * 8) = *(const LAS u32x4*)(W0 + k2 * LDO2 + ch * 8); }
            __syncthreads();
        }
    }
    if (IN(4) && bid >= 64) {
        __syncthreads();
        LAS float* T = (LAS float*)L;
        const int fb = bid - 64, FG_ = G - 64;
        constexpr int NIT = 3 * 3072;
        auto mk = [&](int it) { XposeItem x; if (it < 6144) { const int up = it >= 3072, r0 = it - up * 3072, e = r0 / 192, r = r0 % 192; x.src = args.in[up ? I_WUP : I_WGATE] + (size_t)e * D_MODEL * FF; x.ldn = FF; x.ncols = FF; x.k0 = 64 * (r / 6); x.n0 = 256 * (r % 6);
                x.dst = (bf16_t*)(ws + WS_WGU) + (size_t)e * 2 * FF * D_MODEL; x.dstK = D_MODEL; x.mode = 1 + up; }
            else { const int r0 = it - 6144, e = r0 / 192, r = r0 % 192; x.src = args.in[I_WDOWN] + (size_t)e * FF * D_MODEL; x.ldn = D_MODEL; x.ncols = D_MODEL; x.k0 = 64 * (r / 8); x.n0 = 256 * (r % 8);
                x.dst = (bf16_t*)(ws + WS_WDN) + (size_t)e * D_MODEL * FF; x.dstK = FF; x.mode = 0; } return x; };
        f32x4 r[8];
        int it = fb;
        if (it < NIT) { XposeItem x = mk(it); xpose_load(x, r, tid); }
        while (it < NIT) {
            XposeItem x = mk(it);
            xpose_store_lds(T, r, tid);
            __syncthreads();
            const int nx = it + FG_;
            if (nx < NIT) { XposeItem y = mk(nx); xpose_load(y, r, tid); }
            xpose_emit(x, T, tid);
            __syncthreads();
            it = nx;
        }
    }
    SEAM(4);

    if (IN(5)) {
        const float* gnw = args.in[I_GNW];
        for (int m = gw; m < MTOK; m += NGW) {
#pragma unroll
            for (int half = 0; half < 2; ++half) { const int col = half * 512 + lane * 8;
                const u32x4 a = *(const GAS u32x4*)(OF + (size_t)m * GDW + col), bq = *(const GAS u32x4*)(OB + (size_t)m * GDW + col), zz = *(const GAS u32x4*)(PZ + (size_t)m * GDW + col);
                const unsigned aw[4] = {a.x, a.y, a.z, a.w}, bw[4] = {bq.x, bq.y, bq.z, bq.w}, zw[4] = {zz.x, zz.y, zz.z, zz.w};
                float o[8]; float ss = 0.f;
#pragma unroll
                for (int q = 0; q < 4; ++q) { o[2 * q] = bf2f(aw[q] & 0xffffu) + bf2f(bw[q] & 0xffffu); o[2 * q + 1] = bf2f(aw[q] >> 16) + bf2f(bw[q] >> 16); ss += o[2 * q] * o[2 * q] + o[2 * q + 1] * o[2 * q + 1]; }
                ss += __shfl_xor(ss, 1); ss += __shfl_xor(ss, 2); ss += __shfl_xor(ss, 4); ss += __shfl_xor(ss, 8);
                const float rstd = 1.f / sqrtf(ss * (1.f / HD) + EPS);
                const float* gp = gnw + (col & 127);
                float y[8];
#pragma unroll
                for (int q = 0; q < 4; ++q) { const float z0 = bf2f(zw[q] & 0xffffu), z1 = bf2f(zw[q] >> 16); y[2 * q] = o[2 * q] * rstd * gp[2 * q] * silu_f(z0); y[2 * q + 1] = o[2 * q + 1] * rstd * gp[2 * q + 1] * silu_f(z1); }
                u32x4 w; w.x = pk2(y[0], y[1]); w.y = pk2(y[2], y[3]); w.z = pk2(y[4], y[5]); w.w = pk2(y[6], y[7]);
                *(GAS u32x4*)(A2 + (size_t)m * D_MODEL + 1024 + col) = w; }
        }
    }
    SEAM(5);

    if (IN(6)) {
        SchedOut S{(const char*)A2, (const char*)WOUT, G, bid};
        EpiOut E{args.in[I_X], MOD, X2};
        pg8::gemm_phase<EpiOut, SchedOut, false>(L, TAB, D_MODEL, S, E);
    }
    SEAM(6);

    if (IN(7)) {
        LAS float* WR = (LAS float*)L;
        for (int i = tid; i < D_MODEL * NE; i += NTHREADS) WR[(i & 15) * 2048 + (i >> 4)] = args.in[I_WROUTER][i];
        __syncthreads();
        const float* g2 = args.in[I_N2G];
        bf16_t* HX2 = (bf16_t*)(ws + WS_HX2); float* AFF = (float*)(ws + WS_AFF);
        for (int m = gw; m < MTOK; m += NGW) {
            const int b = m >> 12;
            const float* sh = MOD + b * 12288 + 3 * 2048; const float* sc = sh + 2048;
            const GAS f32x4* xr = (const GAS f32x4*)(X2 + (size_t)m * D_MODEL) + lane;
            f32x4 v[8]; float s = 0.f;
#pragma unroll
            for (int j = 0; j < 8; ++j) { v[j] = xr[64 * j]; s += (v[j].x * v[j].x + v[j].y * v[j].y) + (v[j].z * v[j].z + v[j].w * v[j].w); }
            const float rstd = 1.f / sqrtf(wave_sum(s) * (1.f / D_MODEL) + EPS);
            GAS u32x2* o = (GAS u32x2*)(HX2 + (size_t)m * D_MODEL) + lane;
#pragma unroll
            for (int j = 0; j < 8; ++j) { const f32x4 gg = *((const GAS f32x4*)g2 + lane + 64 * j), s1 = *((const GAS f32x4*)sc + lane + 64 * j), h1 = *((const GAS f32x4*)sh + lane + 64 * j);
                v[j] = v[j] * rstd * gg * (s1 + 1.f) + h1; u32x2 w; w.x = pk2(v[j].x, v[j].y); w.y = pk2(v[j].z, v[j].w); o[64 * j] = w; }
            float a[16];
#pragma unroll
            for (int eg = 0; eg < 4; ++eg) {
#pragma unroll
                for (int q = 0; q < 4; ++q) { const int e = 4 * eg + q; float acc = 0.f;
#pragma unroll
                    for (int j = 0; j < 8; ++j) { const f32x4 w4 = *(const LAS f32x4*)(WR + e * 2048 + 4 * (lane + 64 * j)); acc += (v[j].x * w4.x + v[j].y * w4.y) + (v[j].z * w4.z + v[j].w * w4.w); }
                    a[e] = acc; }
                asm volatile("" ::: "memory"); }
#pragma unroll
            for (int st = 0; st < 4; ++st) { const int msk = 1 << st, n2 = 8 >> st; const bool up = (lane & msk) != 0;
#pragma unroll
                for (int q = 0; q < 8; ++q) if (q < n2) { const float keep = up ? a[q + n2] : a[q], send = up ? a[q] : a[q + n2]; a[q] = keep + __shfl_xor(send, msk); } }
            float lgt = a[0]; lgt += __shfl_xor(lgt, 16); lgt += __shfl_xor(lgt, 32);
            float mx = lgt;
#pragma unroll
            for (int o = 1; o < 16; o <<= 1) mx = fmaxf(mx, __shfl_xor(mx, o));
            const float ex = expf(lgt - mx); float den = ex;
#pragma unroll
            for (int o = 1; o < 16; o <<= 1) den += __shfl_xor(den, o);
            const int eidx = ((lane & 1) << 3) | ((lane & 2) << 1) | ((lane & 4) >> 1) | ((lane & 8) >> 3);
            if (lane < 16) AFF[((size_t)b * NE + eidx) * SEQ + (m & 4095)] = ex / den;
        }
    }
    SEAM(7);

    if (IN(8)) {
        for (int u = bid; u < BATCH * NE; u += G) topk_unit(L, u, (const float*)(ws + WS_AFF), (int*)(ws + WS_IDX), (float*)(ws + WS_VAL), (int*)(ws + WS_SLOT));
    }
    SEAM(8);

    if (IN(9)) {
        SchedGU S{(const char*)(ws + WS_HX2), (const char*)(ws + WS_WGU), (const int*)(ws + WS_IDX), G, bid};
        EpiGU E{(bf16_t*)(ws + WS_HID)};
        pg8::gemm_phase<EpiGU, SchedGU, true>(L, TAB, D_MODEL, S, E);
    }
    SEAM(9);

    if (IN(10)) {
        SchedDN S{(const char*)(ws + WS_HID), (const char*)(ws + WS_WDN), G, bid};
        EpiDN E{(bf16_t*)(ws + WS_YB), (const float*)(ws + WS_VAL)};
        pg8::gemm_phase<EpiDN, SchedDN, false>(L, TAB, FF, S, E);
    }
    SEAM(10);

    if (IN(11)) {
        const float* nf = args.in[I_NORMF]; const bf16_t* YB = (const bf16_t*)(ws + WS_YB); const int* SLOT = (const int*)(ws + WS_SLOT);
        for (int m = gw; m < MTOK; m += NGW) {
            const int b = m >> 12;
            const float* gt = MOD + b * 12288 + 5 * 2048;
            GAS f32x4* xr = (GAS f32x4*)(X2 + (size_t)m * D_MODEL) + lane;
            f32x4 v[8], y[8];
#pragma unroll
            for (int j = 0; j < 8; ++j) { v[j] = xr[64 * j]; y[j] = (f32x4){0.f, 0.f, 0.f, 0.f}; }
            const int myslot = SLOT[(size_t)m * NE + (lane & 15)];
#pragma unroll 1
            for (int e = 0; e < NE; ++e) { const int sl = __builtin_amdgcn_readlane(myslot, e);
                if (sl >= 0) { const GAS u32x2* yr = (const GAS u32x2*)(YB + ((size_t)(b * NE + e) * CAP + sl) * D_MODEL) + lane;
#pragma unroll
                    for (int j = 0; j < 8; ++j) { const u32x2 w = yr[64 * j]; y[j].x += bf2f(w.x & 0xffffu); y[j].y += bf2f(w.x >> 16); y[j].z += bf2f(w.y & 0xffffu); y[j].w += bf2f(w.y >> 16); } } }
            float s = 0.f;
#pragma unroll
            for (int j = 0; j < 8; ++j) { const f32x4 g = *((const GAS f32x4*)gt + lane + 64 * j); v[j] = v[j] + g * y[j]; s += (v[j].x * v[j].x + v[j].y * v[j].y) + (v[j].z * v[j].z + v[j].w * v[j].w); }
            const float rstd = 1.f / sqrtf(wave_sum(s) * (1.f / D_MODEL) + EPS);
#pragma unroll
            for (int j = 0; j < 8; ++j) { const f32x4 g = *((const GAS f32x4*)nf + lane + 64 * j); xr[64 * j] = v[j] * rstd * g; }
        }
    }
#undef IN
#undef SEAM
}

constexpr int NPHASES = 12;

extern "C" void kernel_launch(void* const* d_in, const int* in_sizes, int n_in, void* d_out, int out_size, void* d_ws, size_t ws_size, hipStream_t stream) {
    static int grid = 0;
    if (grid == 0) {
        if (n_in != 19 || out_size != MTOK * D_MODEL || ws_size < WS_END) { fprintf(stderr, "kernel_launch: unexpected shapes (n_in %d out %d ws %zu)\n", n_in, out_size, ws_size); grid = -1; return; }
        int dev = 0, cus = 0, per_cu = 0;
        if (hipGetDevice(&dev) != hipSuccess || hipDeviceGetAttribute(&cus, hipDeviceAttributeMultiprocessorCount, dev) != hipSuccess) { grid = -1; return; }
        if (hipFuncSetAttribute((const void*)fwd_kernel, hipFuncAttributeMaxDynamicSharedMemorySize, LDS_BYTES) != hipSuccess) { grid = -1; return; }
        if (hipOccupancyMaxActiveBlocksPerMultiprocessor(&per_cu, (const void*)fwd_kernel, NTHREADS, LDS_BYTES) != hipSuccess || per_cu < 1) { fprintf(stderr, "occupancy query: %d\n", per_cu); grid = -1; return; }
        grid = cus;
    }
    if (grid < 0) return;
    if (hipMemsetAsync((char*)d_ws + WS_CTL, 0, CTL_ZERO_BYTES, stream) != hipSuccess) return;
    Args a{};
    for (int i = 0; i < 19; ++i) a.in[i] = (const float*)d_in[i];
    a.out = (float*)d_out; a.ws = (unsigned char*)d_ws; a.ph_lo = 0; a.ph_hi = NPHASES;
    hipLaunchKernelGGL(fwd_kernel, dim3(grid), dim3(NTHREADS), LDS_BYTES, stream, a);
}
```

```cpp
#include <hip/hip_runtime.h>
#include <cstdio>
#include <cstdint>

#define GAS __attribute__((address_space(1)))
#define LAS __attribute__((address_space(3)))
typedef unsigned short bf16_t;
typedef short bf16x8 __attribute__((ext_vector_type(8)));
typedef short s16x4 __attribute__((ext_vector_type(4)));
typedef float f32x2 __attribute__((ext_vector_type(2)));
typedef float f32x4 __attribute__((ext_vector_type(4)));
typedef float f32x16 __attribute__((ext_vector_type(16)));
typedef unsigned u32x2 __attribute__((ext_vector_type(2)));
typedef unsigned u32x4 __attribute__((ext_vector_type(4)));
typedef __bf16 bf16x2_t __attribute__((ext_vector_type(2)));

constexpr int NWAVES = 8, NTHREADS = 512;
constexpr int D_MODEL = 2048, BATCH = 4, SEQ = 4096, MTOK = BATCH * SEQ, CTX = 256, MCTX = BATCH * CTX, MALL = MTOK + MCTX;
constexpr int FW = 1024, GDW = 1024, NH = 8, HD = 128, INC = 5152, INC_PAD = 5376;
constexpr int NE = 16, CAP = 512, FF = 1536;
constexpr float EPS = 1e-6f;

constexpr size_t MiB = 1u << 20;
constexpr size_t WS_CTL = 0, CTL_ZERO_BYTES = 1 * MiB;
constexpr size_t WS_MOD = 1 * MiB;
constexpr size_t WS_TW = WS_MOD + 256 * 1024;
constexpr size_t WS_DA = WS_TW + 32 * 1024;
constexpr size_t WS_DB = WS_DA + 16 * 1024;
constexpr size_t WS_DC = WS_DB + 32 * 1024;
constexpr size_t WS_WIN = 2 * MiB;
constexpr size_t WS_WOUT = WS_WIN + (size_t)INC_PAD * D_MODEL * 2;
constexpr size_t WS_WGU = WS_WOUT + (size_t)D_MODEL * D_MODEL * 2;
constexpr size_t WS_WDN = WS_WGU + (size_t)NE * 2 * FF * D_MODEL * 2;
constexpr size_t WS_PF = WS_WDN + (size_t)NE * D_MODEL * FF * 2;
constexpr size_t WS_PQKV = WS_PF + (size_t)MTOK * FW * 2;
constexpr size_t WS_PZ = WS_PQKV + (size_t)MALL * 3 * GDW * 2;
constexpr size_t WS_PAB = WS_PZ + (size_t)MTOK * GDW * 2;
constexpr size_t WS_G = WS_PAB + (size_t)MALL * 32 * 4;
constexpr size_t WS_HX2 = WS_G;
constexpr size_t WS_HID = WS_HX2 + (size_t)MTOK * D_MODEL * 2;
constexpr size_t WS_YB = WS_HID + (size_t)BATCH * NE * CAP * FF * 2;
constexpr size_t WS_AFF = WS_YB + (size_t)BATCH * NE * CAP * D_MODEL * 2;
constexpr size_t WS_IDX = WS_AFF + (size_t)BATCH * NE * SEQ * 4;
constexpr size_t WS_VAL = WS_IDX + (size_t)BATCH * NE * CAP * 4;
constexpr size_t WS_SLOT = WS_VAL + (size_t)BATCH * NE * CAP * 4;
constexpr size_t WS_A2 = WS_PF;
constexpr size_t WS_END = 800 * MiB;
static_assert(WS_SLOT + (size_t)MTOK * NE * 4 <= WS_END, "ws map");


constexpr int RING_BYTES = 131072;
constexpr int TAB_OFF = RING_BYTES;
constexpr int MISC_OFF = TAB_OFF + 16384;
constexpr int LDS_BYTES = MISC_OFF + 256;

constexpr int CW_BAR = 4096;
constexpr int CW_Q0 = 8128, CW_Q1 = 8192, CW_Q2 = 8256;

__device__ __forceinline__ unsigned f2bf(float f) { unsigned u = __builtin_bit_cast(unsigned, f); return (u + 0x7fffu + ((u >> 16) & 1u)) >> 16; }
__device__ __forceinline__ float bf2f(unsigned h) { return __builtin_bit_cast(float, h << 16); }
__device__ __forceinline__ unsigned pk2(float lo, float hi) { f32x2 v = {lo, hi}; bf16x2_t b = __builtin_convertvector(v, bf16x2_t); return __builtin_bit_cast(unsigned, b); }
__device__ __forceinline__ float wave_sum(float v) {
#pragma unroll
    for (int o = 1; o < 64; o <<= 1) v += __shfl_xor(v, o);
    return v;
}
__device__ __forceinline__ float dpp_xor1(float v) { return __builtin_bit_cast(float, __builtin_amdgcn_mov_dpp(__builtin_bit_cast(int, v), 0xB1, 0xf, 0xf, true)); }
__device__ __forceinline__ float dpp_xor2(float v) { return __builtin_bit_cast(float, __builtin_amdgcn_mov_dpp(__builtin_bit_cast(int, v), 0x4E, 0xf, 0xf, true)); }
__device__ __forceinline__ float silu_f(float v) { return v * __builtin_amdgcn_rcpf(1.f + __expf(-v)); }
#define LDS_WAIT() asm volatile("s_waitcnt lgkmcnt(0)" ::: "memory")
#define LBAR() do { asm volatile("s_waitcnt lgkmcnt(0)" ::: "memory"); __builtin_amdgcn_s_barrier(); asm volatile("" ::: "memory"); } while (0)

#define XB_TMO      128
#define XB_XCNT(j)  (256  + 64 * (j))
#define XB_XSUB(j)  (1280 + 64 * (j))
#define XB_XGEN(j)  (2304 + 64 * (j))
#define XB_TOP      3328
#define XB_TOPGEN   3392
#define XCD_BAR_WORDS 3456
#define XB_SPIN_CAP (1u << 18)
__device__ __forceinline__ unsigned xb_ld(unsigned* p)              { return __hip_atomic_load(p, __ATOMIC_RELAXED, __HIP_MEMORY_SCOPE_AGENT); }
__device__ __forceinline__ unsigned xb_add(unsigned* p, unsigned v) { return __hip_atomic_fetch_add(p, v, __ATOMIC_RELAXED, __HIP_MEMORY_SCOPE_AGENT); }
__device__ __forceinline__ unsigned xb_xcc_id() { return (unsigned)__builtin_amdgcn_s_getreg((3 << 11) | 20) & 0xFu; }
#define XB_SPIN(cond, bar) do { unsigned _sp = 0; while (cond) { __builtin_amdgcn_s_sleep(1); \
    if ((++_sp & 255u) == 0u) { if (xb_ld(&(bar)[XB_TMO])) break; if (_sp > XB_SPIN_CAP) { atomicAdd(&(bar)[XB_TMO], 1u); break; } } } } while (0)
struct XcdBarrier { unsigned* bar; unsigned x; volatile LAS unsigned* st; };
__device__ __forceinline__ XcdBarrier xcd_barrier_post(unsigned* bar, volatile LAS unsigned* st) {
    XcdBarrier b; b.bar = bar; b.x = xb_xcc_id(); b.st = st;
    if (threadIdx.x == 0) (void)xb_add(&bar[XB_XCNT(b.x)], 1u);
    return b;
}
__device__ __forceinline__ void xcd_barrier_complete(unsigned* bar, unsigned x, unsigned& nloc, unsigned& nx) {
    const unsigned G = gridDim.x * gridDim.y * gridDim.z;
    unsigned sum, cnt, mine, sp = 0u;
    for (;;) {
        sum = 0u; cnt = 0u; mine = 0u;
#pragma unroll
        for (unsigned j = 0; j < 16; ++j) { const unsigned c = xb_ld(&bar[XB_XCNT(j)]); sum += c; cnt += (c > 0u) ? 1u : 0u; mine = (j == x) ? c : mine; }
        if (sum == G) break;
        __builtin_amdgcn_s_sleep(1);
        if ((++sp & 255u) == 0u) { if (xb_ld(&bar[XB_TMO])) break; if (sp > XB_SPIN_CAP) { atomicAdd(&bar[XB_TMO], 1u); break; } }
    }
    nloc = mine > 0u ? mine : 1u; nx = cnt > 0u ? cnt : 1u;
}
__device__ __forceinline__ void xcd_barrier(const XcdBarrier& b) {
    asm volatile("s_waitcnt vmcnt(0)" ::: "memory");
    __syncthreads();
    if (threadIdx.x == 0) {
        unsigned* bar = b.bar;
        __builtin_amdgcn_s_waitcnt(0);
        unsigned nloc = b.st[0], nx = b.st[1];
        if (nloc == 0u) { xcd_barrier_complete(bar, b.x, nloc, nx); b.st[0] = nloc; b.st[1] = nx; }
        const unsigned old = xb_add(&bar[XB_XSUB(b.x)], 1u);
        const unsigned gen = old / nloc;
        if (old + 1u == (gen + 1u) * nloc) {
            __builtin_amdgcn_fence(__ATOMIC_RELEASE, "agent");
            asm volatile("s_waitcnt vmcnt(0)" ::: "memory");
            const unsigned og = xb_add(&bar[XB_TOP], 1u);
            const unsigned tg = og / nx;
            if (og + 1u == (tg + 1u) * nx) xb_add(&bar[XB_TOPGEN], 1u);
            else XB_SPIN(xb_ld(&bar[XB_TOPGEN]) == tg, bar);
            __builtin_amdgcn_fence(__ATOMIC_ACQUIRE, "agent");
            xb_add(&bar[XB_XGEN(b.x)], 1u);
            asm volatile("s_waitcnt vmcnt(0)" ::: "memory");
        } else {
            XB_SPIN(xb_ld(&bar[XB_XGEN(b.x)]) == gen, bar);
            __builtin_amdgcn_fence(__ATOMIC_ACQUIRE, "agent");
            asm volatile("s_waitcnt vmcnt(0)" ::: "memory");
        }
    }
    __syncthreads();
}

namespace pg8 {
constexpr int BM = 256, BK = 64, HALF = 128, HTB = HALF * BK * 2, STAGE_BYTES = 8 * HTB, NXCD = 8, WGM = 8;
__host__ __device__ __forceinline__ int lds_byte(int r, int c) { const int st = (r >> 4) * 2 + (c >> 5), rr = r & 15, cc = c & 31, ob = rr * 64 + cc * 2; return st * 1024 + (ob ^ (((ob >> 9) & 1) << 5)); }
__host__ __device__ __forceinline__ void stage_rc(int b, int& R, int& C) { const int st = b / 1024, sb = b % 1024, swz = sb ^ (((sb >> 9) & 1) << 5); R = (st >> 1) * 16 + swz / 64; C = (st & 1) * 32 + (swz % 64) / 2; }
__host__ __device__ __forceinline__ int perm32(int rho) { const int n = rho >> 4, i = rho & 15; return 8 * (i >> 2) + 4 * n + (i & 3); }

struct Unit { const char* a; const char* b; const int* gidx; int pm, pn, aux; };

template <class Epi, class Sched, bool GATHER>
__device__ __forceinline__ void gemm_phase(LAS unsigned char* lds, LAS unsigned* tab, const int K, const Sched& S, const Epi& E) {
    int tid_ = threadIdx.x; asm volatile("" : "+v"(tid_));
    const int tid = tid_, wid = __builtin_amdgcn_readfirstlane(tid >> 6), lane = tid & 63, wr = wid >> 2, wc = wid & 3, fr = lane & 15, fq = lane >> 4;
    const int nt = K / BK;
    unsigned voffA[2], voffB[2];
#pragma unroll
    for (int i = 0; i < 2; ++i) { int R, C; stage_rc(tid * 16 + i * 8192, R, C); const int Rb = Epi::PERM ? ((R & ~31) + perm32(R & 31)) : R;
        voffA[i] = (unsigned)(R * K + C) * 2u; voffB[i] = (unsigned)(Rb * K + C) * 2u; }
    const size_t kstep = (size_t)(BK * 2);
    const size_t hstep = (size_t)HALF * K * 2;
    const unsigned ldsw = (unsigned)wid * 1024u;
    const int aoff = lds_byte(wr * 64 + fr, fq * 8), boff = lds_byte(wc * 32 + fr, fq * 8);
#define PG8_SA(b, h) (((b) * 2 + (h)) * HTB)
#define PG8_SB(b, h) ((4 + (b) * 2 + (h)) * HTB)
#define PG8_STAGE(bufoff, gbase, voff) do { _Pragma("unroll") for (int _i = 0; _i < 2; ++_i) \
        __builtin_amdgcn_global_load_lds((const unsigned*)((const char*)(gbase) + (voff)[_i]), (LAS unsigned*)(lds + (bufoff) + ldsw + _i * 8192), 16, 0, 0); } while (0)
#define PG8_STAGE_A(bufoff, gbase, par, h) do { if constexpr (GATHER) { _Pragma("unroll") for (int _i = 0; _i < 2; ++_i) { const unsigned _o = tab[(((par) * 2 + (h)) * 2 + _i) * 512 + tid]; \
            __builtin_amdgcn_global_load_lds((const unsigned*)((const char*)(gbase) + _o), (LAS unsigned*)(lds + (bufoff) + ldsw + _i * 8192), 16, 0, 0); } } \
        else { PG8_STAGE(bufoff, (gbase) + (h) * hstep, voffA); } } while (0)
#define PG8_LDA(dst, b, h) do { _Pragma("unroll") for (int m = 0; m < 4; ++m) _Pragma("unroll") for (int k = 0; k < 2; ++k) dst[m][k] = *(const LAS bf16x8*)(lds + PG8_SA(b, h) + aoff + m * 2048 + k * 1024); } while (0)
#define PG8_LDB(dst, b, h) do { _Pragma("unroll") for (int n = 0; n < 2; ++n) _Pragma("unroll") for (int k = 0; k < 2; ++k) dst[n][k] = *(const LAS bf16x8*)(lds + PG8_SB(b, h) + boff + n * 2048 + k * 1024); } while (0)
#define PG8_MMA(ai, bj, At, Bt) do { __builtin_amdgcn_s_setprio(1); _Pragma("unroll") for (int m = 0; m < 4; ++m) _Pragma("unroll") for (int n = 0; n < 2; ++n) _Pragma("unroll") for (int k = 0; k < 2; ++k) \
        acc[ai][bj][m][n] = __builtin_amdgcn_mfma_f32_16x16x32_bf16(Bt[n][k], At[m][k], acc[ai][bj][m][n], 0, 0, 0); __builtin_amdgcn_s_setprio(0); } while (0)
#define PG8_WAIT_V(n) asm volatile("s_waitcnt vmcnt(" #n ")" ::: "memory")
#define PG8_WAIT_L(n) asm volatile("s_waitcnt lgkmcnt(" #n ")" ::: "memory")
#define PG8_BAR __builtin_amdgcn_s_barrier()
#define PG8_SCHED __builtin_amdgcn_sched_barrier(0)
#define PG8_FILL(par, u) do { if constexpr (GATHER) { _Pragma("unroll") for (int _h = 0; _h < 2; ++_h) _Pragma("unroll") for (int _i = 0; _i < 2; ++_i) { int R_, C_; stage_rc(tid * 16 + _i * 8192, R_, C_); \
        const int row_ = (u).gidx[_h * HALF + R_]; tab[(((par) * 2 + _h) * 2 + _i) * 512 + tid] = (unsigned)(row_ * K + C_) * 2u; } } } while (0)
    Unit cur, nxt; int ui = 0; int par = 0;
    if (!S.next(0, cur)) return;
    f32x4 acc[2][2][4][2];
#pragma unroll
    for (int a = 0; a < 2; ++a)
#pragma unroll
        for (int b = 0; b < 2; ++b)
#pragma unroll
            for (int m = 0; m < 4; ++m)
#pragma unroll
                for (int n = 0; n < 2; ++n) acc[a][b][m][n] = (f32x4){0.f, 0.f, 0.f, 0.f};
    bf16x8 At[4][2], B0[2][2], B1[2][2];
    const char* cA = cur.a; const char* cB = cur.b;
    PG8_FILL(0, cur);
    PG8_STAGE(PG8_SB(0, 0), cB, voffB); PG8_STAGE(PG8_SB(0, 1), cB + hstep, voffB); PG8_STAGE_A(PG8_SA(0, 0), cA, 0, 0); PG8_STAGE_A(PG8_SA(0, 1), cA, 0, 1);
    if (wr == 1) PG8_BAR;
    PG8_WAIT_V(2); PG8_BAR;
    PG8_STAGE(PG8_SB(1, 0), cB + kstep, voffB); PG8_STAGE_A(PG8_SA(1, 0), cA + kstep, 0, 0); PG8_STAGE(PG8_SB(1, 1), cB + hstep + kstep, voffB);
    PG8_WAIT_V(6); PG8_BAR;
    for (;;) {
        const bool has_next = S.next(ui + 1, nxt);
        const char* nA = has_next ? nxt.a : cA; const char* nB = has_next ? nxt.b : cB;
        const int npar = has_next ? (par ^ 1) : par;
        for (int t = 0; t < nt; t += 2) {
            const bool last = (t == nt - 2);
            const char* a1 = cA + (size_t)(t + 1) * kstep;
            const char* a2 = last ? nA : cA + (size_t)(t + 2) * kstep; const char* b2 = last ? nB : cB + (size_t)(t + 2) * kstep;
            const char* a3 = a2 + kstep; const char* b3 = b2 + kstep;
            const int p2 = last ? npar : par;
            if (last && has_next) PG8_FILL(npar, nxt);
            PG8_LDB(B0, 0, 0); PG8_LDB(B1, 0, 1); PG8_SCHED; PG8_LDA(At, 0, 0); PG8_STAGE_A(PG8_SA(1, 1), a1, par, 1);
            PG8_WAIT_V(8); PG8_WAIT_L(0); PG8_BAR; PG8_MMA(0, 0, At, B0); PG8_MMA(0, 1, At, B1); PG8_BAR; PG8_SCHED;
            PG8_LDA(At, 0, 1); PG8_STAGE(PG8_SB(0, 0), b2, voffB); PG8_STAGE(PG8_SB(0, 1), b2 + hstep, voffB); PG8_STAGE_A(PG8_SA(0, 0), a2, p2, 0);
            PG8_WAIT_V(8); PG8_WAIT_L(0); PG8_BAR; PG8_MMA(1, 0, At, B0); PG8_MMA(1, 1, At, B1); PG8_BAR; PG8_SCHED;
            PG8_LDB(B0, 1, 0); PG8_LDB(B1, 1, 1); PG8_SCHED; PG8_LDA(At, 1, 0); PG8_STAGE_A(PG8_SA(0, 1), a2, p2, 1);
            PG8_WAIT_V(8); PG8_WAIT_L(0); PG8_BAR; PG8_MMA(0, 0, At, B0); PG8_MMA(0, 1, At, B1); PG8_BAR; PG8_SCHED;
            PG8_LDA(At, 1, 1); PG8_STAGE(PG8_SB(1, 0), b3, voffB); PG8_STAGE(PG8_SB(1, 1), b3 + hstep, voffB); PG8_STAGE_A(PG8_SA(1, 0), a3, p2, 0);
            PG8_WAIT_V(8); PG8_WAIT_L(0); PG8_BAR; PG8_MMA(1, 0, At, B0); PG8_MMA(1, 1, At, B1); PG8_BAR; PG8_SCHED;
        }
        if (wr == 0) PG8_BAR;
        E(acc, cur, wr, wc, fr, fq);
        if (!has_next) break;
#pragma unroll
        for (int a = 0; a < 2; ++a)
#pragma unroll
            for (int b = 0; b < 2; ++b)
#pragma unroll
                for (int m = 0; m < 4; ++m)
#pragma unroll
                    for (int n = 0; n < 2; ++n) acc[a][b][m][n] = (f32x4){0.f, 0.f, 0.f, 0.f};
        cur = nxt; cA = nA; cB = nB; par = npar; ++ui;
        if (wr == 1) PG8_BAR;
    }
    PG8_WAIT_V(0);
    PG8_BAR;
#undef PG8_SA
#undef PG8_SB
#undef PG8_STAGE
#undef PG8_STAGE_A
#undef PG8_LDA
#undef PG8_LDB
#undef PG8_MMA
#undef PG8_WAIT_V
#undef PG8_WAIT_L
#undef PG8_BAR
#undef PG8_SCHED
#undef PG8_FILL
}
}

__device__ __forceinline__ bf16x8 frag_row(const LAS bf16_t* base, int ld, int r0, int k0, int lane) {
    return *(const LAS bf16x8*)(base + (r0 + (lane & 31)) * ld + k0 + 8 * (lane >> 5));
}
__device__ __forceinline__ bf16x8 frag_tr(const LAS bf16_t* base, int ld, int r0, int k0, int lane) {
    const int h = lane >> 5, blk = (lane >> 4) & 1, q = (lane & 15) >> 2, p = lane & 3;
    const LAS bf16_t* a0 = base + (k0 + 8 * h + q) * ld + r0 + 16 * blk + 4 * p;
    const s16x4 lo = __builtin_bit_cast(s16x4, __builtin_amdgcn_ds_read_tr16_b64_v4i16((LAS s16x4*)a0));
    const s16x4 hi = __builtin_bit_cast(s16x4, __builtin_amdgcn_ds_read_tr16_b64_v4i16((LAS s16x4*)(a0 + 4 * ld)));
    return (bf16x8){lo[0], lo[1], lo[2], lo[3], hi[0], hi[1], hi[2], hi[3]};
}
__device__ __forceinline__ int crow(int r, int lane) { return (r & 3) + 8 * (r >> 2) + 4 * (lane >> 5); }
#define MFMA32(a, b, c) __builtin_amdgcn_mfma_f32_32x32x16_bf16((a), (b), (c), 0, 0, 0)
constexpr f32x16 Z16 = {0.f, 0.f, 0.f, 0.f, 0.f, 0.f, 0.f, 0.f, 0.f, 0.f, 0.f, 0.f, 0.f, 0.f, 0.f, 0.f};


constexpr int CVT_BLOCK_ITEMS = 3 * 3072;
struct CvtJob { f32x4 v[8]; int item; };
__device__ __forceinline__ void cvt_issue(CvtJob& c, int item, int lane, const float* wg, const float* wu, const float* wd) {
    c.item = item;
    if (item < 0) return;
    const int kc = lane & 7, ng = lane >> 3; const int bi = item >> 3, sub = item & 7;
    const float* src; int ldn, k0, n0;
    if (bi < 6144) { const int up = bi >= 3072, r0 = bi - up * 3072, e = r0 / 192, r = r0 % 192; src = (up ? wu : wg) + (size_t)e * D_MODEL * FF; ldn = FF; k0 = 64 * (r / 6); n0 = 256 * (r % 6) + 32 * sub; }
    else { const int r0 = bi - 6144, e = r0 / 192, r = r0 % 192; src = wd + (size_t)e * FF * D_MODEL; ldn = D_MODEL; k0 = 64 * (r / 8); n0 = 256 * (r % 8) + 32 * sub; }
    const float* p = src + (size_t)(k0 + 8 * kc) * ldn + n0 + 4 * ng;
#pragma unroll
    for (int i = 0; i < 8; ++i) c.v[i] = *(const GAS f32x4*)(p + (size_t)i * ldn);
}
__device__ __forceinline__ void cvt_finish(const CvtJob& c, int lane, bf16_t* WGU, bf16_t* WDN) {
    const int item = c.item;
    if (item < 0) return;
    const int kc = lane & 7, ng = lane >> 3; const int bi = item >> 3, sub = item & 7;
    bf16_t* dst; int dstK, k0, n0, mode;
    if (bi < 6144) { const int up = bi >= 3072, r0 = bi - up * 3072, e = r0 / 192, r = r0 % 192; dst = WGU + (size_t)e * 2 * FF * D_MODEL; dstK = D_MODEL; k0 = 64 * (r / 6); n0 = 256 * (r % 6) + 32 * sub; mode = 1 + up; }
    else { const int r0 = bi - 6144, e = r0 / 192, r = r0 % 192; dst = WDN + (size_t)e * D_MODEL * FF; dstK = FF; k0 = 64 * (r / 8); n0 = 256 * (r % 8) + 32 * sub; mode = 0; }
    const int n = n0 + 4 * ng;
    const int row0 = mode == 0 ? n : (256 * (n >> 7) + 128 * (mode - 1) + (n & 127));
    bf16_t* o = dst + (size_t)row0 * dstK + k0 + 8 * kc;
#pragma unroll
    for (int j = 0; j < 4; ++j) { u32x4 w; w.x = pk2(c.v[0][j], c.v[1][j]); w.y = pk2(c.v[2][j], c.v[3][j]); w.z = pk2(c.v[4][j], c.v[5][j]); w.w = pk2(c.v[6][j], c.v[7][j]);
        *(GAS u32x4*)(o + (size_t)j * dstK) = w; }
}
struct CvtShadow { int base, left; };
__device__ __forceinline__ int cvt_next(CvtShadow& cs, unsigned* q, int lane) {
    if (cs.left == 0) { if (cs.base == -2) return -1; unsigned v = 0; if (lane == 0) v = atomicAdd(q, 1u); const int b = (int)__builtin_amdgcn_readfirstlane(v);
        if (b >= CVT_BLOCK_ITEMS) { cs.base = -2; return -1; } cs.base = b * 8; cs.left = 8; }
    const int it = cs.base + (8 - cs.left); --cs.left; return it;
}
constexpr int REC_W = 0, REC_UT = 16384, REC_QD = 32768, REC_KDT = 49152, REC_QK = 65536, REC_GT = 73728, REC_BYTES = 73984;
constexpr int NREC_X = BATCH * NH * 2 * 64, NREC = NREC_X + BATCH * NH * 2 * 4;
__device__ __forceinline__ size_t rec_index(bool isctx, int b, int h, int d, int c) { return isctx ? (size_t)(NREC_X + ((b * NH + h) * 2 + d) * 4 + c) : (size_t)(((b * NH + h) * 2 + d) * 64 + c); }
__device__ __forceinline__ float softplus_f(float v) { return v > 20.f ? v : log1pf(__expf(v)); }

struct GdnItem { bool isctx; int b, h, c, rowbase, vlo, vhi; };
__device__ __forceinline__ GdnItem gdn_decode(int item) {
    GdnItem I;
    if (item < BATCH * NH * 64) { I.isctx = false; I.b = item >> 9; I.h = (item >> 6) & 7; I.c = item & 63; I.rowbase = I.b * SEQ + I.c * 64; I.vlo = 0; I.vhi = 64; }
    else { const int j = item - BATCH * NH * 64; I.isctx = true; I.b = j >> 5; I.h = (j >> 2) & 7; I.c = j & 3; I.rowbase = MTOK + I.b * CTX + I.c * 64; I.vlo = -I.c * 64; I.vhi = CTX - I.c * 64; }
    return I;
}
struct GdnPre { u32x4 raw[7]; f32x4 cw; float ga, gb; };
__device__ __forceinline__ void gdn_prefetch(GdnPre& P, const GdnItem& I, int tid, int lane, int wave, const bf16_t* PQKV, const float* PAB, const float* convw) {
#pragma unroll
    for (int e = 0; e < 7; ++e) { const int idx = tid + 512 * e; u32x4 v = {0u, 0u, 0u, 0u};
        if (idx < 3 * 68 * 16) { const int ch = idx & 15, rr = (idx >> 4) % 68, t = (idx >> 4) / 68; const int rel = rr - 2;
            if (rel >= I.vlo && rel < I.vhi) v = *(const GAS u32x4*)(PQKV + (size_t)(I.rowbase + rel) * (3 * GDW) + t * GDW + I.h * HD + ch * 8); }
        P.raw[e] = v; }
    if (tid < 480) { const int t = tid / 160, j = (tid % 160) >> 5, c4 = tid & 31; P.cw = *(const GAS f32x4*)(convw + j * (3 * GDW) + t * GDW + I.h * HD + c4 * 4); }
    if (wave < 2) { const int d = wave; const int i = d ? 63 - lane : lane; const int m = I.rowbase + i; P.ga = PAB[(size_t)m * 32 + d * 8 + I.h]; P.gb = PAB[(size_t)m * 32 + 16 + d * 8 + I.h]; }
}

__device__ __forceinline__ void gdn_chunk_items(LAS unsigned char* L, int first, int stride, const bf16_t* PQKV, const float* PAB, const float* convw, const float* a_log, const float* dt_bias, unsigned char* GREC,
                                                unsigned* cvq, const float* wg, const float* wu, const float* wd, bf16_t* WGU, bf16_t* WDN) {
    const int tid_f_ = threadIdx.x, wave = __builtin_amdgcn_readfirstlane(tid_f_ >> 6);
    constexpr int LD = 136, LDT_ = 72, NITEMS = BATCH * NH * 64 + BATCH * NH * 4;
    LAS bf16_t* QN = (LAS bf16_t*)L; LAS bf16_t* KN = (LAS bf16_t*)(L + 17408); LAS bf16_t* VI = (LAS bf16_t*)(L + 34816);
    LAS bf16_t* RAW = (LAS bf16_t*)(L + 52224);
    LAS bf16_t* TB = (LAS bf16_t*)(L + 52224); LAS bf16_t* TBG = (LAS bf16_t*)(L + 70656);
    LAS float* MPD = (LAS float*)(L + 89088);
    LAS bf16_t* MB = (LAS bf16_t*)(L + 97280);
    LAS bf16_t* TI = (LAS bf16_t*)(L + 52224);
    LAS bf16_t* PI = (LAS bf16_t*)(L + 70656);
    LAS float* GC = (LAS float*)(L + 122880); LAS float* BETA = GC + 128; LAS float* EGC = GC + 256; LAS float* EKD = GC + 384; LAS float* GTOT = (LAS float*)(L + 115712);
    LAS float* CW = (LAS float*)(L + 124928);
    LAS bf16_t* QKB = (LAS bf16_t*)(L + 124928);
    if (first >= NITEMS) return;
    CvtShadow cs; cs.base = -1; cs.left = 0; CvtJob cj; cj.item = -1;
#ifndef CVT_SHADOW
#define CVT_SHADOW 0
#endif
#if CVT_SHADOW
#define CVT_HOOK_ISSUE() cvt_issue(cj, cvt_next(cs, cvq, lane), lane, wg, wu, wd)
#define CVT_HOOK_FINISH() cvt_finish(cj, lane, WGU, WDN)
#else
#define CVT_HOOK_ISSUE() do { } while (0)
#define CVT_HOOK_FINISH() do { } while (0)
#endif
    GdnPre P;
    { int t0_ = tid_f_; asm volatile("" : "+v"(t0_)); const GdnItem I0 = gdn_decode(first); gdn_prefetch(P, I0, t0_, t0_ & 63, wave, PQKV, PAB, convw); }
#pragma unroll 1
    for (int item = first; item < NITEMS; item += stride) {
        int tid_o_ = tid_f_; asm volatile("" : "+v"(tid_o_)); const int tid = tid_o_, lane = tid & 63;
        const GdnItem I = gdn_decode(item);
        const bool isctx = I.isctx; const int b = I.b, h = I.h, c = I.c;
#pragma unroll
        for (int e = 0; e < 7; ++e) { const int idx = tid + 512 * e; if (idx < 3 * 68 * 16) { const int ch = idx & 15, rr = (idx >> 4) % 68, t = (idx >> 4) / 68; *(LAS u32x4*)(RAW + (t * 68 + rr) * LD + ch * 8) = P.raw[e]; } }
        if (tid < 480) { const int t = tid / 160, j = (tid % 160) >> 5, c4 = tid & 31; *(LAS f32x4*)(CW + (t * 5 + j) * 128 + c4 * 4) = P.cw; }
        if (wave < 2) { const int d = wave; const int i = d ? 63 - lane : lane;
            const float g = -__expf(a_log[d * 8 + h]) * softplus_f(P.ga + dt_bias[d * 8 + h]);
            float s = g;
#pragma unroll
            for (int o = 1; o < 64; o <<= 1) { const float t = __shfl_up(s, o); if (lane >= o) s += t; }
            const float gt_ = __shfl(s, 63);
            GC[d * 64 + i] = s; EGC[d * 64 + i] = __expf(s); EKD[d * 64 + i] = __expf(gt_ - s); BETA[d * 64 + i] = __builtin_amdgcn_rcpf(1.f + __expf(-P.gb));
            if (lane == 63) GTOT[d] = s; }
        LBAR();
        { const int nxt = item + stride; if (nxt < NITEMS) { const GdnItem In = gdn_decode(nxt); gdn_prefetch(P, In, tid, lane, wave, PQKV, PAB, convw); } }
#ifndef REPG
#define REPG 0
#endif
#define GS(k) for (int gq_ = 0; gq_ <= ((REPG >> (k)) & 1); ++gq_)
        GS(1) {
        CVT_HOOK_ISSUE();
        { int tt = tid; asm volatile("" : "+v"(tt)); const int cgp = tt & 31, tg = tt >> 5;
#pragma unroll
            for (int t = 0; t < 3; ++t) {
                f32x4 w[5];
#pragma unroll
                for (int j = 0; j < 5; ++j) w[j] = *(const LAS f32x4*)(CW + (t * 5 + j) * 128 + 4 * cgp);
                f32x4 x[8];
#pragma unroll
                for (int rr = 0; rr < 8; ++rr) { const u32x2 q = *(const LAS u32x2*)(RAW + (t * 68 + 4 * tg + rr) * LD + 4 * cgp); x[rr] = (f32x4){bf2f(q.x & 0xffffu), bf2f(q.x >> 16), bf2f(q.y & 0xffffu), bf2f(q.y >> 16)}; }
                f32x4 y[4]; float ss[4];
#pragma unroll
                for (int k = 0; k < 4; ++k) { f32x4 acc = w[0] * x[k];
#pragma unroll
                    for (int j = 1; j < 5; ++j) acc += w[j] * x[k + j];
                    acc.x = silu_f(acc.x); acc.y = silu_f(acc.y); acc.z = silu_f(acc.z); acc.w = silu_f(acc.w);
                    y[k] = acc; ss[k] = (acc.x * acc.x + acc.y * acc.y) + (acc.z * acc.z + acc.w * acc.w); }
                if (t < 2) {
#pragma unroll
                    for (int k = 0; k < 4; ++k) { float v = ss[k]; v += dpp_xor1(v); v += dpp_xor2(v); v += __shfl_xor(v, 4); v += __shfl_xor(v, 8); v += __shfl_xor(v, 16);
                        float sc = __builtin_amdgcn_rsqf(v + EPS); if (t == 0) sc *= 0.08838834764831845f; y[k] = y[k] * sc; } }
                LAS bf16_t* dst = (t == 0 ? QN : (t == 1 ? KN : VI)) + (4 * tg) * LD + 4 * cgp;
#pragma unroll
                for (int k = 0; k < 4; ++k) { u32x2 o; o.x = pk2(y[k].x, y[k].y); o.y = pk2(y[k].z, y[k].w); *(LAS u32x2*)(dst + k * LD) = o; }
            }
        }
        CVT_HOOK_FINISH();
        LBAR();
        }
        GS(2) {
        { const int which = wave >> 2, ti = (wave >> 1) & 1, tj = wave & 1; f32x16 acc = Z16;
            { bf16x8 fa[8], fb[8];
#pragma unroll
                for (int ks = 0; ks < 8; ++ks) { fa[ks] = frag_row(which ? QN : KN, LD, 32 * ti, 16 * ks, lane); fb[ks] = frag_row(KN, LD, 32 * tj, 16 * ks, lane); }
                __builtin_amdgcn_sched_barrier(0);
#pragma unroll
                for (int ks = 0; ks < 8; ++ks) acc = MFMA32(fa[ks], fb[ks], acc); }
            const int j = 32 * tj + (lane & 31); const float g0j = GC[j], g1j = GC[64 + j];
#pragma unroll
            for (int g4 = 0; g4 < 4; ++g4) { const int i0 = 32 * ti + 8 * g4 + 4 * (lane >> 5);
                const f32x4 g0i = *(const LAS f32x4*)(GC + i0), g1i = *(const LAS f32x4*)(GC + 64 + i0), b0i = *(const LAS f32x4*)(BETA + i0), b1i = *(const LAS f32x4*)(BETA + 64 + i0);
#pragma unroll
                for (int e = 0; e < 4; ++e) { const int i = i0 + e; const float a_ = acc[4 * g4 + e];
                    const bool lo = j < i, hi = j > i;
                    const float ex = __expf(lo ? (g0i[e] - g0j) : (hi ? (g1i[e] - g1j) : 0.f));
                    if (which == 0) { const float v = a_ * ex * (lo ? b0i[e] : b1i[e]); const float v0 = lo ? v : 0.f, v1 = hi ? v : 0.f; const int il = 63 - i, jl = 63 - j;
                        MB[(0 * 64 + i) * LDT_ + j] = (bf16_t)f2bf(v0); MB[(1 * 64 + il) * LDT_ + jl] = (bf16_t)f2bf(v1);
                        if ((i >> 4) == (j >> 4)) { MPD[((0 * 4 + (i >> 4)) * 16 + (i & 15)) * 16 + (j & 3) * 4 + ((j & 15) >> 2)] = v0; MPD[((1 * 4 + (il >> 4)) * 16 + (il & 15)) * 16 + (jl & 3) * 4 + ((jl & 15) >> 2)] = v1; } }
                    else { const float v = a_ * ex; QKB[(0 * 64 + i) * LDT_ + j] = (bf16_t)f2bf(hi ? 0.f : v); QKB[(1 * 64 + i) * LDT_ + j] = (bf16_t)f2bf(lo ? 0.f : v); } } }
        }
        LBAR();
        }
        GS(3) {
        CVT_HOOK_ISSUE();
        { const int d = wave >> 2, a_ = wave & 3; const int c = lane >> 2, r = lane & 3; float T[4] = {0.f, 0.f, 0.f, 0.f};
            LAS bf16_t* TId = TI + d * 64 * LDT_;
            { LAS unsigned* z = (LAS unsigned*)(TId + 16 * a_ * LDT_);
#pragma unroll
                for (int e = 0; e < 9; ++e) z[lane + 64 * e] = 0u; }
            const LAS float* mp = MPD + ((d * 4 + a_) * 16) * 16 + r * 4;
            f32x4 md[16];
#pragma unroll
            for (int rr = 0; rr < 16; ++rr) md[rr] = *(const LAS f32x4*)(mp + rr * 16);
#pragma unroll
            for (int rr = 0; rr < 16; ++rr) { float acc = (md[rr].x * T[0] + md[rr].y * T[1]) + (md[rr].z * T[2] + md[rr].w * T[3]);
                acc += dpp_xor1(acc); acc += dpp_xor2(acc);
                const float t = (rr == c ? 1.f : 0.f) - acc;
                if (r == (rr & 3)) T[rr >> 2] = t; }
            LDS_WAIT();
#pragma unroll
            for (int q = 0; q < 4; ++q) TId[(16 * a_ + 4 * q + r) * LDT_ + 16 * a_ + c] = (bf16_t)f2bf(T[q]);
        }
        LBAR();
        { const int d = wave >> 2, hsel = wave & 3; LAS bf16_t* TId = TI + d * 64 * LDT_; LAS bf16_t* PId = PI + d * 64 * LDT_; const LAS bf16_t* MBd = MB + d * 64 * LDT_;
            if (hsel < 2) { const int o = 32 * hsel;
                f32x16 p = Z16;
#pragma unroll
                for (int ks = 0; ks < 2; ++ks) p = MFMA32(frag_row(MBd, LDT_, o, o + 16 * ks, lane), frag_tr(TId, LDT_, o, o + 16 * ks, lane), p);
#pragma unroll
                for (int rg = 0; rg < 16; ++rg) PId[(o + crow(rg, lane)) * LDT_ + o + (lane & 31)] = (bf16_t)f2bf(p[rg]);
                LDS_WAIT();
                f32x16 q = Z16;
#pragma unroll
                for (int ks = 0; ks < 2; ++ks) q = MFMA32(frag_row(TId, LDT_, o, o + 16 * ks, lane), frag_tr(PId, LDT_, o, o + 16 * ks, lane), q);
                if ((lane & 31) < 16) {
#pragma unroll
                    for (int rg = 8; rg < 16; ++rg) TId[(o + crow(rg, lane)) * LDT_ + o + (lane & 31)] = (bf16_t)f2bf(-q[rg]); } }
        }
        LBAR();
        { const int d = wave >> 2, hsel = wave & 3; LAS bf16_t* TId = TI + d * 64 * LDT_; LAS bf16_t* PId = PI + d * 64 * LDT_; const LAS bf16_t* MBd = MB + d * 64 * LDT_;
            if (hsel == 0) {
                f32x16 p = Z16;
#pragma unroll
                for (int ks = 0; ks < 2; ++ks) p = MFMA32(frag_row(MBd, LDT_, 32, 16 * ks, lane), frag_tr(TId, LDT_, 0, 16 * ks, lane), p);
#pragma unroll
                for (int rg = 0; rg < 16; ++rg) PId[(32 + crow(rg, lane)) * LDT_ + (lane & 31)] = (bf16_t)f2bf(p[rg]);
                LDS_WAIT();
                f32x16 q = Z16;
#pragma unroll
                for (int ks = 0; ks < 2; ++ks) q = MFMA32(frag_row(TId, LDT_, 32, 32 + 16 * ks, lane), frag_tr(PId, LDT_, 0, 32 + 16 * ks, lane), q);
#pragma unroll
                for (int rg = 0; rg < 16; ++rg) TId[(32 + crow(rg, lane)) * LDT_ + (lane & 31)] = (bf16_t)f2bf(-q[rg]); }
        }
        LBAR();
        { int tt = tid; asm volatile("" : "+v"(tt)); const int d = tt >> 8, t2 = tt & 255;
            if (d == 0) {
#pragma unroll
                for (int e = 0; e < 16; ++e) { const int idx = t2 + 256 * e, i = idx >> 6, j = idx & 63; const float t = bf2f(TI[i * LDT_ + j]); const float bj = BETA[j];
                    TB[i * LDT_ + j] = (bf16_t)f2bf(t * bj); TBG[i * LDT_ + j] = (bf16_t)f2bf(t * bj * EGC[j]); } }
            else {
#pragma unroll
                for (int e = 0; e < 8; ++e) { const int idx = t2 + 256 * e, p = idx >> 6, q = idx & 63, p2 = 63 - p, q2 = 63 - q;
                    const float ta = bf2f(TI[(64 + p) * LDT_ + q]), tb = bf2f(TI[(64 + p2) * LDT_ + q2]); const float b1 = BETA[64 + q], b2 = BETA[64 + q2];
                    TB[(64 + p) * LDT_ + q] = (bf16_t)f2bf(tb * b1); TB[(64 + p2) * LDT_ + q2] = (bf16_t)f2bf(ta * b2);
                    TBG[(64 + p) * LDT_ + q] = (bf16_t)f2bf(tb * b1 * EGC[64 + q]); TBG[(64 + p2) * LDT_ + q2] = (bf16_t)f2bf(ta * b2 * EGC[64 + q2]); } }
        }
        CVT_HOOK_FINISH();
        LBAR();
        }
        GS(4) {
        CVT_HOOK_ISSUE();
        { const int d = wave >> 2, wq = wave & 3; unsigned char* rec = GREC + rec_index(isctx, b, h, d, c) * REC_BYTES;
            bf16_t* uT = (bf16_t*)(rec + REC_UT); bf16_t* wout = (bf16_t*)(rec + REC_W);
#pragma unroll
            for (int it = 0; it < 2; ++it) { f32x16 au = Z16, aw = Z16;
                { bf16x8 f1[4], f2[4], f3[4], f4[4];
#pragma unroll
                    for (int ks = 0; ks < 4; ++ks) { f1[ks] = frag_row(TB + d * 64 * LDT_, LDT_, 32 * it, 16 * ks, lane); f2[ks] = frag_tr(VI, LD, 32 * wq, 16 * ks, lane);
                        f3[ks] = frag_tr(KN, LD, 32 * wq, 16 * ks, lane); f4[ks] = frag_row(TBG + d * 64 * LDT_, LDT_, 32 * it, 16 * ks, lane); }
                    __builtin_amdgcn_sched_barrier(0);
#pragma unroll
                    for (int ks = 0; ks < 4; ++ks) { au = MFMA32(f1[ks], f2[ks], au); aw = MFMA32(f3[ks], f4[ks], aw); } }
#pragma unroll
                for (int g4 = 0; g4 < 4; ++g4) { u32x2 pu, pw; pu.x = pk2(au[4 * g4], au[4 * g4 + 1]); pu.y = pk2(au[4 * g4 + 2], au[4 * g4 + 3]); pw.x = pk2(aw[4 * g4], aw[4 * g4 + 1]); pw.y = pk2(aw[4 * g4 + 2], aw[4 * g4 + 3]);
                    *(GAS u32x2*)(uT + (32 * wq + (lane & 31)) * 64 + 32 * it + 8 * g4 + 4 * (lane >> 5)) = pu;
                    *(GAS u32x2*)(wout + (32 * it + (lane & 31)) * 128 + 32 * wq + 8 * g4 + 4 * (lane >> 5)) = pw; } }
        }
        { int tt = tid; asm volatile("" : "+v"(tt)); const int d = tt >> 8, t2 = tt & 255; unsigned char* rec = GREC + rec_index(isctx, b, h, d, c) * REC_BYTES; const float gtot = GTOT[d];
#pragma unroll
            for (int e = 0; e < 4; ++e) { const int idx = t2 + 256 * e, i = idx >> 4, ch = idx & 15; const float sc = EGC[d * 64 + i];
                const u32x4 v = *(const LAS u32x4*)(QN + i * LD + ch * 8); const unsigned rw[4] = {v.x, v.y, v.z, v.w}; u32x4 o; unsigned ow[4];
#pragma unroll
                for (int q = 0; q < 4; ++q) ow[q] = pk2(bf2f(rw[q] & 0xffffu) * sc, bf2f(rw[q] >> 16) * sc);
                o.x = ow[0]; o.y = ow[1]; o.z = ow[2]; o.w = ow[3];
                *(GAS u32x4*)(rec + REC_QD + (i * 128 + ch * 8) * 2) = o; }
#pragma unroll
            for (int e = 0; e < 4; ++e) { const int idx = t2 + 256 * e, k = idx >> 3, ci = idx & 7; float o[8];
#pragma unroll
                for (int q = 0; q < 8; ++q) { const int i = 8 * ci + q; o[q] = bf2f(KN[i * LD + k]) * EKD[d * 64 + i]; }
                u32x4 w; w.x = pk2(o[0], o[1]); w.y = pk2(o[2], o[3]); w.z = pk2(o[4], o[5]); w.w = pk2(o[6], o[7]);
                *(GAS u32x4*)(rec + REC_KDT + (k * 64 + 8 * ci) * 2) = w; }
#pragma unroll
            for (int e = 0; e < 2; ++e) { const int idx = t2 + 256 * e, i = idx >> 3, cj = idx & 7;
                *(GAS u32x4*)(rec + REC_QK + (i * 64 + 8 * cj) * 2) = *(const LAS u32x4*)(QKB + (d * 64 + i) * LDT_ + 8 * cj); }
            if (t2 == 0) *(float*)(rec + REC_GT) = __expf(gtot);
        }
        CVT_HOOK_FINISH();
        LBAR();
        }
    }
    while (cs.left > 0) { cvt_issue(cj, cvt_next(cs, cvq, tid_f_ & 63), tid_f_ & 63, wg, wu, wd); cvt_finish(cj, tid_f_ & 63, WGU, WDN); }
#undef CVT_HOOK_ISSUE
#undef CVT_HOOK_FINISH
}

__device__ __forceinline__ void gdn_scan_unit(LAS unsigned char* L, int unit, const unsigned char* GREC, bf16_t* OF, bf16_t* OB) {
    int tid_o_ = threadIdx.x; asm volatile("" : "+v"(tid_o_)); const int tid = tid_o_, lane = tid & 63, wave = __builtin_amdgcn_readfirstlane(tid >> 6);
    constexpr int LD = 136, LDS_ = 72;
    LAS bf16_t* ST = (LAS bf16_t*)L;
    LAS bf16_t* Wl = (LAS bf16_t*)(L + 34816);
    LAS bf16_t* QDl = (LAS bf16_t*)(L + 52224);
    LAS bf16_t* KDTl = (LAS bf16_t*)(L + 69632);
    LAS bf16_t* QKl = (LAS bf16_t*)(L + 88064);
    LAS bf16_t* VNT = (LAS bf16_t*)(L + 97280);
    const int b = unit >> 4, h = (unit >> 1) & 7, d = unit & 1;
    bf16_t* O = d ? OB : OF;
    for (int i = tid; i < 128 * LD / 8; i += NTHREADS) *(LAS u32x4*)(ST + i * 8) = (u32x4){0u, 0u, 0u, 0u};
    f32x16 S0 = Z16, S1 = Z16;
    const int kt = wave >> 1, vt0 = 2 * (wave & 1);
    struct ScanOps { u32x4 rg[7]; u32x2 u[4]; float gt; };
    auto rec_of = [&](int s) -> const unsigned char* { const bool isctx = s < 4; const int cs = isctx ? s : s - 4; const int c = isctx ? (d ? 3 - cs : cs) : (d ? 63 - cs : cs);
        return GREC + rec_index(isctx, b, h, d, c) * REC_BYTES; };
    auto load_ops = [&](ScanOps& o, int s) { const unsigned char* rec = rec_of(s); const bool withq = s >= 4;
#pragma unroll
        for (int e = 0; e < 2; ++e) { const int idx = tid + 512 * e; o.rg[e] = *(const GAS u32x4*)(rec + REC_W + idx * 16); o.rg[4 + e] = *(const GAS u32x4*)(rec + REC_KDT + idx * 16); }
        if (withq) {
#pragma unroll
            for (int e = 0; e < 2; ++e) { const int idx = tid + 512 * e; o.rg[2 + e] = *(const GAS u32x4*)(rec + REC_QD + idx * 16); }
            o.rg[6] = *(const GAS u32x4*)(rec + REC_QK + tid * 16); }
        { const int it = wave >> 2, vt = wave & 3; const bf16_t* uT = (const bf16_t*)(rec + REC_UT) + (32 * vt + (lane & 31)) * 64 + 32 * it + 4 * (lane >> 5);
#pragma unroll
            for (int g4 = 0; g4 < 4; ++g4) o.u[g4] = *(const GAS u32x2*)(uT + 8 * g4); }
        o.gt = *(const float*)(rec + REC_GT);
    };
    auto step = [&](ScanOps& o, int s) {
        const bool isctx = s < 4;
#pragma unroll
        for (int e = 0; e < 2; ++e) { const int idx = tid + 512 * e; *(LAS u32x4*)(Wl + (idx >> 4) * LD + (idx & 15) * 8) = o.rg[e]; *(LAS u32x4*)(KDTl + (idx >> 3) * LDS_ + (idx & 7) * 8) = o.rg[4 + e]; }
        if (!isctx) {
#pragma unroll
            for (int e = 0; e < 2; ++e) { const int idx = tid + 512 * e; *(LAS u32x4*)(QDl + (idx >> 4) * LD + (idx & 15) * 8) = o.rg[2 + e]; }
            *(LAS u32x4*)(QKl + (tid >> 3) * LDS_ + (tid & 7) * 8) = o.rg[6]; }
        const float gt = o.gt; u32x2 uc[4];
#pragma unroll
        for (int g4 = 0; g4 < 4; ++g4) uc[g4] = o.u[g4];
        LBAR();
        if (s + 2 < 68) load_ops(o, s + 2);
        const int it = wave >> 2, vt = wave & 3;
        { bf16x8 fw[8], fs[8];
#pragma unroll
            for (int ks = 0; ks < 8; ++ks) { fw[ks] = frag_row(Wl, LD, 32 * it, 16 * ks, lane); fs[ks] = frag_row(ST, LD, 32 * vt, 16 * ks, lane); }
            __builtin_amdgcn_sched_barrier(0);
            f32x16 acc = Z16;
#pragma unroll
            for (int ks = 0; ks < 8; ++ks) acc = MFMA32(fw[ks], fs[ks], acc);
#pragma unroll
            for (int g4 = 0; g4 < 4; ++g4) { const u32x2 uu = uc[g4];
                const float v0 = bf2f(uu.x & 0xffffu) - acc[4 * g4], v1 = bf2f(uu.x >> 16) - acc[4 * g4 + 1], v2 = bf2f(uu.y & 0xffffu) - acc[4 * g4 + 2], v3 = bf2f(uu.y >> 16) - acc[4 * g4 + 3];
                u32x2 p; p.x = pk2(v0, v1); p.y = pk2(v2, v3);
                *(LAS u32x2*)(VNT + (32 * vt + (lane & 31)) * LDS_ + 32 * it + 8 * g4 + 4 * (lane >> 5)) = p; } }
        LBAR();
        bf16x8 fk[4], fv0[4], fv1[4];
#pragma unroll
        for (int ks = 0; ks < 4; ++ks) { fk[ks] = frag_row(KDTl, LDS_, 32 * kt, 16 * ks, lane); fv0[ks] = frag_row(VNT, LDS_, 32 * vt0, 16 * ks, lane); fv1[ks] = frag_row(VNT, LDS_, 32 * (vt0 + 1), 16 * ks, lane); }
        __builtin_amdgcn_sched_barrier(0);
        { S0 = S0 * gt; S1 = S1 * gt;
#pragma unroll
            for (int ks = 0; ks < 4; ++ks) { S0 = MFMA32(fk[ks], fv0[ks], S0); S1 = MFMA32(fk[ks], fv1[ks], S1); } }
        if (!isctx) { f32x16 acc = Z16;
            { bf16x8 fq[8], fs[8];
#pragma unroll
                for (int ks = 0; ks < 8; ++ks) { fs[ks] = frag_row(ST, LD, 32 * vt, 16 * ks, lane); fq[ks] = frag_row(QDl, LD, 32 * it, 16 * ks, lane); }
                __builtin_amdgcn_sched_barrier(0);
#pragma unroll
                for (int ks = 0; ks < 8; ++ks) acc = MFMA32(fs[ks], fq[ks], acc); }
            { bf16x8 fvn[4], fqk[4];
#pragma unroll
                for (int ks = 0; ks < 4; ++ks) { fvn[ks] = frag_row(VNT, LDS_, 32 * vt, 16 * ks, lane); fqk[ks] = frag_row(QKl, LDS_, 32 * it, 16 * ks, lane); }
                __builtin_amdgcn_sched_barrier(0);
#pragma unroll
                for (int ks = 0; ks < 4; ++ks) acc = MFMA32(fvn[ks], fqk[ks], acc); }
            const int cs = s - 4, c = d ? 63 - cs : cs;
            bf16_t* op = O + (size_t)(b * SEQ + c * 64 + 32 * it + (lane & 31)) * GDW + h * HD + 32 * vt + 4 * (lane >> 5);
#pragma unroll
            for (int g4 = 0; g4 < 4; ++g4) { u32x2 p; p.x = pk2(acc[4 * g4], acc[4 * g4 + 1]); p.y = pk2(acc[4 * g4 + 2], acc[4 * g4 + 3]); *(GAS u32x2*)(op + 8 * g4) = p; } }
        LBAR();
#pragma unroll
        for (int g4 = 0; g4 < 4; ++g4) { u32x2 p0, p1; p0.x = pk2(S0[4 * g4], S0[4 * g4 + 1]); p0.y = pk2(S0[4 * g4 + 2], S0[4 * g4 + 3]); p1.x = pk2(S1[4 * g4], S1[4 * g4 + 1]); p1.y = pk2(S1[4 * g4 + 2], S1[4 * g4 + 3]);
            *(LAS u32x2*)(ST + (32 * vt0 + (lane & 31)) * LD + 32 * kt + 8 * g4 + 4 * (lane >> 5)) = p0;
            *(LAS u32x2*)(ST + (32 * (vt0 + 1) + (lane & 31)) * LD + 32 * kt + 8 * g4 + 4 * (lane >> 5)) = p1; }
    };
    ScanOps A, B;
    load_ops(A, 0); load_ops(B, 1);
#pragma unroll 1
    for (int s = 0; s < 68; s += 2) { step(A, s); step(B, s + 1); }
    LBAR();
}

struct Args { const float* in[19]; float* out; unsigned char* ws; int ph_lo, ph_hi; };
enum { I_X = 0, I_C, I_CTX, I_CCTX, I_WMOD, I_BMOD, I_N1G, I_N2G, I_WIN, I_CONVW, I_ALOG, I_DTB, I_GNW, I_WOUT, I_WROUTER, I_WGATE, I_WUP, I_WDOWN, I_NORMF };

struct XposeItem { const float* src; int ldn, ncols, k0, n0; bf16_t* dst; int dstK; int mode; };
__device__ __forceinline__ int xpose_row(const XposeItem& it, int n) { return it.mode == 0 ? n : (256 * (n >> 7) + 128 * (it.mode - 1) + (n & 127)); }
__device__ __forceinline__ void xpose_load(const XposeItem& it, f32x4 (&r)[8], int tid) {
    const int n = it.n0 + 4 * (tid & 63);
#pragma unroll
    for (int j = 0; j < 8; ++j) { const int k = it.k0 + (tid >> 6) + 8 * j;
        if (n + 3 < it.ncols) r[j] = *(const GAS f32x4*)(it.src + (size_t)k * it.ldn + n);
        else { f32x4 v = {0.f, 0.f, 0.f, 0.f}; const float* p = it.src + (size_t)k * it.ldn; if (n < it.ncols) v.x = p[n]; if (n + 1 < it.ncols) v.y = p[n + 1]; if (n + 2 < it.ncols) v.z = p[n + 2]; r[j] = v; } }
}
__device__ __forceinline__ void xpose_store_lds(LAS float* T, const f32x4 (&r)[8], int tid) {
#pragma unroll
    for (int j = 0; j < 8; ++j) *(LAS f32x4*)(T + ((tid >> 6) + 8 * j) * 260 + 4 * (tid & 63)) = r[j];
}
__device__ __forceinline__ void xpose_emit(const XposeItem& it, const LAS float* T, int tid) {
    const int kc = tid & 7;
#pragma unroll
    for (int j = 0; j < 4; ++j) { const int nl = (tid >> 3) + 64 * j, n = it.n0 + nl;
        const LAS float* s = T + (8 * kc) * 260 + nl;
        u32x4 o; o.x = pk2(s[0], s[260]); o.y = pk2(s[2 * 260], s[3 * 260]); o.z = pk2(s[4 * 260], s[5 * 260]); o.w = pk2(s[6 * 260], s[7 * 260]);
        if (n < it.ncols) *(GAS u32x4*)(it.dst + (size_t)xpose_row(it, n) * it.dstK + it.k0 + 8 * kc) = o; }
}


__device__ __forceinline__ void moe_convert(LAS unsigned char* L, volatile LAS unsigned* MISC, unsigned* q, const float* wg, const float* wu, const float* wd, bf16_t* WGU, bf16_t* WDN, int maxpulls) {
    int tid_o_ = threadIdx.x; asm volatile("" : "+v"(tid_o_)); const int tid = tid_o_;
    __syncthreads();
    LAS float* T = (LAS float*)L;
    constexpr int NIT = 3 * 3072;
    auto mk = [&](int it) { XposeItem x; if (it < 6144) { const int up = it >= 3072, r0 = it - up * 3072, e = r0 / 192, r = r0 % 192; x.src = (up ? wu : wg) + (size_t)e * D_MODEL * FF; x.ldn = FF; x.ncols = FF; x.k0 = 64 * (r / 6); x.n0 = 256 * (r % 6);
            x.dst = WGU + (size_t)e * 2 * FF * D_MODEL; x.dstK = D_MODEL; x.mode = 1 + up; }
        else { const int r0 = it - 6144, e = r0 / 192, r = r0 % 192; x.src = wd + (size_t)e * FF * D_MODEL; x.ldn = D_MODEL; x.ncols = D_MODEL; x.k0 = 64 * (r / 8); x.n0 = 256 * (r % 8);
            x.dst = WDN + (size_t)e * D_MODEL * FF; x.dstK = FF; x.mode = 0; } return x; };
    f32x4 r[8];
    int pulls = 0;
    if (tid == 0) MISC[18] = maxpulls > 0 ? atomicAdd(q, 1u) : (unsigned)NIT;
    ++pulls;
    __syncthreads();
    int it = (int)MISC[18];
    if (it < NIT) { XposeItem x = mk(it); xpose_load(x, r, tid); }
    for (int qn = 0; it < NIT; ++qn) {
        XposeItem x = mk(it);
        xpose_store_lds(T, r, tid);
        if (tid == 0) MISC[19 + (qn & 1)] = pulls < maxpulls ? atomicAdd(q, 1u) : (unsigned)NIT;
        ++pulls;
        __syncthreads();
        const int nx = (int)MISC[19 + (qn & 1)];
        if (nx < NIT) { XposeItem y = mk(nx); xpose_load(y, r, tid); }
        xpose_emit(x, T, tid);
        __syncthreads();
        it = nx;
    }
}
struct SchedIn {
    const char* A; const char* B; int G, c;
    __device__ __forceinline__ bool next(int i, pg8::Unit& u) const {
        const int L = i * G + c; constexpr int NX = 64 * 21, NC = 4 * 13;
        if (L >= NX + NC) return false;
        int pm, pn;
        if (L < NX) { int wgid = L; { const int q = NX / 8, xcd = wgid % 8, off = wgid / 8; wgid = xcd * q + off; }
            const int nig = 8 * 21, gid = wgid / nig, fm = gid * 8; pm = fm + ((wgid % nig) % 8); pn = (wgid % nig) / 8; }
        else { const int r = L - NX; pm = 64 + r / 13; const int j = r % 13; pn = j < 12 ? 4 + j : 20; }
        u.pm = pm; u.pn = pn; u.aux = 0; u.gidx = nullptr;
        u.a = A + (size_t)pm * 256 * D_MODEL * 2; u.b = B + (size_t)pn * 256 * D_MODEL * 2; return true;
    }
};

struct EpiIn {
    static constexpr bool PERM = true;
    bf16_t* pf; bf16_t* pqkv; bf16_t* pz; float* pab;
    __device__ __forceinline__ void operator()(const f32x4 (&acc)[2][2][4][2], const pg8::Unit& u, int wr, int wc, int fr, int fq) const {
        const int row0 = u.pm * 256 + wr * 64 + fr; const int pn = u.pn;
        if (pn == 20) {
            if (wc == 0) {
#pragma unroll
                for (int ai = 0; ai < 2; ++ai)
#pragma unroll
                    for (int m = 0; m < 4; ++m) { float* rp = pab + (size_t)(row0 + ai * 128 + m * 16) * 32 + 8 * fq;
                        *(GAS f32x4*)rp = acc[ai][0][m][0]; *(GAS f32x4*)(rp + 4) = acc[ai][0][m][1]; }
            }
            return;
        }
        bf16_t* base; int ld, c0;
        if (pn < 4) { base = pf; ld = FW; c0 = pn * 256; } else if (pn < 16) { base = pqkv; ld = 3 * GDW; c0 = (pn - 4) * 256; } else { base = pz; ld = GDW; c0 = (pn - 16) * 256; }
        const int col0 = c0 + wc * 32 + 8 * fq;
#pragma unroll
        for (int ai = 0; ai < 2; ++ai)
#pragma unroll
            for (int m = 0; m < 4; ++m) { bf16_t* rowp = base + (size_t)(row0 + ai * 128 + m * 16) * ld + col0;
#pragma unroll
                for (int bj = 0; bj < 2; ++bj) { const f32x4 v0 = acc[ai][bj][m][0], v1 = acc[ai][bj][m][1];
                    u32x4 w; w.x = pk2(v0[0], v0[1]); w.y = pk2(v0[2], v0[3]); w.z = pk2(v1[0], v1[1]); w.w = pk2(v1[2], v1[3]);
                    *(GAS u32x4*)(rowp + bj * 128) = w; } }
    }
};

struct SchedOut {
    const char* A; const char* B; int G, c;
    __device__ __forceinline__ bool next(int i, pg8::Unit& u) const {
        const int Lq = i * G + c; constexpr int NU = 64 * 8;
        if (Lq >= NU) return false;
        int wgid = Lq; { const int q = NU / 8, xcd = wgid % 8, off = wgid / 8; wgid = xcd * q + off; }
        const int nig = 8 * 8, gid = wgid / nig, fm = gid * 8; const int pm = fm + ((wgid % nig) % 8), pn = (wgid % nig) / 8;
        u.pm = pm; u.pn = pn; u.aux = 0; u.gidx = nullptr;
        u.a = A + (size_t)pm * 256 * D_MODEL * 2; u.b = B + (size_t)pn * 256 * D_MODEL * 2; return true;
    }
};

struct EpiOut {
    static constexpr bool PERM = true;
    const float* x; const float* mod; bf16_t* x2;
    __device__ __forceinline__ void operator()(const f32x4 (&acc)[2][2][4][2], const pg8::Unit& u, int wr, int wc, int fr, int fq) const {
        const int row0 = u.pm * 256 + wr * 64 + fr, col0 = u.pn * 256 + wc * 32 + 8 * fq;
        const float* gt = mod + (u.pm >> 4) * 12288 + 2 * 2048;
        f32x4 gv[2][2];
#pragma unroll
        for (int bj = 0; bj < 2; ++bj)
#pragma unroll
            for (int n = 0; n < 2; ++n) gv[bj][n] = *(const GAS f32x4*)(gt + col0 + bj * 128 + n * 4);
#pragma unroll
        for (int ai = 0; ai < 2; ++ai)
#pragma unroll
            for (int m = 0; m < 4; ++m) { const size_t off = (size_t)(row0 + ai * 128 + m * 16) * D_MODEL + col0;
#pragma unroll
                for (int bj = 0; bj < 2; ++bj) { const f32x4 x0 = *(const GAS f32x4*)(x + off + bj * 128), x1 = *(const GAS f32x4*)(x + off + bj * 128 + 4);
                    const f32x4 y0 = x0 + gv[bj][0] * acc[ai][bj][m][0], y1 = x1 + gv[bj][1] * acc[ai][bj][m][1];
                    u32x4 w; w.x = pk2(y0[0], y0[1]); w.y = pk2(y0[2], y0[3]); w.z = pk2(y1[0], y1[1]); w.w = pk2(y1[2], y1[3]);
                    *(GAS u32x4*)(x2 + off + bj * 128) = w; } }
    }
};


struct SchedGU {
    const char* HX2; const char* W; const int* IDX; int G, c;
    __device__ __forceinline__ bool next(int i, pg8::Unit& u) const {
        const int L = i * G + c; if (L >= 1536) return false;
        int wt, rt;
        if (G == 256) { const int xcd = c & 7, j = c >> 3; wt = (i * 8 + xcd) * 4 + (j >> 3); rt = j & 7; } else { wt = L >> 3; rt = L & 7; }
        const int e = wt / 12, pn = wt % 12, b = rt >> 1, mt = rt & 1;
        u.pm = (b * NE + e) * 2 + mt; u.pn = pn; u.aux = 0;
        u.a = HX2 + (size_t)b * SEQ * D_MODEL * 2; u.gidx = IDX + (b * NE + e) * CAP + mt * 256;
        u.b = W + ((size_t)e * 2 * FF + (size_t)pn * 256) * D_MODEL * 2; return true;
    }
};
struct EpiGU {
    static constexpr bool PERM = true;
    bf16_t* hid;
    __device__ __forceinline__ void operator()(const f32x4 (&acc)[2][2][4][2], const pg8::Unit& u, int wr, int wc, int fr, int fq) const {
        const int row0 = u.pm * 256 + wr * 64 + fr, col0 = u.pn * 128 + wc * 32 + 8 * fq;
#pragma unroll
        for (int ai = 0; ai < 2; ++ai)
#pragma unroll
            for (int m = 0; m < 4; ++m) { const f32x4 g0 = acc[ai][0][m][0], g1 = acc[ai][0][m][1], u0 = acc[ai][1][m][0], u1 = acc[ai][1][m][1];
                u32x4 w; w.x = pk2(silu_f(g0[0]) * u0[0], silu_f(g0[1]) * u0[1]); w.y = pk2(silu_f(g0[2]) * u0[2], silu_f(g0[3]) * u0[3]);
                w.z = pk2(silu_f(g1[0]) * u1[0], silu_f(g1[1]) * u1[1]); w.w = pk2(silu_f(g1[2]) * u1[2], silu_f(g1[3]) * u1[3]);
                *(GAS u32x4*)(hid + (size_t)(row0 + ai * 128 + m * 16) * FF + col0) = w; }
    }
};
struct SchedDN {
    const char* HID; const char* W; int G, c;
    __device__ __forceinline__ bool next(int i, pg8::Unit& u) const {
        const int L = i * G + c; if (L >= 1024) return false;
        int wt, rt;
        if (G == 256) { const int xcd = c & 7, j = c >> 3; wt = (i * 8 + xcd) * 4 + (j >> 3); rt = j & 7; } else { wt = L >> 3; rt = L & 7; }
        const int e = wt >> 3, pn = wt & 7, b = rt >> 1, mt = rt & 1;
        u.pm = (b * NE + e) * 2 + mt; u.pn = pn; u.aux = 0; u.gidx = nullptr;
        u.a = HID + (size_t)u.pm * 256 * FF * 2; u.b = W + ((size_t)e * D_MODEL + (size_t)pn * 256) * FF * 2; return true;
    }
};
struct EpiDN {
    static constexpr bool PERM = true;
    bf16_t* yb; const float* val;
    __device__ __forceinline__ void operator()(const f32x4 (&acc)[2][2][4][2], const pg8::Unit& u, int wr, int wc, int fr, int fq) const {
        const int row0 = u.pm * 256 + wr * 64 + fr, col0 = u.pn * 256 + wc * 32 + 8 * fq;
#pragma unroll
        for (int ai = 0; ai < 2; ++ai)
#pragma unroll
            for (int m = 0; m < 4; ++m) { const int row = row0 + ai * 128 + m * 16; const float vv = val[row]; bf16_t* rowp = yb + (size_t)row * D_MODEL + col0;
#pragma unroll
                for (int bj = 0; bj < 2; ++bj) { const f32x4 v0 = acc[ai][bj][m][0] * vv, v1 = acc[ai][bj][m][1] * vv;
                    u32x4 w; w.x = pk2(v0[0], v0[1]); w.y = pk2(v0[2], v0[3]); w.z = pk2(v1[0], v1[1]); w.w = pk2(v1[2], v1[3]);
                    *(GAS u32x4*)(rowp + bj * 128) = w; } }
    }
};

__device__ __forceinline__ unsigned block_excl_scan(unsigned v, LAS unsigned* scr, int tid, int lane, int wave, unsigned& total) {
    unsigned s = v;
#pragma unroll
    for (int o = 1; o < 64; o <<= 1) { const unsigned t = __shfl_up(s, o); if (lane >= o) s += t; }
    if (lane == 63) scr[wave] = s;
    __syncthreads();
    unsigned base = 0, tot = 0;
#pragma unroll
    for (int w = 0; w < NWAVES; ++w) { const unsigned x = scr[w]; if (w < wave) base += x; tot += x; }
    __syncthreads();
    total = tot; return base + s - v;
}
__device__ __forceinline__ void topk_unit(LAS unsigned char* L, int unit, const float* AFF, int* IDX, float* VAL, int* SLOT) {
    int tid_o_ = threadIdx.x; asm volatile("" : "+v"(tid_o_)); const int tid = tid_o_, lane = tid & 63, wave = __builtin_amdgcn_readfirstlane(tid >> 6);
    LAS unsigned* HIST = (LAS unsigned*)L; LAS unsigned* SH = HIST + 256; LAS unsigned* SCR = SH + 8;
    const int b = unit >> 4, e = unit & 15;
    unsigned key[8];
    { const u32x4 k0 = *(const GAS u32x4*)(AFF + (size_t)unit * SEQ + tid * 8), k1 = *(const GAS u32x4*)(AFF + (size_t)unit * SEQ + tid * 8 + 4);
        key[0] = k0.x; key[1] = k0.y; key[2] = k0.z; key[3] = k0.w; key[4] = k1.x; key[5] = k1.y; key[6] = k1.z; key[7] = k1.w; }
    unsigned prefix = 0;
#pragma unroll 1
    for (int bit = 31; bit >= 0; --bit) { const unsigned cand = prefix | (1u << bit); unsigned c = 0;
#pragma unroll
        for (int q = 0; q < 8; ++q) c += (unsigned)__popcll(__ballot(key[q] >= cand));
        if (lane == 0) HIST[(bit & 1) * 8 + wave] = c;
        __syncthreads();
        unsigned tot = 0;
#pragma unroll
        for (int w = 0; w < NWAVES; ++w) tot += HIST[(bit & 1) * 8 + w];
        if (tot >= (unsigned)CAP) prefix = cand; }
    unsigned gtc = 0;
#pragma unroll
    for (int q = 0; q < 8; ++q) gtc += (key[q] > prefix) ? 1u : 0u;
    unsigned gtot_; (void)block_excl_scan(gtc, SCR, tid, lane, wave, gtot_);
    const unsigned need = (unsigned)CAP - gtot_;
    const unsigned T = prefix;
    unsigned eq = 0;
#pragma unroll
    for (int q = 0; q < 8; ++q) eq += (key[q] == T) ? 1u : 0u;
    unsigned tot; unsigned eqbase = block_excl_scan(eq, SCR, tid, lane, wave, tot);
    unsigned selmask = 0, cnt = 0;
#pragma unroll
    for (int q = 0; q < 8; ++q) { bool sel = key[q] > T; if (key[q] == T) { sel = eqbase < need; ++eqbase; } if (sel) { selmask |= 1u << q; ++cnt; } }
    unsigned slot = block_excl_scan(cnt, SCR, tid, lane, wave, tot);
#pragma unroll
    for (int q = 0; q < 8; ++q) { const int t = tid * 8 + q; int sl = -1;
        if (selmask & (1u << q)) { sl = (int)slot; ++slot; if (sl < CAP) { IDX[unit * CAP + sl] = t; VAL[unit * CAP + sl] = __uint_as_float(key[q]); } else sl = -1; }
        SLOT[((size_t)b * SEQ + t) * NE + e] = sl; }
    __syncthreads();
}
__global__ void __launch_bounds__(NTHREADS, 2) fwd_kernel(Args args) {
    extern __shared__ __attribute__((aligned(16))) unsigned char lds_raw[];
    LAS unsigned char* L = (LAS unsigned char*)lds_raw;
    volatile LAS unsigned* MISC = (volatile LAS unsigned*)(L + MISC_OFF);
    LAS unsigned* TAB = (LAS unsigned*)(L + TAB_OFF);
    const int tid = threadIdx.x, lane = tid & 63, wave = __builtin_amdgcn_readfirstlane(tid >> 6);
    const int G = gridDim.x, bid = blockIdx.x;
    if (tid < 64) MISC[tid] = 0u;
    __syncthreads();
    unsigned char* ws = args.ws;
    unsigned* ctl = (unsigned*)(ws + WS_CTL);
    XcdBarrier bar = xcd_barrier_post(ctl + CW_BAR, MISC + 8);
    const int gw = bid * NWAVES + wave, NGW = G * NWAVES;
    const int lo = args.ph_lo, hi = args.ph_hi;
#define IN(k) (lo <= (k) && (k) < hi)
#ifndef REPMASK
#define REPMASK 0
#endif
#define PH(k) for (int rp_ = 0; rp_ <= ((REPMASK >> (k)) & 1); ++rp_) if (IN(k))
#define RPB do { if (rp_) xcd_barrier(bar); } while (0)
#define OPQ_IDS int tid_o_ = threadIdx.x; asm volatile("" : "+v"(tid_o_)); const int tid = tid_o_, lane = tid & 63; (void)tid; (void)lane
#ifndef REPSUB
#define REPSUB 0
#endif
#define RS(k) for (int rs_ = 0; rs_ <= ((REPSUB >> (k)) & 1); ++rs_)
#ifdef TPROBE_A
    unsigned long long* TSB = (unsigned long long*)(ws + WS_CTL + 512 * 1024);
#define STAMP(k) do { if (bid == 0 && tid == 0) TSB[k] = __builtin_amdgcn_s_memrealtime(); } while (0)
#else
#define STAMP(k) do { } while (0)
#endif
#define SEAM(k) do { if (IN(k) && IN((k) + 1)) xcd_barrier(bar); STAMP((k) + 1); } while (0)
    STAMP(0);

    float* MOD = (float*)(ws + WS_MOD);
    float* TW = (float*)(ws + WS_TW);
    bf16_t* DA = (bf16_t*)(ws + WS_DA); bf16_t* DB = (bf16_t*)(ws + WS_DB); bf16_t* DC = (bf16_t*)(ws + WS_DC);
    bf16_t* WIN = (bf16_t*)(ws + WS_WIN); bf16_t* WOUT = (bf16_t*)(ws + WS_WOUT);
    bf16_t* PF = (bf16_t*)(ws + WS_PF); bf16_t* PQKV = (bf16_t*)(ws + WS_PQKV); bf16_t* PZ = (bf16_t*)(ws + WS_PZ); float* PAB = (float*)(ws + WS_PAB);
    bf16_t* A2 = (bf16_t*)(ws + WS_A2);
    bf16_t* OF = (bf16_t*)(ws + WS_A2 + (size_t)MTOK * D_MODEL * 2); bf16_t* OB = OF + (size_t)MTOK * GDW;
    bf16_t* HX = (bf16_t*)args.out;
    bf16_t* YB = (bf16_t*)args.out;
    bf16_t* X2B = (bf16_t*)(ws + WS_A2 + (size_t)MTOK * D_MODEL * 2);

    PH(0) { RPB; OPQ_IDS;
        if (bid < 192) {
            LAS float* SC = (LAS float*)L;
            LAS float* RED = (LAS float*)(L + 5 * 2048 * 4);
            for (int i = tid; i < 5 * 2048; i += NTHREADS) { const int r = i >> 11, k = i & 2047; const float v = r < 4 ? args.in[I_C][r * 2048 + k] : args.in[I_CCTX][k]; SC[i] = silu_f(v); }
            __syncthreads();
            for (int s = bid; s < 192; s += G) {
                const int cg = lane & 15, ksub = lane >> 4;
                const float* wp = args.in[I_WMOD] + (size_t)(wave * 256 + ksub) * 12288 + s * 64 + cg * 4;
                f32x4 a0 = {0.f, 0.f, 0.f, 0.f}, a1 = a0, a2 = a0, a3 = a0, a4 = a0;
                for (int k = 0; k < 256; k += 32) {
                    f32x4 wv[8];
#pragma unroll
                    for (int j = 0; j < 8; ++j) wv[j] = *(const GAS f32x4*)(wp + (size_t)(k + 4 * j) * 12288);
#pragma unroll
                    for (int j = 0; j < 8; ++j) { const int kk = wave * 256 + k + 4 * j + ksub;
                        a0 += wv[j] * SC[kk]; a1 += wv[j] * SC[2048 + kk]; a2 += wv[j] * SC[4096 + kk]; a3 += wv[j] * SC[6144 + kk]; a4 += wv[j] * SC[8192 + kk]; }
                }
                LAS float* rp = RED + ((wave * 4 + ksub) * 5) * 64 + cg * 4;
                *(LAS f32x4*)(rp) = a0; *(LAS f32x4*)(rp + 64) = a1; *(LAS f32x4*)(rp + 128) = a2; *(LAS f32x4*)(rp + 192) = a3; *(LAS f32x4*)(rp + 256) = a4;
                __syncthreads();
                if (tid < 320) { const int r = tid >> 6, c = tid & 63; float v = 0.f;
#pragma unroll
                    for (int w = 0; w < 32; ++w) v += RED[(w * 5 + r) * 64 + c];
                    MOD[r * 12288 + s * 64 + c] = v + args.in[I_BMOD][s * 64 + c]; }
                __syncthreads();
            }
        }
        if (bid == G - 1) {
            for (int i = tid; i < 4096; i += NTHREADS) { float s, c; sincosf(6.283185307179586f * (float)i / 4096.f, &s, &c); TW[2 * i] = c; TW[2 * i + 1] = s; }
            for (int i = tid; i < 128 * 64; i += NTHREADS) { const int r = i >> 6, n1 = i & 63, a = r & 63; const int m = (a * n1) & 63; float s, c; sincosf(6.283185307179586f * (float)m / 64.f, &s, &c);
                DA[i] = (bf16_t)f2bf(r < 64 ? c : -s); }
        }
        if (bid == G - 2) {
            for (int i = tid; i < 128 * 128; i += NTHREADS) { const int r = i >> 7, rho = i & 127, k2 = r & 63, n2 = rho >> 1, ri = rho & 1; const int m = (k2 * n2) & 63; float s, c; sincosf(6.283185307179586f * (float)m / 64.f, &s, &c);
                const float v = r < 64 ? (ri == 0 ? c : s) : (ri == 0 ? -s : c); DB[i] = (bf16_t)f2bf(v); }
        }
        if (bid == G - 3) {
            const float scale = 0.0013810679320049757f;
            for (int i = tid; i < 128 * 256; i += NTHREADS) { const int cp = i >> 8, kap = i & 255, ri = kap >> 7, c = kap & 127; const int m = (c * cp) & 127; float s, co; sincosf(6.283185307179586f * (float)m / 128.f, &s, &co);
                DC[i] = (bf16_t)f2bf((ri == 0 ? co : s) * scale); }
        }
        for (size_t i = (size_t)bid * NTHREADS + tid; i < (size_t)(INC_PAD - INC) * D_MODEL / 8; i += (size_t)G * NTHREADS) *(GAS u32x4*)(WIN + (size_t)INC * D_MODEL + i * 8) = (u32x4){0u, 0u, 0u, 0u};
        {
            __syncthreads();
            LAS float* T = (LAS float*)L;
            constexpr int N_IN = 32 * 21, N_OUT = 32 * 8, NIT = N_IN + N_OUT;
            auto mk = [&](int it) { XposeItem x; if (it < N_IN) { x.src = args.in[I_WIN]; x.ldn = INC; x.ncols = INC; x.k0 = 64 * (it / 21); x.n0 = 256 * (it % 21); x.dst = WIN; x.dstK = D_MODEL; x.mode = 0; }
                else { const int r = it - N_IN; x.src = args.in[I_WOUT]; x.ldn = D_MODEL; x.ncols = D_MODEL; x.k0 = 64 * (r / 8); x.n0 = 256 * (r % 8); x.dst = WOUT; x.dstK = D_MODEL; x.mode = 0; } return x; };
            f32x4 r[8];
            if (tid == 0) MISC[18] = atomicAdd(ctl + CW_Q0, 1u);
            __syncthreads();
            int it = (int)MISC[18];
            if (it < NIT) { XposeItem x = mk(it); xpose_load(x, r, tid); }
            for (int qn = 0; it < NIT; ++qn) {
                XposeItem x = mk(it);
                xpose_store_lds(T, r, tid);
                if (tid == 0) MISC[19 + (qn & 1)] = atomicAdd(ctl + CW_Q0, 1u);
                __syncthreads();
                const int nx = (int)MISC[19 + (qn & 1)];
                if (nx < NIT) { XposeItem y = mk(nx); xpose_load(y, r, tid); }
                xpose_emit(x, T, tid);
                __syncthreads();
                it = nx;
            }
        }
    }
    SEAM(0);

    PH(1) { RPB; OPQ_IDS;
        const float* g1 = args.in[I_N1G];
        f32x4 ca[8], cb[8]; int curmr = -1;
        const int PW = (MTOK / 2 + NGW - 1) / NGW;
        for (int k = 0; k < PW; ++k) {
            const int p = gw * PW + k;
            if (p >= MTOK / 2) continue;
            const int m0 = 2 * p; const int mr = m0 < MTOK ? (m0 >> 12) : 4;
            if (mr != curmr) { curmr = mr; const float* sh = MOD + mr * 12288; const float* sc = sh + 2048;
#pragma unroll
                for (int j = 0; j < 8; ++j) { const f32x4 gg = *((const GAS f32x4*)g1 + lane + 64 * j), s1 = *((const GAS f32x4*)sc + lane + 64 * j); ca[j] = gg * (s1 + 1.f); cb[j] = *((const GAS f32x4*)sh + lane + 64 * j); } }
            const float* src = m0 < MTOK ? args.in[I_X] + (size_t)m0 * D_MODEL : args.in[I_CTX] + (size_t)(m0 - MTOK) * D_MODEL;
            f32x4 v0[8], v1[8]; float s0 = 0.f, s1_ = 0.f;
#pragma unroll
            for (int j = 0; j < 8; ++j) { v0[j] = *((const GAS f32x4*)src + lane + 64 * j); v1[j] = *((const GAS f32x4*)(src + D_MODEL) + lane + 64 * j); }
#pragma unroll
            for (int j = 0; j < 8; ++j) { s0 += (v0[j].x * v0[j].x + v0[j].y * v0[j].y) + (v0[j].z * v0[j].z + v0[j].w * v0[j].w); s1_ += (v1[j].x * v1[j].x + v1[j].y * v1[j].y) + (v1[j].z * v1[j].z + v1[j].w * v1[j].w); }
#pragma unroll
            for (int o = 1; o < 64; o <<= 1) { s0 += __shfl_xor(s0, o); s1_ += __shfl_xor(s1_, o); }
            const float r0 = __builtin_amdgcn_rsqf(s0 * (1.f / D_MODEL) + EPS), r1 = __builtin_amdgcn_rsqf(s1_ * (1.f / D_MODEL) + EPS);
            GAS u32x2* o0 = (GAS u32x2*)(HX + (size_t)m0 * D_MODEL) + lane; GAS u32x2* o1 = o0 + D_MODEL / 4;
#pragma unroll
            for (int j = 0; j < 8; ++j) { const f32x4 y0 = v0[j] * r0 * ca[j] + cb[j], y1 = v1[j] * r1 * ca[j] + cb[j];
                u32x2 w; w.x = pk2(y0.x, y0.y); w.y = pk2(y0.z, y0.w); o0[64 * j] = w; w.x = pk2(y1.x, y1.y); w.y = pk2(y1.z, y1.w); o1[64 * j] = w; }
        }
        for (int r = gw >> 1; (gw & 1) == 0 && r < MCTX; r += NGW / 2) {
            const float* sh = MOD + 4 * 12288; const float* sc = sh + 2048; const float* src = args.in[I_CTX] + (size_t)r * D_MODEL;
            f32x4 v0[8]; float s0 = 0.f;
#pragma unroll
            for (int j = 0; j < 8; ++j) { v0[j] = *((const GAS f32x4*)src + lane + 64 * j); s0 += (v0[j].x * v0[j].x + v0[j].y * v0[j].y) + (v0[j].z * v0[j].z + v0[j].w * v0[j].w); }
            const float r0 = __builtin_amdgcn_rsqf(wave_sum(s0) * (1.f / D_MODEL) + EPS);
            GAS u32x2* o0 = (GAS u32x2*)(HX + (size_t)(MTOK + r) * D_MODEL) + lane;
#pragma unroll
            for (int j = 0; j < 8; ++j) { const f32x4 gg = *((const GAS f32x4*)g1 + lane + 64 * j), s1 = *((const GAS f32x4*)sc + lane + 64 * j), h1 = *((const GAS f32x4*)sh + lane + 64 * j);
                const f32x4 y0 = v0[j] * r0 * gg * (s1 + 1.f) + h1; u32x2 w; w.x = pk2(y0.x, y0.y); w.y = pk2(y0.z, y0.w); o0[64 * j] = w; }
        }
    }
    SEAM(1);

    PH(2) { RPB; OPQ_IDS;
        SchedIn S{(const char*)HX, (const char*)WIN, G, bid};
        EpiIn E{PF, PQKV, PZ, PAB};
        pg8::gemm_phase<EpiIn, SchedIn, false>(L, TAB, D_MODEL, S, E);
        { constexpr int NU = 64 * 21 + 4 * 13; const int mine = (NU - bid + G - 1) / G, most = (NU + G - 1) / G;
            if (mine < most) moe_convert(L, MISC, ctl + CW_Q2, args.in[I_WGATE], args.in[I_WUP], args.in[I_WDOWN], (bf16_t*)(ws + WS_WGU), (bf16_t*)(ws + WS_WDN), 11 * (most - mine)); }
    }
    SEAM(2);

    PH(3) { RPB; OPQ_IDS;
        RS(0) gdn_chunk_items(L, bid, G, PQKV, PAB, args.in[I_CONVW], args.in[I_ALOG], args.in[I_DTB], ws + WS_G, ctl + CW_Q2, args.in[I_WGATE], args.in[I_WUP], args.in[I_WDOWN], (bf16_t*)(ws + WS_WGU), (bf16_t*)(ws + WS_WDN));
        __syncthreads();
        constexpr int LDF = 136, LDA_ = 72, LDO = 136;
        LAS bf16_t* DAl = (LAS bf16_t*)L;
        LAS bf16_t* Fi = (LAS bf16_t*)(L + 128 * LDA_ * 2);
        LAS bf16_t* Oi = (LAS bf16_t*)(L + 128 * LDA_ * 2 + 64 * LDF * 2);
        for (int i = tid; i < 128 * 64; i += NTHREADS) DAl[(i >> 6) * LDA_ + (i & 63)] = DA[i];
        LBAR();
        RS(1) for (int it = bid; it < BATCH * 64 * 8; it += G) {
            const int g = it & 7, n2 = (it >> 3) & 63, b = it >> 9;
#pragma unroll
            for (int j = 0; j < 2; ++j) { const int idx = tid + 512 * j, row = idx >> 4, ch = idx & 15;
                const u32x4 v = *(const GAS u32x4*)(PF + (size_t)(b * SEQ + 64 * row + n2) * FW + g * 128 + ch * 8);
                *(LAS u32x4*)(Fi + row * LDF + ch * 8) = v; }
            LBAR();
            const int ct = wave & 3, kt = wave >> 2;
            f32x16 are = Z16, aim = Z16;
            { bf16x8 fb_[4], fr_[4], fi_[4];
#pragma unroll
                for (int ks = 0; ks < 4; ++ks) { fb_[ks] = frag_tr(Fi, LDF, 32 * ct, 16 * ks, lane); fr_[ks] = frag_row(DAl, LDA_, 32 * kt, 16 * ks, lane); fi_[ks] = frag_row(DAl, LDA_, 64 + 32 * kt, 16 * ks, lane); }
                __builtin_amdgcn_sched_barrier(0);
#pragma unroll
                for (int ks = 0; ks < 4; ++ks) { are = MFMA32(fr_[ks], fb_[ks], are); aim = MFMA32(fi_[ks], fb_[ks], aim); } }
#pragma unroll
            for (int r = 0; r < 16; ++r) { const int k1 = 32 * kt + crow(r, lane); const int m = (n2 * k1) & 4095; const float c = TW[2 * m], s = TW[2 * m + 1];
                const float re = are[r] * c + aim[r] * s, im = aim[r] * c - are[r] * s;
                Oi[k1 * LDO + 32 * ct + (lane & 31)] = (bf16_t)f2bf(re); Oi[(64 + k1) * LDO + 32 * ct + (lane & 31)] = (bf16_t)f2bf(im); }
            LBAR();
#pragma unroll
            for (int j = 0; j < 4; ++j) { const int idx = tid + 512 * j, row = idx >> 4, ch = idx & 15, ri = row >> 6, k1 = row & 63;
                const u32x4 v = *(const LAS u32x4*)(Oi + row * LDO + ch * 8);
                *(GAS u32x4*)(YB + ((size_t)((b * 64 + k1) * 64 + n2) * 2 + ri) * FW + g * 128 + ch * 8) = v; }
        }
    }
    if (IN(3)) { constexpr int NI = BATCH * NH * 64 + BATCH * NH * 4; const int mine = (NI - bid + G - 1) / G, most = (NI + G - 1) / G;
        if (mine < most) moe_convert(L, MISC, ctl + CW_Q2, args.in[I_WGATE], args.in[I_WUP], args.in[I_WDOWN], (bf16_t*)(ws + WS_WGU), (bf16_t*)(ws + WS_WDN), 4 * (most - mine)); }
    SEAM(3);

    PH(4) { RPB; OPQ_IDS;
    if (bid < 64) {
        RS(2) for (int u = bid; u < 64; u += G) gdn_scan_unit(L, u, ws + WS_G, OF, OB);
    }
    if (bid >= 64) {
        constexpr int LDB_ = 136, LDT = 136, LDZ = 264, LDO2 = 136;
        LAS bf16_t* DBl = (LAS bf16_t*)L;
        LAS bf16_t* DCl = (LAS bf16_t*)(L + 34816);
        LAS bf16_t* W0 = (LAS bf16_t*)(L + 34816 + 65536);
        for (int i = tid; i < 128 * 128; i += NTHREADS) DBl[(i >> 7) * LDB_ + (i & 127)] = DB[i];
        for (int i = tid; i < 128 * 32; i += NTHREADS) { const int row = i >> 5, ch = i & 31; *(LAS u32x4*)(DCl + row * 256 + ((ch ^ (row & 15)) * 8)) = *(const GAS u32x4*)(DC + row * 256 + ch * 8); }
        LBAR();
        for (int qn = 0;; ++qn) {
            if (tid == 0) MISC[16 + (qn & 1)] = atomicAdd(ctl + CW_Q1, 1u);
            LBAR();
            const int it = (int)MISC[16 + (qn & 1)];
            if (it >= BATCH * 64 * 8) break;
            const int g = it & 7, k1 = (it >> 3) & 63, b = it >> 9;
#pragma unroll
            for (int j = 0; j < 4; ++j) { const int idx = tid + 512 * j, row = idx >> 4, ch = idx & 15;
                const u32x4 v = *(const GAS u32x4*)(YB + ((size_t)(b * 64 + k1) * 128 + row) * FW + g * 128 + ch * 8);
                *(LAS u32x4*)(W0 + row * LDT + ch * 8) = v; }
            LBAR();
            const int ct = wave & 3, kt = wave >> 2;
            f32x16 zre = Z16, zim = Z16;
#pragma unroll
            for (int kh = 0; kh < 2; ++kh) { bf16x8 fb_[4], fr_[4], fi_[4];
#pragma unroll
                for (int k4 = 0; k4 < 4; ++k4) { const int ks = 4 * kh + k4; fb_[k4] = frag_tr(W0, LDT, 32 * ct, 16 * ks, lane); fr_[k4] = frag_row(DBl, LDB_, 32 * kt, 16 * ks, lane); fi_[k4] = frag_row(DBl, LDB_, 64 + 32 * kt, 16 * ks, lane); }
                __builtin_amdgcn_sched_barrier(0);
#pragma unroll
                for (int k4 = 0; k4 < 4; ++k4) { zre = MFMA32(fr_[k4], fb_[k4], zre); zim = MFMA32(fi_[k4], fb_[k4], zim); }
                __builtin_amdgcn_sched_barrier(0); }
            LBAR();
#pragma unroll
            for (int r = 0; r < 16; ++r) { const int k2 = 32 * kt + crow(r, lane); const int c = 32 * ct + (lane & 31);
                W0[k2 * LDZ + c] = (bf16_t)f2bf(zre[r]); W0[k2 * LDZ + 128 + c] = (bf16_t)f2bf(zim[r]); }
            LBAR();
            f32x16 yo = Z16;
            { const int mt = wave >> 2, nt2 = wave & 3; const int rowc = 32 * nt2 + (lane & 31);
#pragma unroll
                for (int kq = 0; kq < 2; ++kq) { bf16x8 fa_[8], fb_[8];
#pragma unroll
                    for (int k8 = 0; k8 < 8; ++k8) { const int ks = 8 * kq + k8, chunk = 2 * ks + (lane >> 5);
                        fb_[k8] = *(const LAS bf16x8*)(DCl + rowc * 256 + ((chunk ^ (rowc & 15)) * 8)); fa_[k8] = frag_row(W0, LDZ, 32 * mt, 16 * ks, lane); }
                    __builtin_amdgcn_sched_barrier(0);
#pragma unroll
                    for (int k8 = 0; k8 < 8; ++k8) yo = MFMA32(fa_[k8], fb_[k8], yo);
                    __builtin_amdgcn_sched_barrier(0); } }
            LBAR();
            { const int mt = wave >> 2, nt2 = wave & 3;
#pragma unroll
                for (int r = 0; r < 16; ++r) W0[(32 * mt + crow(r, lane)) * LDO2 + 32 * nt2 + (lane & 31)] = (bf16_t)f2bf(yo[r]); }
            LBAR();
#pragma unroll
            for (int j = 0; j < 2; ++j) { const int idx = tid + 512 * j, k2 = idx >> 4, ch = idx & 15;
                *(GAS u32x4*)(A2 + (size_t)(b * SEQ + k1 + 64 * k2) * D_MODEL + g * 128 + ch * 8) = *(const LAS u32x4*)(W0 + k2 * LDO2 + ch * 8); }
            LBAR();
        }
    }
    moe_convert(L, MISC, ctl + CW_Q2, args.in[I_WGATE], args.in[I_WUP], args.in[I_WDOWN], (bf16_t*)(ws + WS_WGU), (bf16_t*)(ws + WS_WDN), 1 << 30);
    }
    SEAM(4);

    PH(5) { RPB; OPQ_IDS;
        const float* gnw = args.in[I_GNW];
        f32x4 gn0 = *(const GAS f32x4*)(gnw + ((lane * 8) & 127)), gn1 = *(const GAS f32x4*)(gnw + ((lane * 8) & 127) + 4);
        for (int m = 2 * gw; m < MTOK; m += 2 * NGW) {
            u32x4 a[2][2], bq[2][2], zz[2][2];
#pragma unroll
            for (int t = 0; t < 2; ++t)
#pragma unroll
                for (int half = 0; half < 2; ++half) { const size_t off = (size_t)(m + t) * GDW + half * 512 + lane * 8;
                    a[t][half] = *(const GAS u32x4*)(OF + off); bq[t][half] = *(const GAS u32x4*)(OB + off); zz[t][half] = *(const GAS u32x4*)(PZ + off); }
#pragma unroll
            for (int t = 0; t < 2; ++t)
#pragma unroll
                for (int half = 0; half < 2; ++half) {
                    const unsigned aw[4] = {a[t][half].x, a[t][half].y, a[t][half].z, a[t][half].w}, bw[4] = {bq[t][half].x, bq[t][half].y, bq[t][half].z, bq[t][half].w}, zw[4] = {zz[t][half].x, zz[t][half].y, zz[t][half].z, zz[t][half].w};
                    float o[8]; float ss = 0.f;
#pragma unroll
                    for (int q = 0; q < 4; ++q) { o[2 * q] = bf2f(aw[q] & 0xffffu) + bf2f(bw[q] & 0xffffu); o[2 * q + 1] = bf2f(aw[q] >> 16) + bf2f(bw[q] >> 16); ss += o[2 * q] * o[2 * q] + o[2 * q + 1] * o[2 * q + 1]; }
                    ss += dpp_xor1(ss); ss += dpp_xor2(ss); ss += __shfl_xor(ss, 4); ss += __shfl_xor(ss, 8);
                    const float rstd = __builtin_amdgcn_rsqf(ss * (1.f / HD) + EPS);
                    const float gp[8] = {gn0.x, gn0.y, gn0.z, gn0.w, gn1.x, gn1.y, gn1.z, gn1.w};
                    float y[8];
#pragma unroll
                    for (int q = 0; q < 4; ++q) { const float z0 = bf2f(zw[q] & 0xffffu), z1 = bf2f(zw[q] >> 16); y[2 * q] = o[2 * q] * rstd * gp[2 * q] * silu_f(z0); y[2 * q + 1] = o[2 * q + 1] * rstd * gp[2 * q + 1] * silu_f(z1); }
                    u32x4 w; w.x = pk2(y[0], y[1]); w.y = pk2(y[2], y[3]); w.z = pk2(y[4], y[5]); w.w = pk2(y[6], y[7]);
                    *(GAS u32x4*)(A2 + (size_t)(m + t) * D_MODEL + 1024 + half * 512 + lane * 8) = w; }
        }
    }
    SEAM(5);

    PH(6) { RPB; OPQ_IDS;
        SchedOut S{(const char*)A2, (const char*)WOUT, G, bid};
        EpiOut E{args.in[I_X], MOD, X2B};
        pg8::gemm_phase<EpiOut, SchedOut, false>(L, TAB, D_MODEL, S, E);
    }
    SEAM(6);

    PH(7) { RPB; OPQ_IDS;
        LAS float* WR = (LAS float*)L;
        for (int i = tid; i < D_MODEL * NE; i += NTHREADS) { const int e = i & 15, k = i >> 4; WR[e * 2048 + ((k >> 2) & 1) * 1024 + (k >> 3) * 4 + (k & 3)] = args.in[I_WROUTER][i]; }
        __syncthreads();
        const float* g2 = args.in[I_N2G];
        bf16_t* HX2 = (bf16_t*)(ws + WS_HX2); float* AFF = (float*)(ws + WS_AFF);
        for (int m0 = 2 * gw; m0 < MTOK; m0 += 2 * NGW) {
            const int b = m0 >> 12;
            const float* sh = MOD + b * 12288 + 3 * 2048; const float* sc = sh + 2048;
            f32x4 v[2][8]; float s0 = 0.f, s1 = 0.f;
#pragma unroll
            for (int jc = 0; jc < 4; ++jc) { const u32x4 q0 = *((const GAS u32x4*)(X2B + (size_t)m0 * D_MODEL) + lane + 64 * jc), q1 = *((const GAS u32x4*)(X2B + (size_t)(m0 + 1) * D_MODEL) + lane + 64 * jc);
                v[0][2 * jc] = (f32x4){bf2f(q0.x & 0xffffu), bf2f(q0.x >> 16), bf2f(q0.y & 0xffffu), bf2f(q0.y >> 16)}; v[0][2 * jc + 1] = (f32x4){bf2f(q0.z & 0xffffu), bf2f(q0.z >> 16), bf2f(q0.w & 0xffffu), bf2f(q0.w >> 16)};
                v[1][2 * jc] = (f32x4){bf2f(q1.x & 0xffffu), bf2f(q1.x >> 16), bf2f(q1.y & 0xffffu), bf2f(q1.y >> 16)}; v[1][2 * jc + 1] = (f32x4){bf2f(q1.z & 0xffffu), bf2f(q1.z >> 16), bf2f(q1.w & 0xffffu), bf2f(q1.w >> 16)}; }
#pragma unroll
            for (int j = 0; j < 8; ++j) { s0 += (v[0][j].x * v[0][j].x + v[0][j].y * v[0][j].y) + (v[0][j].z * v[0][j].z + v[0][j].w * v[0][j].w); s1 += (v[1][j].x * v[1][j].x + v[1][j].y * v[1][j].y) + (v[1][j].z * v[1][j].z + v[1][j].w * v[1][j].w); }
#pragma unroll
            for (int o = 1; o < 64; o <<= 1) { s0 += __shfl_xor(s0, o); s1 += __shfl_xor(s1, o); }
            const float r0 = __builtin_amdgcn_rsqf(s0 * (1.f / D_MODEL) + EPS), r1 = __builtin_amdgcn_rsqf(s1 * (1.f / D_MODEL) + EPS);
#pragma unroll
            for (int jc = 0; jc < 4; ++jc) { const int c0 = 8 * (lane + 64 * jc); u32x4 w0, w1;
#pragma unroll
                for (int hh = 0; hh < 2; ++hh) { const f32x4 gg = *(const GAS f32x4*)(g2 + c0 + 4 * hh), sc1 = *(const GAS f32x4*)(sc + c0 + 4 * hh) + 1.f, h1 = *(const GAS f32x4*)(sh + c0 + 4 * hh);
                    const f32x4 y0 = v[0][2 * jc + hh] * r0 * gg * sc1 + h1, y1 = v[1][2 * jc + hh] * r1 * gg * sc1 + h1; v[0][2 * jc + hh] = y0; v[1][2 * jc + hh] = y1;
                    if (hh == 0) { w0.x = pk2(y0.x, y0.y); w0.y = pk2(y0.z, y0.w); w1.x = pk2(y1.x, y1.y); w1.y = pk2(y1.z, y1.w); } else { w0.z = pk2(y0.x, y0.y); w0.w = pk2(y0.z, y0.w); w1.z = pk2(y1.x, y1.y); w1.w = pk2(y1.z, y1.w); } }
                *((GAS u32x4*)(HX2 + (size_t)m0 * D_MODEL) + lane + 64 * jc) = w0; *((GAS u32x4*)(HX2 + (size_t)(m0 + 1) * D_MODEL) + lane + 64 * jc) = w1; }
            float a0[16], a1[16];
#pragma unroll
            for (int eg = 0; eg < 4; ++eg) {
#pragma unroll
                for (int q = 0; q < 4; ++q) { const int e = 4 * eg + q; float c0 = 0.f, c1 = 0.f;
#pragma unroll
                    for (int j = 0; j < 8; ++j) { const f32x4 w4 = *(const LAS f32x4*)(WR + e * 2048 + (j & 1) * 1024 + 4 * (lane + 64 * (j >> 1)));
                        c0 += (v[0][j].x * w4.x + v[0][j].y * w4.y) + (v[0][j].z * w4.z + v[0][j].w * w4.w); c1 += (v[1][j].x * w4.x + v[1][j].y * w4.y) + (v[1][j].z * w4.z + v[1][j].w * w4.w); }
                    a0[e] = c0; a1[e] = c1; }
                asm volatile("" ::: "memory"); }
#pragma unroll
            for (int st = 0; st < 4; ++st) { const int msk = 1 << st, n2 = 8 >> st; const bool up = (lane & msk) != 0;
#pragma unroll
                for (int q = 0; q < 8; ++q) if (q < n2) { const float k0 = up ? a0[q + n2] : a0[q], d0 = up ? a0[q] : a0[q + n2], k1 = up ? a1[q + n2] : a1[q], d1 = up ? a1[q] : a1[q + n2];
                    a0[q] = k0 + __shfl_xor(d0, msk); a1[q] = k1 + __shfl_xor(d1, msk); } }
            float l0 = a0[0], l1 = a1[0]; l0 += __shfl_xor(l0, 16); l1 += __shfl_xor(l1, 16); l0 += __shfl_xor(l0, 32); l1 += __shfl_xor(l1, 32);
            float mx0 = l0, mx1 = l1;
#pragma unroll
            for (int o = 1; o < 16; o <<= 1) { mx0 = fmaxf(mx0, __shfl_xor(mx0, o)); mx1 = fmaxf(mx1, __shfl_xor(mx1, o)); }
            const float e0 = expf(l0 - mx0), e1 = expf(l1 - mx1); float dn0 = e0, dn1 = e1;
#pragma unroll
            for (int o = 1; o < 16; o <<= 1) { dn0 += __shfl_xor(dn0, o); dn1 += __shfl_xor(dn1, o); }
            const int eidx = ((lane & 1) << 3) | ((lane & 2) << 1) | ((lane & 4) >> 1) | ((lane & 8) >> 3);
            if (lane < 16) { float* ap = AFF + ((size_t)b * NE + eidx) * SEQ + (m0 & 4095); f32x2 pr = {e0 / dn0, e1 / dn1}; *(GAS f32x2*)ap = pr; }
        }
    }
    SEAM(7);

    PH(8) { RPB; OPQ_IDS;
        for (int u = bid; u < BATCH * NE; u += G) topk_unit(L, u, (const float*)(ws + WS_AFF), (int*)(ws + WS_IDX), (float*)(ws + WS_VAL), (int*)(ws + WS_SLOT));
    }
    SEAM(8);

    PH(9) { RPB; OPQ_IDS;
        SchedGU S{(const char*)(ws + WS_HX2), (const char*)(ws + WS_WGU), (const int*)(ws + WS_IDX), G, bid};
        EpiGU E{(bf16_t*)(ws + WS_HID)};
        pg8::gemm_phase<EpiGU, SchedGU, true>(L, TAB, D_MODEL, S, E);
    }
    SEAM(9);

    PH(10) { RPB; OPQ_IDS;
        SchedDN S{(const char*)(ws + WS_HID), (const char*)(ws + WS_WDN), G, bid};
        EpiDN E{(bf16_t*)(ws + WS_YB), (const float*)(ws + WS_VAL)};
        pg8::gemm_phase<EpiDN, SchedDN, false>(L, TAB, FF, S, E);
    }
    SEAM(10);

    PH(11) { RPB; OPQ_IDS;
        const float* nf = args.in[I_NORMF]; const bf16_t* YB = (const bf16_t*)(ws + WS_YB); const int* SLOT = (const int*)(ws + WS_SLOT);
        f32x4 cg[8], cn[8]; int curb = -1;
        const int RW = (MTOK + NGW - 1) / NGW;
        for (int k = 0; k < RW; ++k) {
            const int m = gw * RW + k; if (m >= MTOK) break;
            const int b = m >> 12;
            if (b != curb) { curb = b; const float* gt = MOD + b * 12288 + 5 * 2048;
#pragma unroll
                for (int jc = 0; jc < 4; ++jc) { const int c0 = 8 * (lane + 64 * jc); cg[2 * jc] = *(const GAS f32x4*)(gt + c0); cg[2 * jc + 1] = *(const GAS f32x4*)(gt + c0 + 4); cn[2 * jc] = *(const GAS f32x4*)(nf + c0); cn[2 * jc + 1] = *(const GAS f32x4*)(nf + c0 + 4); } }
            f32x4 v[8], y[8];
            u32x4 xq[4];
#pragma unroll
            for (int jc = 0; jc < 4; ++jc) xq[jc] = *((const GAS u32x4*)(X2B + (size_t)m * D_MODEL) + lane + 64 * jc);
            const int myslot = SLOT[(size_t)m * NE + (lane & 15)];
#pragma unroll
            for (int j = 0; j < 8; ++j) y[j] = (f32x4){0.f, 0.f, 0.f, 0.f};
            unsigned emask = (unsigned)(__ballot(myslot >= 0) & 0xffffull);
#pragma unroll 1
            while (emask) {
                int es[4], sl[4];
#pragma unroll
                for (int q = 0; q < 4; ++q) { if (emask) { es[q] = __builtin_ctz(emask); emask &= emask - 1; sl[q] = __builtin_amdgcn_readlane(myslot, es[q]); } else { es[q] = 0; sl[q] = -1; } }
                u32x4 w[4][4];
#pragma unroll
                for (int q = 0; q < 4; ++q) if (sl[q] >= 0) { const GAS u32x4* yr = (const GAS u32x4*)(YB + ((size_t)(b * NE + es[q]) * CAP + sl[q]) * D_MODEL) + lane;
#pragma unroll
                    for (int jc = 0; jc < 4; ++jc) w[q][jc] = yr[64 * jc]; }
#pragma unroll
                for (int q = 0; q < 4; ++q) if (sl[q] >= 0) {
#pragma unroll
                    for (int jc = 0; jc < 4; ++jc) { y[2 * jc].x += bf2f(w[q][jc].x & 0xffffu); y[2 * jc].y += bf2f(w[q][jc].x >> 16); y[2 * jc].z += bf2f(w[q][jc].y & 0xffffu); y[2 * jc].w += bf2f(w[q][jc].y >> 16);
                        y[2 * jc + 1].x += bf2f(w[q][jc].z & 0xffffu); y[2 * jc + 1].y += bf2f(w[q][jc].z >> 16); y[2 * jc + 1].z += bf2f(w[q][jc].w & 0xffffu); y[2 * jc + 1].w += bf2f(w[q][jc].w >> 16); } }
            }
            float s = 0.f;
#pragma unroll
            for (int jc = 0; jc < 4; ++jc) { v[2 * jc] = (f32x4){bf2f(xq[jc].x & 0xffffu), bf2f(xq[jc].x >> 16), bf2f(xq[jc].y & 0xffffu), bf2f(xq[jc].y >> 16)}; v[2 * jc + 1] = (f32x4){bf2f(xq[jc].z & 0xffffu), bf2f(xq[jc].z >> 16), bf2f(xq[jc].w & 0xffffu), bf2f(xq[jc].w >> 16)}; }
#pragma unroll
            for (int j = 0; j < 8; ++j) { v[j] = v[j] + cg[j] * y[j]; s += (v[j].x * v[j].x + v[j].y * v[j].y) + (v[j].z * v[j].z + v[j].w * v[j].w); }
            const float rstd = __builtin_amdgcn_rsqf(wave_sum(s) * (1.f / D_MODEL) + EPS);
            float* orow = args.out + (size_t)m * D_MODEL;
#pragma unroll
            for (int jc = 0; jc < 4; ++jc) { const int c0 = 8 * (lane + 64 * jc); *(GAS f32x4*)(orow + c0) = v[2 * jc] * rstd * cn[2 * jc]; *(GAS f32x4*)(orow + c0 + 4) = v[2 * jc + 1] * rstd * cn[2 * jc + 1]; }
        }
    }
#ifdef TPROBE_A
    __syncthreads();
    if (bid == 0 && tid == 0) { asm volatile("s_waitcnt vmcnt(0)" ::: "memory"); const unsigned long long te = __builtin_amdgcn_s_memrealtime(); TSB[12] = te;
        const float ta = (float)(TSB[TPROBE_A + 1] - TSB[TPROBE_A]) * 0.1f, tb = (float)(TSB[TPROBE_B + 1] - TSB[TPROBE_B]) * 0.1f;
        args.out[0] = ta; for (int i = 1; i <= 100; ++i) args.out[i] = tb; }
#endif
#undef IN
#undef SEAM
}

constexpr int NPHASES = 12;

extern "C" void kernel_launch(void* const* d_in, const int* in_sizes, int n_in, void* d_out, int out_size, void* d_ws, size_t ws_size, hipStream_t stream) {
    static int grid = 0;
    if (grid == 0) {
        if (n_in != 19 || out_size != MTOK * D_MODEL || ws_size < WS_END) { fprintf(stderr, "kernel_launch: unexpected shapes (n_in %d out %d ws %zu)\n", n_in, out_size, ws_size); grid = -1; return; }
        int dev = 0, cus = 0, per_cu = 0;
        if (hipGetDevice(&dev) != hipSuccess || hipDeviceGetAttribute(&cus, hipDeviceAttributeMultiprocessorCount, dev) != hipSuccess) { grid = -1; return; }
        if (hipFuncSetAttribute((const void*)fwd_kernel, hipFuncAttributeMaxDynamicSharedMemorySize, LDS_BYTES) != hipSuccess) { grid = -1; return; }
        if (hipOccupancyMaxActiveBlocksPerMultiprocessor(&per_cu, (const void*)fwd_kernel, NTHREADS, LDS_BYTES) != hipSuccess || per_cu < 1) { fprintf(stderr, "occupancy query: %d\n", per_cu); grid = -1; return; }
        grid = cus;
    }
    if (grid < 0) return;
    if (hipMemsetAsync((char*)d_ws + WS_CTL, 0, CTL_ZERO_BYTES, stream) != hipSuccess) return;
    Args a{};
    for (int i = 0; i < 19; ++i) a.in[i] = (const float*)d_in[i];
    a.out = (float*)d_out; a.ws = (unsigned char*)d_ws; a.ph_lo = 0; a.ph_hi = NPHASES;
    hipLaunchKernelGGL(fwd_kernel, dim3(grid), dim3(NTHREADS), LDS_BYTES, stream, a);
}
```

```cpp
#include <hip/hip_runtime.h>
#include <cstdio>
#include <cstdint>

#define GAS __attribute__((address_space(1)))
#define LAS __attribute__((address_space(3)))
typedef unsigned short bf16_t;
typedef short bf16x8 __attribute__((ext_vector_type(8)));
typedef short s16x4 __attribute__((ext_vector_type(4)));
typedef float f32x2 __attribute__((ext_vector_type(2)));
typedef float f32x4 __attribute__((ext_vector_type(4)));
typedef float f32x16 __attribute__((ext_vector_type(16)));
typedef unsigned u32x2 __attribute__((ext_vector_type(2)));
typedef unsigned u32x4 __attribute__((ext_vector_type(4)));
typedef __bf16 bf16x2_t __attribute__((ext_vector_type(2)));

constexpr int NWAVES = 8, NTHREADS = 512;
constexpr int D_MODEL = 2048, BATCH = 4, SEQ = 4096, MTOK = BATCH * SEQ, CTX = 256, MCTX = BATCH * CTX, MALL = MTOK + MCTX;
constexpr int FW = 1024, GDW = 1024, NH = 8, HD = 128, INC = 5152, INC_PAD = 5376;
constexpr int NE = 16, CAP = 512, FF = 1536;
constexpr float EPS = 1e-6f;

constexpr size_t MiB = 1u << 20;
constexpr size_t WS_CTL = 0, CTL_ZERO_BYTES = 1 * MiB;
constexpr size_t WS_MOD = 1 * MiB;
constexpr size_t WS_TW = WS_MOD + 256 * 1024;
constexpr size_t WS_DA = WS_TW + 32 * 1024;
constexpr size_t WS_DB = WS_DA + 16 * 1024;
constexpr size_t WS_DC = WS_DB + 32 * 1024;
constexpr size_t WS_WIN = 2 * MiB;
constexpr size_t WS_WOUT = WS_WIN + (size_t)INC_PAD * D_MODEL * 2;
constexpr size_t WS_WGU = WS_WOUT + (size_t)D_MODEL * D_MODEL * 2;
constexpr size_t WS_WDN = WS_WGU + (size_t)NE * 2 * FF * D_MODEL * 2;
constexpr size_t WS_PF = WS_WDN + (size_t)NE * D_MODEL * FF * 2;
constexpr size_t WS_PQKV = WS_PF + (size_t)MTOK * FW * 2;
constexpr size_t WS_PZ = WS_PQKV + (size_t)MALL * 3 * GDW * 2;
constexpr size_t WS_PAB = WS_PZ + (size_t)MTOK * GDW * 2;
constexpr size_t WS_G = WS_PAB + (size_t)MALL * 32 * 4;
constexpr size_t WS_HX2 = WS_G;
constexpr size_t WS_HID = WS_HX2 + (size_t)MTOK * D_MODEL * 2;
constexpr size_t WS_YB = WS_HID + (size_t)BATCH * NE * CAP * FF * 2;
constexpr size_t WS_AFF = WS_YB + (size_t)BATCH * NE * CAP * D_MODEL * 2;
constexpr size_t WS_IDX = WS_AFF + (size_t)BATCH * NE * SEQ * 4;
constexpr size_t WS_VAL = WS_IDX + (size_t)BATCH * NE * CAP * 4;
constexpr size_t WS_SLOT = WS_VAL + (size_t)BATCH * NE * CAP * 4;
constexpr size_t WS_A2 = WS_PF;
constexpr size_t WS_END = 800 * MiB;
static_assert(WS_SLOT + (size_t)MTOK * NE * 4 <= WS_END, "ws map");


constexpr int RING_BYTES = 131072;
constexpr int TAB_OFF = RING_BYTES;
constexpr int MISC_OFF = TAB_OFF + 16384;
constexpr int LDS_BYTES = MISC_OFF + 256;

constexpr int CW_BAR = 4096;
constexpr int CW_Q0 = 8128, CW_Q1 = 8192, CW_Q2 = 8256;

__device__ __forceinline__ unsigned f2bf(float f) { unsigned u = __builtin_bit_cast(unsigned, f); return (u + 0x7fffu + ((u >> 16) & 1u)) >> 16; }
__device__ __forceinline__ float bf2f(unsigned h) { return __builtin_bit_cast(float, h << 16); }
__device__ __forceinline__ unsigned pk2(float lo, float hi) { f32x2 v = {lo, hi}; bf16x2_t b = __builtin_convertvector(v, bf16x2_t); return __builtin_bit_cast(unsigned, b); }
__device__ __forceinline__ float wave_sum(float v) {
#pragma unroll
    for (int o = 1; o < 64; o <<= 1) v += __shfl_xor(v, o);
    return v;
}
__device__ __forceinline__ float dpp_xor1(float v) { return __builtin_bit_cast(float, __builtin_amdgcn_mov_dpp(__builtin_bit_cast(int, v), 0xB1, 0xf, 0xf, true)); }
__device__ __forceinline__ float dpp_xor2(float v) { return __builtin_bit_cast(float, __builtin_amdgcn_mov_dpp(__builtin_bit_cast(int, v), 0x4E, 0xf, 0xf, true)); }
__device__ __forceinline__ float silu_f(float v) { return v * __builtin_amdgcn_rcpf(1.f + __expf(-v)); }
#define LDS_WAIT() asm volatile("s_waitcnt lgkmcnt(0)" ::: "memory")
#define LBAR() do { asm volatile("s_waitcnt lgkmcnt(0)" ::: "memory"); __builtin_amdgcn_s_barrier(); asm volatile("" ::: "memory"); } while (0)

#define XB_TMO      128
#define XB_XCNT(j)  (256  + 64 * (j))
#define XB_XSUB(j)  (1280 + 64 * (j))
#define XB_XGEN(j)  (2304 + 64 * (j))
#define XB_TOP      3328
#define XB_TOPGEN   3392
#define XCD_BAR_WORDS 3456
#define XB_SPIN_CAP (1u << 18)
__device__ __forceinline__ unsigned xb_ld(unsigned* p)              { return __hip_atomic_load(p, __ATOMIC_RELAXED, __HIP_MEMORY_SCOPE_AGENT); }
__device__ __forceinline__ unsigned xb_add(unsigned* p, unsigned v) { return __hip_atomic_fetch_add(p, v, __ATOMIC_RELAXED, __HIP_MEMORY_SCOPE_AGENT); }
__device__ __forceinline__ unsigned xb_xcc_id() { return (unsigned)__builtin_amdgcn_s_getreg((3 << 11) | 20) & 0xFu; }
#define XB_SPIN(cond, bar) do { unsigned _sp = 0; while (cond) { __builtin_amdgcn_s_sleep(1); \
    if ((++_sp & 255u) == 0u) { if (xb_ld(&(bar)[XB_TMO])) break; if (_sp > XB_SPIN_CAP) { atomicAdd(&(bar)[XB_TMO], 1u); break; } } } } while (0)
struct XcdBarrier { unsigned* bar; unsigned x; volatile LAS unsigned* st; };
__device__ __forceinline__ XcdBarrier xcd_barrier_post(unsigned* bar, volatile LAS unsigned* st) {
    XcdBarrier b; b.bar = bar; b.x = xb_xcc_id(); b.st = st;
    if (threadIdx.x == 0) (void)xb_add(&bar[XB_XCNT(b.x)], 1u);
    return b;
}
__device__ __forceinline__ void xcd_barrier_complete(unsigned* bar, unsigned x, unsigned& nloc, unsigned& nx) {
    const unsigned G = gridDim.x * gridDim.y * gridDim.z;
    unsigned sum, cnt, mine, sp = 0u;
    for (;;) {
        sum = 0u; cnt = 0u; mine = 0u;
#pragma unroll
        for (unsigned j = 0; j < 16; ++j) { const unsigned c = xb_ld(&bar[XB_XCNT(j)]); sum += c; cnt += (c > 0u) ? 1u : 0u; mine = (j == x) ? c : mine; }
        if (sum == G) break;
        __builtin_amdgcn_s_sleep(1);
        if ((++sp & 255u) == 0u) { if (xb_ld(&bar[XB_TMO])) break; if (sp > XB_SPIN_CAP) { atomicAdd(&bar[XB_TMO], 1u); break; } }
    }
    nloc = mine > 0u ? mine : 1u; nx = cnt > 0u ? cnt : 1u;
}
__device__ __forceinline__ void xcd_barrier(const XcdBarrier& b) {
    asm volatile("s_waitcnt vmcnt(0)" ::: "memory");
    __syncthreads();
    if (threadIdx.x == 0) {
        unsigned* bar = b.bar;
        __builtin_amdgcn_s_waitcnt(0);
        unsigned nloc = b.st[0], nx = b.st[1];
        if (nloc == 0u) { xcd_barrier_complete(bar, b.x, nloc, nx); b.st[0] = nloc; b.st[1] = nx; }
        const unsigned old = xb_add(&bar[XB_XSUB(b.x)], 1u);
        const unsigned gen = old / nloc;
        if (old + 1u == (gen + 1u) * nloc) {
            __builtin_amdgcn_fence(__ATOMIC_RELEASE, "agent");
            asm volatile("s_waitcnt vmcnt(0)" ::: "memory");
            const unsigned og = xb_add(&bar[XB_TOP], 1u);
            const unsigned tg = og / nx;
            if (og + 1u == (tg + 1u) * nx) xb_add(&bar[XB_TOPGEN], 1u);
            else XB_SPIN(xb_ld(&bar[XB_TOPGEN]) == tg, bar);
            __builtin_amdgcn_fence(__ATOMIC_ACQUIRE, "agent");
            xb_add(&bar[XB_XGEN(b.x)], 1u);
            asm volatile("s_waitcnt vmcnt(0)" ::: "memory");
        } else {
            XB_SPIN(xb_ld(&bar[XB_XGEN(b.x)]) == gen, bar);
            __builtin_amdgcn_fence(__ATOMIC_ACQUIRE, "agent");
            asm volatile("s_waitcnt vmcnt(0)" ::: "memory");
        }
    }
    __syncthreads();
}

namespace pg8 {
constexpr int BM = 256, BK = 64, HALF = 128, HTB = HALF * BK * 2, STAGE_BYTES = 8 * HTB, NXCD = 8, WGM = 8;
__host__ __device__ __forceinline__ int lds_byte(int r, int c) { const int st = (r >> 4) * 2 + (c >> 5), rr = r & 15, cc = c & 31, ob = rr * 64 + cc * 2; return st * 1024 + (ob ^ (((ob >> 9) & 1) << 5)); }
__host__ __device__ __forceinline__ void stage_rc(int b, int& R, int& C) { const int st = b / 1024, sb = b % 1024, swz = sb ^ (((sb >> 9) & 1) << 5); R = (st >> 1) * 16 + swz / 64; C = (st & 1) * 32 + (swz % 64) / 2; }
__host__ __device__ __forceinline__ int perm32(int rho) { const int n = rho >> 4, i = rho & 15; return 8 * (i >> 2) + 4 * n + (i & 3); }

struct Unit { const char* a; const char* b; const int* gidx; int pm, pn, aux; };

template <class Epi, class Sched, bool GATHER>
__device__ __forceinline__ void gemm_phase(LAS unsigned char* lds, LAS unsigned* tab, const int K, const Sched& S, const Epi& E) {
    int tid_ = threadIdx.x; asm volatile("" : "+v"(tid_));
    const int tid = tid_, wid = __builtin_amdgcn_readfirstlane(tid >> 6), lane = tid & 63, wr = wid >> 2, wc = wid & 3, fr = lane & 15, fq = lane >> 4;
    const int nt = K / BK;
    unsigned voffA[2], voffB[2];
#pragma unroll
    for (int i = 0; i < 2; ++i) { int R, C; stage_rc(tid * 16 + i * 8192, R, C); const int Rb = Epi::PERM ? ((R & ~31) + perm32(R & 31)) : R;
        voffA[i] = (unsigned)(R * K + C) * 2u; voffB[i] = (unsigned)(Rb * K + C) * 2u; }
    const size_t kstep = (size_t)(BK * 2);
    const size_t hstep = (size_t)HALF * K * 2;
    const unsigned ldsw = (unsigned)wid * 1024u;
    const int aoff = lds_byte(wr * 64 + fr, fq * 8), boff = lds_byte(wc * 32 + fr, fq * 8);
#define PG8_SA(b, h) (((b) * 2 + (h)) * HTB)
#define PG8_SB(b, h) ((4 + (b) * 2 + (h)) * HTB)
#define PG8_STAGE(bufoff, gbase, voff) do { _Pragma("unroll") for (int _i = 0; _i < 2; ++_i) \
        __builtin_amdgcn_global_load_lds((const unsigned*)((const char*)(gbase) + (voff)[_i]), (LAS unsigned*)(lds + (bufoff) + ldsw + _i * 8192), 16, 0, 0); } while (0)
#define PG8_STAGE_A(bufoff, gbase, par, h) do { if constexpr (GATHER) { _Pragma("unroll") for (int _i = 0; _i < 2; ++_i) { const unsigned _o = tab[(((par) * 2 + (h)) * 2 + _i) * 512 + tid]; \
            __builtin_amdgcn_global_load_lds((const unsigned*)((const char*)(gbase) + _o), (LAS unsigned*)(lds + (bufoff) + ldsw + _i * 8192), 16, 0, 0); } } \
        else { PG8_STAGE(bufoff, (gbase) + (h) * hstep, voffA); } } while (0)
#define PG8_LDA(dst, b, h) do { _Pragma("unroll") for (int m = 0; m < 4; ++m) _Pragma("unroll") for (int k = 0; k < 2; ++k) dst[m][k] = *(const LAS bf16x8*)(lds + PG8_SA(b, h) + aoff + m * 2048 + k * 1024); } while (0)
#define PG8_LDB(dst, b, h) do { _Pragma("unroll") for (int n = 0; n < 2; ++n) _Pragma("unroll") for (int k = 0; k < 2; ++k) dst[n][k] = *(const LAS bf16x8*)(lds + PG8_SB(b, h) + boff + n * 2048 + k * 1024); } while (0)
#define PG8_MMA(ai, bj, At, Bt) do { __builtin_amdgcn_s_setprio(1); _Pragma("unroll") for (int m = 0; m < 4; ++m) _Pragma("unroll") for (int n = 0; n < 2; ++n) _Pragma("unroll") for (int k = 0; k < 2; ++k) \
        acc[ai][bj][m][n] = __builtin_amdgcn_mfma_f32_16x16x32_bf16(Bt[n][k], At[m][k], acc[ai][bj][m][n], 0, 0, 0); __builtin_amdgcn_s_setprio(0); } while (0)
#define PG8_WAIT_V(n) asm volatile("s_waitcnt vmcnt(" #n ")" ::: "memory")
#define PG8_WAIT_L(n) asm volatile("s_waitcnt lgkmcnt(" #n ")" ::: "memory")
#define PG8_BAR __builtin_amdgcn_s_barrier()
#define PG8_SCHED __builtin_amdgcn_sched_barrier(0)
#define PG8_FILL(par, u) do { if constexpr (GATHER) { _Pragma("unroll") for (int _h = 0; _h < 2; ++_h) _Pragma("unroll") for (int _i = 0; _i < 2; ++_i) { int R_, C_; stage_rc(tid * 16 + _i * 8192, R_, C_); \
        const int row_ = (u).gidx[_h * HALF + R_]; tab[(((par) * 2 + _h) * 2 + _i) * 512 + tid] = (unsigned)(row_ * K + C_) * 2u; } } } while (0)
    Unit cur, nxt; int ui = 0; int par = 0;
    if (!S.next(0, cur)) return;
    f32x4 acc[2][2][4][2];
#pragma unroll
    for (int a = 0; a < 2; ++a)
#pragma unroll
        for (int b = 0; b < 2; ++b)
#pragma unroll
            for (int m = 0; m < 4; ++m)
#pragma unroll
                for (int n = 0; n < 2; ++n) acc[a][b][m][n] = (f32x4){0.f, 0.f, 0.f, 0.f};
    bf16x8 At[4][2], B0[2][2], B1[2][2];
    const char* cA = cur.a; const char* cB = cur.b;
    PG8_FILL(0, cur);
    PG8_STAGE(PG8_SB(0, 0), cB, voffB); PG8_STAGE(PG8_SB(0, 1), cB + hstep, voffB); PG8_STAGE_A(PG8_SA(0, 0), cA, 0, 0); PG8_STAGE_A(PG8_SA(0, 1), cA, 0, 1);
    if (wr == 1) PG8_BAR;
    PG8_WAIT_V(2); PG8_BAR;
    PG8_STAGE(PG8_SB(1, 0), cB + kstep, voffB); PG8_STAGE_A(PG8_SA(1, 0), cA + kstep, 0, 0); PG8_STAGE(PG8_SB(1, 1), cB + hstep + kstep, voffB);
    PG8_WAIT_V(6); PG8_BAR;
    for (;;) {
        const bool has_next = S.next(ui + 1, nxt);
        const char* nA = has_next ? nxt.a : cA; const char* nB = has_next ? nxt.b : cB;
        const int npar = has_next ? (par ^ 1) : par;
        for (int t = 0; t < nt; t += 2) {
            const bool last = (t == nt - 2);
            const char* a1 = cA + (size_t)(t + 1) * kstep;
            const char* a2 = last ? nA : cA + (size_t)(t + 2) * kstep; const char* b2 = last ? nB : cB + (size_t)(t + 2) * kstep;
            const char* a3 = a2 + kstep; const char* b3 = b2 + kstep;
            const int p2 = last ? npar : par;
            if (last && has_next) PG8_FILL(npar, nxt);
            PG8_LDB(B0, 0, 0); PG8_LDB(B1, 0, 1); PG8_SCHED; PG8_LDA(At, 0, 0); PG8_STAGE_A(PG8_SA(1, 1), a1, par, 1);
            PG8_WAIT_V(8); PG8_WAIT_L(0); PG8_BAR; PG8_MMA(0, 0, At, B0); PG8_MMA(0, 1, At, B1); PG8_BAR; PG8_SCHED;
            PG8_LDA(At, 0, 1); PG8_STAGE(PG8_SB(0, 0), b2, voffB); PG8_STAGE(PG8_SB(0, 1), b2 + hstep, voffB); PG8_STAGE_A(PG8_SA(0, 0), a2, p2, 0);
            PG8_WAIT_V(8); PG8_WAIT_L(0); PG8_BAR; PG8_MMA(1, 0, At, B0); PG8_MMA(1, 1, At, B1); PG8_BAR; PG8_SCHED;
            PG8_LDB(B0, 1, 0); PG8_LDB(B1, 1, 1); PG8_SCHED; PG8_LDA(At, 1, 0); PG8_STAGE_A(PG8_SA(0, 1), a2, p2, 1);
            PG8_WAIT_V(8); PG8_WAIT_L(0); PG8_BAR; PG8_MMA(0, 0, At, B0); PG8_MMA(0, 1, At, B1); PG8_BAR; PG8_SCHED;
            PG8_LDA(At, 1, 1); PG8_STAGE(PG8_SB(1, 0), b3, voffB); PG8_STAGE(PG8_SB(1, 1), b3 + hstep, voffB); PG8_STAGE_A(PG8_SA(1, 0), a3, p2, 0);
            PG8_WAIT_V(8); PG8_WAIT_L(0); PG8_BAR; PG8_MMA(1, 0, At, B0); PG8_MMA(1, 1, At, B1); PG8_BAR; PG8_SCHED;
        }
        if (wr == 0) PG8_BAR;
        E(acc, cur, wr, wc, fr, fq);
        if (!has_next) break;
#pragma unroll
        for (int a = 0; a < 2; ++a)
#pragma unroll
            for (int b = 0; b < 2; ++b)
#pragma unroll
                for (int m = 0; m < 4; ++m)
#pragma unroll
                    for (int n = 0; n < 2; ++n) acc[a][b][m][n] = (f32x4){0.f, 0.f, 0.f, 0.f};
        cur = nxt; cA = nA; cB = nB; par = npar; ++ui;
        if (wr == 1) PG8_BAR;
    }
    PG8_WAIT_V(0);
    PG8_BAR;
#undef PG8_SA
#undef PG8_SB
#undef PG8_STAGE
#undef PG8_STAGE_A
#undef PG8_LDA
#undef PG8_LDB
#undef PG8_MMA
#undef PG8_WAIT_V
#undef PG8_WAIT_L
#undef PG8_BAR
#undef PG8_SCHED
#undef PG8_FILL
}
}

__device__ __forceinline__ bf16x8 frag_row(const LAS bf16_t* base, int ld, int r0, int k0, int lane) {
    return *(const LAS bf16x8*)(base + (r0 + (lane & 31)) * ld + k0 + 8 * (lane >> 5));
}
__device__ __forceinline__ bf16x8 frag_tr(const LAS bf16_t* base, int ld, int r0, int k0, int lane) {
    const int h = lane >> 5, blk = (lane >> 4) & 1, q = (lane & 15) >> 2, p = lane & 3;
    const LAS bf16_t* a0 = base + (k0 + 8 * h + q) * ld + r0 + 16 * blk + 4 * p;
    const s16x4 lo = __builtin_bit_cast(s16x4, __builtin_amdgcn_ds_read_tr16_b64_v4i16((LAS s16x4*)a0));
    const s16x4 hi = __builtin_bit_cast(s16x4, __builtin_amdgcn_ds_read_tr16_b64_v4i16((LAS s16x4*)(a0 + 4 * ld)));
    return (bf16x8){lo[0], lo[1], lo[2], lo[3], hi[0], hi[1], hi[2], hi[3]};
}
__device__ __forceinline__ int crow(int r, int lane) { return (r & 3) + 8 * (r >> 2) + 4 * (lane >> 5); }
#define MFMA32(a, b, c) __builtin_amdgcn_mfma_f32_32x32x16_bf16((a), (b), (c), 0, 0, 0)
constexpr f32x16 Z16 = {0.f, 0.f, 0.f, 0.f, 0.f, 0.f, 0.f, 0.f, 0.f, 0.f, 0.f, 0.f, 0.f, 0.f, 0.f, 0.f};


constexpr int CVT_BLOCK_ITEMS = 3 * 3072;
struct CvtJob { f32x4 v[8]; int item; };
__device__ __forceinline__ void cvt_issue(CvtJob& c, int item, int lane, const float* wg, const float* wu, const float* wd) {
    c.item = item;
    if (item < 0) return;
    const int kc = lane & 7, ng = lane >> 3; const int bi = item >> 3, sub = item & 7;
    const float* src; int ldn, k0, n0;
    if (bi < 6144) { const int up = bi >= 3072, r0 = bi - up * 3072, e = r0 / 192, r = r0 % 192; src = (up ? wu : wg) + (size_t)e * D_MODEL * FF; ldn = FF; k0 = 64 * (r / 6); n0 = 256 * (r % 6) + 32 * sub; }
    else { const int r0 = bi - 6144, e = r0 / 192, r = r0 % 192; src = wd + (size_t)e * FF * D_MODEL; ldn = D_MODEL; k0 = 64 * (r / 8); n0 = 256 * (r % 8) + 32 * sub; }
    const float* p = src + (size_t)(k0 + 8 * kc) * ldn + n0 + 4 * ng;
#pragma unroll
    for (int i = 0; i < 8; ++i) c.v[i] = *(const GAS f32x4*)(p + (size_t)i * ldn);
}
__device__ __forceinline__ void cvt_finish(const CvtJob& c, int lane, bf16_t* WGU, bf16_t* WDN) {
    const int item = c.item;
    if (item < 0) return;
    const int kc = lane & 7, ng = lane >> 3; const int bi = item >> 3, sub = item & 7;
    bf16_t* dst; int dstK, k0, n0, mode;
    if (bi < 6144) { const int up = bi >= 3072, r0 = bi - up * 3072, e = r0 / 192, r = r0 % 192; dst = WGU + (size_t)e * 2 * FF * D_MODEL; dstK = D_MODEL; k0 = 64 * (r / 6); n0 = 256 * (r % 6) + 32 * sub; mode = 1 + up; }
    else { const int r0 = bi - 6144, e = r0 / 192, r = r0 % 192; dst = WDN + (size_t)e * D_MODEL * FF; dstK = FF; k0 = 64 * (r / 8); n0 = 256 * (r % 8) + 32 * sub; mode = 0; }
    const int n = n0 + 4 * ng;
    const int row0 = mode == 0 ? n : (256 * (n >> 7) + 128 * (mode - 1) + (n & 127));
    bf16_t* o = dst + (size_t)row0 * dstK + k0 + 8 * kc;
#pragma unroll
    for (int j = 0; j < 4; ++j) { u32x4 w; w.x = pk2(c.v[0][j], c.v[1][j]); w.y = pk2(c.v[2][j], c.v[3][j]); w.z = pk2(c.v[4][j], c.v[5][j]); w.w = pk2(c.v[6][j], c.v[7][j]);
        *(GAS u32x4*)(o + (size_t)j * dstK) = w; }
}
struct CvtShadow { int base, left; };
__device__ __forceinline__ int cvt_next(CvtShadow& cs, unsigned* q, int lane) {
    if (cs.left == 0) { if (cs.base == -2) return -1; unsigned v = 0; if (lane == 0) v = atomicAdd(q, 1u); const int b = (int)__builtin_amdgcn_readfirstlane(v);
        if (b >= CVT_BLOCK_ITEMS) { cs.base = -2; return -1; } cs.base = b * 8; cs.left = 8; }
    const int it = cs.base + (8 - cs.left); --cs.left; return it;
}
constexpr int REC_W = 0, REC_UT = 16384, REC_QD = 32768, REC_KDT = 49152, REC_QK = 65536, REC_GT = 73728, REC_BYTES = 73984;
constexpr int NREC_X = BATCH * NH * 2 * 64, NREC = NREC_X + BATCH * NH * 2 * 4;
__device__ __forceinline__ size_t rec_index(bool isctx, int b, int h, int d, int c) { return isctx ? (size_t)(NREC_X + ((b * NH + h) * 2 + d) * 4 + c) : (size_t)(((b * NH + h) * 2 + d) * 64 + c); }
__device__ __forceinline__ float softplus_f(float v) { return v > 20.f ? v : log1pf(__expf(v)); }

struct GdnItem { bool isctx; int b, h, c, rowbase, vlo, vhi; };
__device__ __forceinline__ GdnItem gdn_decode(int item) {
    GdnItem I;
    if (item < BATCH * NH * 64) { I.isctx = false; I.b = item >> 9; I.h = (item >> 6) & 7; I.c = item & 63; I.rowbase = I.b * SEQ + I.c * 64; I.vlo = 0; I.vhi = 64; }
    else { const int j = item - BATCH * NH * 64; I.isctx = true; I.b = j >> 5; I.h = (j >> 2) & 7; I.c = j & 3; I.rowbase = MTOK + I.b * CTX + I.c * 64; I.vlo = -I.c * 64; I.vhi = CTX - I.c * 64; }
    return I;
}
struct GdnPre { u32x4 raw[7]; f32x4 cw; float ga, gb; };
__device__ __forceinline__ void gdn_prefetch(GdnPre& P, const GdnItem& I, int tid, int lane, int wave, const bf16_t* PQKV, const float* PAB, const float* convw) {
#pragma unroll
    for (int e = 0; e < 7; ++e) { const int idx = tid + 512 * e; u32x4 v = {0u, 0u, 0u, 0u};
        if (idx < 3 * 68 * 16) { const int ch = idx & 15, rr = (idx >> 4) % 68, t = (idx >> 4) / 68; const int rel = rr - 2;
            if (rel >= I.vlo && rel < I.vhi) v = *(const GAS u32x4*)(PQKV + (size_t)(I.rowbase + rel) * (3 * GDW) + t * GDW + I.h * HD + ch * 8); }
        P.raw[e] = v; }
    if (tid < 480) { const int t = tid / 160, j = (tid % 160) >> 5, c4 = tid & 31; P.cw = *(const GAS f32x4*)(convw + j * (3 * GDW) + t * GDW + I.h * HD + c4 * 4); }
    if (wave < 2) { const int d = wave; const int i = d ? 63 - lane : lane; const int m = I.rowbase + i; P.ga = PAB[(size_t)m * 32 + d * 8 + I.h]; P.gb = PAB[(size_t)m * 32 + 16 + d * 8 + I.h]; }
}

__device__ __forceinline__ void gdn_chunk_items(LAS unsigned char* L, int first, int stride, const bf16_t* PQKV, const float* PAB, const float* convw, const float* a_log, const float* dt_bias, unsigned char* GREC,
                                                unsigned* cvq, const float* wg, const float* wu, const float* wd, bf16_t* WGU, bf16_t* WDN) {
    const int tid_f_ = threadIdx.x, wave = __builtin_amdgcn_readfirstlane(tid_f_ >> 6);
    constexpr int LD = 136, LDT_ = 72, NITEMS = BATCH * NH * 64 + BATCH * NH * 4;
    LAS bf16_t* QN = (LAS bf16_t*)L; LAS bf16_t* KN = (LAS bf16_t*)(L + 17408); LAS bf16_t* VI = (LAS bf16_t*)(L + 34816);
    LAS bf16_t* RAW = (LAS bf16_t*)(L + 52224);
    LAS bf16_t* TB = (LAS bf16_t*)(L + 52224); LAS bf16_t* TBG = (LAS bf16_t*)(L + 70656);
    LAS float* MPD = (LAS float*)(L + 89088);
    LAS bf16_t* MB = (LAS bf16_t*)(L + 97280);
    LAS bf16_t* TI = (LAS bf16_t*)(L + 52224);
    LAS bf16_t* PI = (LAS bf16_t*)(L + 70656);
    LAS float* GC = (LAS float*)(L + 122880); LAS float* BETA = GC + 128; LAS float* EGC = GC + 256; LAS float* EKD = GC + 384; LAS float* GTOT = (LAS float*)(L + 115712);
    LAS float* CW = (LAS float*)(L + 124928);
    LAS bf16_t* QKB = (LAS bf16_t*)(L + 124928);
    if (first >= NITEMS) return;
    CvtShadow cs; cs.base = -1; cs.left = 0; CvtJob cj; cj.item = -1;
#ifndef CVT_SHADOW
#define CVT_SHADOW 0
#endif
#if CVT_SHADOW
#define CVT_HOOK_ISSUE() cvt_issue(cj, cvt_next(cs, cvq, lane), lane, wg, wu, wd)
#define CVT_HOOK_FINISH() cvt_finish(cj, lane, WGU, WDN)
#else
#define CVT_HOOK_ISSUE() do { } while (0)
#define CVT_HOOK_FINISH() do { } while (0)
#endif
    GdnPre P;
    { int t0_ = tid_f_; asm volatile("" : "+v"(t0_)); const GdnItem I0 = gdn_decode(first); gdn_prefetch(P, I0, t0_, t0_ & 63, wave, PQKV, PAB, convw); }
#pragma unroll 1
    for (int item = first; item < NITEMS; item += stride) {
        int tid_o_ = tid_f_; asm volatile("" : "+v"(tid_o_)); const int tid = tid_o_, lane = tid & 63;
        const GdnItem I = gdn_decode(item);
        const bool isctx = I.isctx; const int b = I.b, h = I.h, c = I.c;
#pragma unroll
        for (int e = 0; e < 7; ++e) { const int idx = tid + 512 * e; if (idx < 3 * 68 * 16) { const int ch = idx & 15, rr = (idx >> 4) % 68, t = (idx >> 4) / 68; *(LAS u32x4*)(RAW + (t * 68 + rr) * LD + ch * 8) = P.raw[e]; } }
        if (tid < 480) { const int t = tid / 160, j = (tid % 160) >> 5, c4 = tid & 31; *(LAS f32x4*)(CW + (t * 5 + j) * 128 + c4 * 4) = P.cw; }
        if (wave < 2) { const int d = wave; const int i = d ? 63 - lane : lane;
            const float g = -__expf(a_log[d * 8 + h]) * softplus_f(P.ga + dt_bias[d * 8 + h]);
            float s = g;
#pragma unroll
            for (int o = 1; o < 64; o <<= 1) { const float t = __shfl_up(s, o); if (lane >= o) s += t; }
            const float gt_ = __shfl(s, 63);
            GC[d * 64 + i] = s; EGC[d * 64 + i] = __expf(s); EKD[d * 64 + i] = __expf(gt_ - s); BETA[d * 64 + i] = __builtin_amdgcn_rcpf(1.f + __expf(-P.gb));
            if (lane == 63) GTOT[d] = s; }
        LBAR();
        { const int nxt = item + stride; if (nxt < NITEMS) { const GdnItem In = gdn_decode(nxt); gdn_prefetch(P, In, tid, lane, wave, PQKV, PAB, convw); } }
#ifndef REPG
#define REPG 0
#endif
#define GS(k) for (int gq_ = 0; gq_ <= ((REPG >> (k)) & 1); ++gq_)
        GS(1) {
        CVT_HOOK_ISSUE();
        { int tt = tid; asm volatile("" : "+v"(tt)); const int cgp = tt & 31, tg = tt >> 5;
#pragma unroll
            for (int t = 0; t < 3; ++t) {
                f32x4 w[5];
#pragma unroll
                for (int j = 0; j < 5; ++j) w[j] = *(const LAS f32x4*)(CW + (t * 5 + j) * 128 + 4 * cgp);
                f32x4 x[8];
#pragma unroll
                for (int rr = 0; rr < 8; ++rr) { const u32x2 q = *(const LAS u32x2*)(RAW + (t * 68 + 4 * tg + rr) * LD + 4 * cgp); x[rr] = (f32x4){bf2f(q.x & 0xffffu), bf2f(q.x >> 16), bf2f(q.y & 0xffffu), bf2f(q.y >> 16)}; }
                f32x4 y[4]; float ss[4];
#pragma unroll
                for (int k = 0; k < 4; ++k) { f32x4 acc = w[0] * x[k];
#pragma unroll
                    for (int j = 1; j < 5; ++j) acc += w[j] * x[k + j];
                    acc.x = silu_f(acc.x); acc.y = silu_f(acc.y); acc.z = silu_f(acc.z); acc.w = silu_f(acc.w);
                    y[k] = acc; ss[k] = (acc.x * acc.x + acc.y * acc.y) + (acc.z * acc.z + acc.w * acc.w); }
                if (t < 2) {
#pragma unroll
                    for (int k = 0; k < 4; ++k) { float v = ss[k]; v += dpp_xor1(v); v += dpp_xor2(v); v += __shfl_xor(v, 4); v += __shfl_xor(v, 8); v += __shfl_xor(v, 16);
                        float sc = __builtin_amdgcn_rsqf(v + EPS); if (t == 0) sc *= 0.08838834764831845f; y[k] = y[k] * sc; } }
                LAS bf16_t* dst = (t == 0 ? QN : (t == 1 ? KN : VI)) + (4 * tg) * LD + 4 * cgp;
#pragma unroll
                for (int k = 0; k < 4; ++k) { u32x2 o; o.x = pk2(y[k].x, y[k].y); o.y = pk2(y[k].z, y[k].w); *(LAS u32x2*)(dst + k * LD) = o; }
            }
        }
        CVT_HOOK_FINISH();
        LBAR();
        }
        GS(2) {
        { const int which = wave >> 2, ti = (wave >> 1) & 1, tj = wave & 1; f32x16 acc = Z16;
            { bf16x8 fa[8], fb[8];
#pragma unroll
                for (int ks = 0; ks < 8; ++ks) { fa[ks] = frag_row(which ? QN : KN, LD, 32 * ti, 16 * ks, lane); fb[ks] = frag_row(KN, LD, 32 * tj, 16 * ks, lane); }
                __builtin_amdgcn_sched_barrier(0);
#pragma unroll
                for (int ks = 0; ks < 8; ++ks) acc = MFMA32(fa[ks], fb[ks], acc); }
            const int j = 32 * tj + (lane & 31); const float g0j = GC[j], g1j = GC[64 + j];
#pragma unroll
            for (int g4 = 0; g4 < 4; ++g4) { const int i0 = 32 * ti + 8 * g4 + 4 * (lane >> 5);
                const f32x4 g0i = *(const LAS f32x4*)(GC + i0), g1i = *(const LAS f32x4*)(GC + 64 + i0), b0i = *(const LAS f32x4*)(BETA + i0), b1i = *(const LAS f32x4*)(BETA + 64 + i0);
#pragma unroll
                for (int e = 0; e < 4; ++e) { const int i = i0 + e; const float a_ = acc[4 * g4 + e];
                    const bool lo = j < i, hi = j > i;
                    const float ex = __expf(lo ? (g0i[e] - g0j) : (hi ? (g1i[e] - g1j) : 0.f));
                    if (which == 0) { const float v = a_ * ex * (lo ? b0i[e] : b1i[e]); const float v0 = lo ? v : 0.f, v1 = hi ? v : 0.f; const int il = 63 - i, jl = 63 - j;
                        MB[(0 * 64 + i) * LDT_ + j] = (bf16_t)f2bf(v0); MB[(1 * 64 + il) * LDT_ + jl] = (bf16_t)f2bf(v1);
                        if ((i >> 4) == (j >> 4)) { MPD[((0 * 4 + (i >> 4)) * 16 + (i & 15)) * 16 + (j & 3) * 4 + ((j & 15) >> 2)] = v0; MPD[((1 * 4 + (il >> 4)) * 16 + (il & 15)) * 16 + (jl & 3) * 4 + ((jl & 15) >> 2)] = v1; } }
                    else { const float v = a_ * ex; QKB[(0 * 64 + i) * LDT_ + j] = (bf16_t)f2bf(hi ? 0.f : v); QKB[(1 * 64 + i) * LDT_ + j] = (bf16_t)f2bf(lo ? 0.f : v); } } }
        }
        LBAR();
        }
        GS(3) {
        CVT_HOOK_ISSUE();
        { const int d = wave >> 2, a_ = wave & 3; const int c = lane >> 2, r = lane & 3; float T[4] = {0.f, 0.f, 0.f, 0.f};
            LAS bf16_t* TId = TI + d * 64 * LDT_;
            { LAS unsigned* z = (LAS unsigned*)(TId + 16 * a_ * LDT_);
#pragma unroll
                for (int e = 0; e < 9; ++e) z[lane + 64 * e] = 0u; }
            const LAS float* mp = MPD + ((d * 4 + a_) * 16) * 16 + r * 4;
            f32x4 md[16];
#pragma unroll
            for (int rr = 0; rr < 16; ++rr) md[rr] = *(const LAS f32x4*)(mp + rr * 16);
#pragma unroll
            for (int rr = 0; rr < 16; ++rr) { float acc = (md[rr].x * T[0] + md[rr].y * T[1]) + (md[rr].z * T[2] + md[rr].w * T[3]);
                acc += dpp_xor1(acc); acc += dpp_xor2(acc);
                const float t = (rr == c ? 1.f : 0.f) - acc;
                if (r == (rr & 3)) T[rr >> 2] = t; }
            LDS_WAIT();
#pragma unroll
            for (int q = 0; q < 4; ++q) TId[(16 * a_ + 4 * q + r) * LDT_ + 16 * a_ + c] = (bf16_t)f2bf(T[q]);
        }
        LBAR();
        { const int d = wave >> 2, hsel = wave & 3; LAS bf16_t* TId = TI + d * 64 * LDT_; LAS bf16_t* PId = PI + d * 64 * LDT_; const LAS bf16_t* MBd = MB + d * 64 * LDT_;
            if (hsel < 2) { const int o = 32 * hsel;
                f32x16 p = Z16;
#pragma unroll
                for (int ks = 0; ks < 2; ++ks) p = MFMA32(frag_row(MBd, LDT_, o, o + 16 * ks, lane), frag_tr(TId, LDT_, o, o + 16 * ks, lane), p);
#pragma unroll
                for (int rg = 0; rg < 16; ++rg) PId[(o + crow(rg, lane)) * LDT_ + o + (lane & 31)] = (bf16_t)f2bf(p[rg]);
                LDS_WAIT();
                f32x16 q = Z16;
#pragma unroll
                for (int ks = 0; ks < 2; ++ks) q = MFMA32(frag_row(TId, LDT_, o, o + 16 * ks, lane), frag_tr(PId, LDT_, o, o + 16 * ks, lane), q);
                if ((lane & 31) < 16) {
#pragma unroll
                    for (int rg = 8; rg < 16; ++rg) TId[(o + crow(rg, lane)) * LDT_ + o + (lane & 31)] = (bf16_t)f2bf(-q[rg]); } }
        }
        LBAR();
        { const int d = wave >> 2, hsel = wave & 3; LAS bf16_t* TId = TI + d * 64 * LDT_; LAS bf16_t* PId = PI + d * 64 * LDT_; const LAS bf16_t* MBd = MB + d * 64 * LDT_;
            if (hsel == 0) {
                f32x16 p = Z16;
#pragma unroll
                for (int ks = 0; ks < 2; ++ks) p = MFMA32(frag_row(MBd, LDT_, 32, 16 * ks, lane), frag_tr(TId, LDT_, 0, 16 * ks, lane), p);
#pragma unroll
                for (int rg = 0; rg < 16; ++rg) PId[(32 + crow(rg, lane)) * LDT_ + (lane & 31)] = (bf16_t)f2bf(p[rg]);
                LDS_WAIT();
                f32x16 q = Z16;
#pragma unroll
                for (int ks = 0; ks < 2; ++ks) q = MFMA32(frag_row(TId, LDT_, 32, 32 + 16 * ks, lane), frag_tr(PId, LDT_, 0, 32 + 16 * ks, lane), q);
#pragma unroll
                for (int rg = 0; rg < 16; ++rg) TId[(32 + crow(rg, lane)) * LDT_ + (lane & 31)] = (bf16_t)f2bf(-q[rg]); }
        }
        LBAR();
        { int tt = tid; asm volatile("" : "+v"(tt)); const int d = tt >> 8, t2 = tt & 255;
            if (d == 0) {
#pragma unroll
                for (int e = 0; e < 16; ++e) { const int idx = t2 + 256 * e, i = idx >> 6, j = idx & 63; const float t = bf2f(TI[i * LDT_ + j]); const float bj = BETA[j];
                    TB[i * LDT_ + j] = (bf16_t)f2bf(t * bj); TBG[i * LDT_ + j] = (bf16_t)f2bf(t * bj * EGC[j]); } }
            else {
#pragma unroll
                for (int e = 0; e < 8; ++e) { const int idx = t2 + 256 * e, p = idx >> 6, q = idx & 63, p2 = 63 - p, q2 = 63 - q;
                    const float ta = bf2f(TI[(64 + p) * LDT_ + q]), tb = bf2f(TI[(64 + p2) * LDT_ + q2]); const float b1 = BETA[64 + q], b2 = BETA[64 + q2];
                    TB[(64 + p) * LDT_ + q] = (bf16_t)f2bf(tb * b1); TB[(64 + p2) * LDT_ + q2] = (bf16_t)f2bf(ta * b2);
                    TBG[(64 + p) * LDT_ + q] = (bf16_t)f2bf(tb * b1 * EGC[64 + q]); TBG[(64 + p2) * LDT_ + q2] = (bf16_t)f2bf(ta * b2 * EGC[64 + q2]); } }
        }
        CVT_HOOK_FINISH();
        LBAR();
        }
        GS(4) {
        CVT_HOOK_ISSUE();
        { const int d = wave >> 2, wq = wave & 3; unsigned char* rec = GREC + rec_index(isctx, b, h, d, c) * REC_BYTES;
            bf16_t* uT = (bf16_t*)(rec + REC_UT); bf16_t* wout = (bf16_t*)(rec + REC_W);
#pragma unroll
            for (int it = 0; it < 2; ++it) { f32x16 au = Z16, aw = Z16;
                { bf16x8 f1[4], f2[4], f3[4], f4[4];
#pragma unroll
                    for (int ks = 0; ks < 4; ++ks) { f1[ks] = frag_row(TB + d * 64 * LDT_, LDT_, 32 * it, 16 * ks, lane); f2[ks] = frag_tr(VI, LD, 32 * wq, 16 * ks, lane);
                        f3[ks] = frag_tr(KN, LD, 32 * wq, 16 * ks, lane); f4[ks] = frag_row(TBG + d * 64 * LDT_, LDT_, 32 * it, 16 * ks, lane); }
                    __builtin_amdgcn_sched_barrier(0);
#pragma unroll
                    for (int ks = 0; ks < 4; ++ks) { au = MFMA32(f1[ks], f2[ks], au); aw = MFMA32(f3[ks], f4[ks], aw); } }
#pragma unroll
                for (int g4 = 0; g4 < 4; ++g4) { u32x2 pu, pw; pu.x = pk2(au[4 * g4], au[4 * g4 + 1]); pu.y = pk2(au[4 * g4 + 2], au[4 * g4 + 3]); pw.x = pk2(aw[4 * g4], aw[4 * g4 + 1]); pw.y = pk2(aw[4 * g4 + 2], aw[4 * g4 + 3]);
                    *(GAS u32x2*)(uT + (32 * wq + (lane & 31)) * 64 + 32 * it + 8 * g4 + 4 * (lane >> 5)) = pu;
                    *(GAS u32x2*)(wout + (32 * it + (lane & 31)) * 128 + 32 * wq + 8 * g4 + 4 * (lane >> 5)) = pw; } }
        }
        { int tt = tid; asm volatile("" : "+v"(tt)); const int d = tt >> 8, t2 = tt & 255; unsigned char* rec = GREC + rec_index(isctx, b, h, d, c) * REC_BYTES; const float gtot = GTOT[d];
#pragma unroll
            for (int e = 0; e < 4; ++e) { const int idx = t2 + 256 * e, i = idx >> 4, ch = idx & 15; const float sc = EGC[d * 64 + i];
                const u32x4 v = *(const LAS u32x4*)(QN + i * LD + ch * 8); const unsigned rw[4] = {v.x, v.y, v.z, v.w}; u32x4 o; unsigned ow[4];
#pragma unroll
                for (int q = 0; q < 4; ++q) ow[q] = pk2(bf2f(rw[q] & 0xffffu) * sc, bf2f(rw[q] >> 16) * sc);
                o.x = ow[0]; o.y = ow[1]; o.z = ow[2]; o.w = ow[3];
                *(GAS u32x4*)(rec + REC_QD + (i * 128 + ch * 8) * 2) = o; }
#pragma unroll
            for (int e = 0; e < 4; ++e) { const int idx = t2 + 256 * e, k = idx >> 3, ci = idx & 7; float o[8];
#pragma unroll
                for (int q = 0; q < 8; ++q) { const int i = 8 * ci + q; o[q] = bf2f(KN[i * LD + k]) * EKD[d * 64 + i]; }
                u32x4 w; w.x = pk2(o[0], o[1]); w.y = pk2(o[2], o[3]); w.z = pk2(o[4], o[5]); w.w = pk2(o[6], o[7]);
                *(GAS u32x4*)(rec + REC_KDT + (k * 64 + 8 * ci) * 2) = w; }
#pragma unroll
            for (int e = 0; e < 2; ++e) { const int idx = t2 + 256 * e, i = idx >> 3, cj = idx & 7;
                *(GAS u32x4*)(rec + REC_QK + (i * 64 + 8 * cj) * 2) = *(const LAS u32x4*)(QKB + (d * 64 + i) * LDT_ + 8 * cj); }
            if (t2 == 0) *(float*)(rec + REC_GT) = __expf(gtot);
        }
        CVT_HOOK_FINISH();
        LBAR();
        }
    }
    while (cs.left > 0) { cvt_issue(cj, cvt_next(cs, cvq, tid_f_ & 63), tid_f_ & 63, wg, wu, wd); cvt_finish(cj, tid_f_ & 63, WGU, WDN); }
#undef CVT_HOOK_ISSUE
#undef CVT_HOOK_FINISH
}

__device__ __forceinline__ void gdn_scan_unit(LAS unsigned char* L, int unit, const unsigned char* GREC, bf16_t* OF, bf16_t* OB) {
    int tid_o_ = threadIdx.x; asm volatile("" : "+v"(tid_o_)); const int tid = tid_o_, lane = tid & 63, wave = __builtin_amdgcn_readfirstlane(tid >> 6);
    constexpr int LD = 136, LDS_ = 72;
    LAS bf16_t* ST = (LAS bf16_t*)L;
    LAS bf16_t* Wl = (LAS bf16_t*)(L + 34816);
    LAS bf16_t* QDl = (LAS bf16_t*)(L + 52224);
    LAS bf16_t* KDTl = (LAS bf16_t*)(L + 69632);
    LAS bf16_t* QKl = (LAS bf16_t*)(L + 88064);
    LAS bf16_t* VNT = (LAS bf16_t*)(L + 97280);
    const int b = unit >> 4, h = (unit >> 1) & 7, d = unit & 1;
    bf16_t* O = d ? OB : OF;
    for (int i = tid; i < 128 * LD / 8; i += NTHREADS) *(LAS u32x4*)(ST + i * 8) = (u32x4){0u, 0u, 0u, 0u};
    f32x16 S0 = Z16, S1 = Z16;
    const int kt = wave >> 1, vt0 = 2 * (wave & 1);
    struct ScanOps { u32x4 rg[7]; u32x2 u[4]; float gt; };
    auto rec_of = [&](int s) -> const unsigned char* { const bool isctx = s < 4; const int cs = isctx ? s : s - 4; const int c = isctx ? (d ? 3 - cs : cs) : (d ? 63 - cs : cs);
        return GREC + rec_index(isctx, b, h, d, c) * REC_BYTES; };
    auto load_ops = [&](ScanOps& o, int s) { const unsigned char* rec = rec_of(s); const bool withq = s >= 4;
#pragma unroll
        for (int e = 0; e < 2; ++e) { const int idx = tid + 512 * e; o.rg[e] = *(const GAS u32x4*)(rec + REC_W + idx * 16); o.rg[4 + e] = *(const GAS u32x4*)(rec + REC_KDT + idx * 16); }
        if (withq) {
#pragma unroll
            for (int e = 0; e < 2; ++e) { const int idx = tid + 512 * e; o.rg[2 + e] = *(const GAS u32x4*)(rec + REC_QD + idx * 16); }
            o.rg[6] = *(const GAS u32x4*)(rec + REC_QK + tid * 16); }
        { const int it = wave >> 2, vt = wave & 3; const bf16_t* uT = (const bf16_t*)(rec + REC_UT) + (32 * vt + (lane & 31)) * 64 + 32 * it + 4 * (lane >> 5);
#pragma unroll
            for (int g4 = 0; g4 < 4; ++g4) o.u[g4] = *(const GAS u32x2*)(uT + 8 * g4); }
        o.gt = *(const float*)(rec + REC_GT);
    };
    auto step = [&](ScanOps& o, int s) {
        const bool isctx = s < 4;
#pragma unroll
        for (int e = 0; e < 2; ++e) { const int idx = tid + 512 * e; *(LAS u32x4*)(Wl + (idx >> 4) * LD + (idx & 15) * 8) = o.rg[e]; *(LAS u32x4*)(KDTl + (idx >> 3) * LDS_ + (idx & 7) * 8) = o.rg[4 + e]; }
        if (!isctx) {
#pragma unroll
            for (int e = 0; e < 2; ++e) { const int idx = tid + 512 * e; *(LAS u32x4*)(QDl + (idx >> 4) * LD + (idx & 15) * 8) = o.rg[2 + e]; }
            *(LAS u32x4*)(QKl + (tid >> 3) * LDS_ + (tid & 7) * 8) = o.rg[6]; }
        const float gt = o.gt; u32x2 uc[4];
#pragma unroll
        for (int g4 = 0; g4 < 4; ++g4) uc[g4] = o.u[g4];
        LBAR();
        if (s + 2 < 68) load_ops(o, s + 2);
        const int it = wave >> 2, vt = wave & 3;
        { bf16x8 fw[8], fs[8];
#pragma unroll
            for (int ks = 0; ks < 8; ++ks) { fw[ks] = frag_row(Wl, LD, 32 * it, 16 * ks, lane); fs[ks] = frag_row(ST, LD, 32 * vt, 16 * ks, lane); }
            __builtin_amdgcn_sched_barrier(0);
            f32x16 acc = Z16;
#pragma unroll
            for (int ks = 0; ks < 8; ++ks) acc = MFMA32(fw[ks], fs[ks], acc);
#pragma unroll
            for (int g4 = 0; g4 < 4; ++g4) { const u32x2 uu = uc[g4];
                const float v0 = bf2f(uu.x & 0xffffu) - acc[4 * g4], v1 = bf2f(uu.x >> 16) - acc[4 * g4 + 1], v2 = bf2f(uu.y & 0xffffu) - acc[4 * g4 + 2], v3 = bf2f(uu.y >> 16) - acc[4 * g4 + 3];
                u32x2 p; p.x = pk2(v0, v1); p.y = pk2(v2, v3);
                *(LAS u32x2*)(VNT + (32 * vt + (lane & 31)) * LDS_ + 32 * it + 8 * g4 + 4 * (lane >> 5)) = p; } }
        LBAR();
        bf16x8 fk[4], fv0[4], fv1[4];
#pragma unroll
        for (int ks = 0; ks < 4; ++ks) { fk[ks] = frag_row(KDTl, LDS_, 32 * kt, 16 * ks, lane); fv0[ks] = frag_row(VNT, LDS_, 32 * vt0, 16 * ks, lane); fv1[ks] = frag_row(VNT, LDS_, 32 * (vt0 + 1), 16 * ks, lane); }
        __builtin_amdgcn_sched_barrier(0);
        { S0 = S0 * gt; S1 = S1 * gt;
#pragma unroll
            for (int ks = 0; ks < 4; ++ks) { S0 = MFMA32(fk[ks], fv0[ks], S0); S1 = MFMA32(fk[ks], fv1[ks], S1); } }
        if (!isctx) { f32x16 acc = Z16;
            { bf16x8 fq[8], fs[8];
#pragma unroll
                for (int ks = 0; ks < 8; ++ks) { fs[ks] = frag_row(ST, LD, 32 * vt, 16 * ks, lane); fq[ks] = frag_row(QDl, LD, 32 * it, 16 * ks, lane); }
                __builtin_amdgcn_sched_barrier(0);
#pragma unroll
                for (int ks = 0; ks < 8; ++ks) acc = MFMA32(fs[ks], fq[ks], acc); }
            { bf16x8 fvn[4], fqk[4];
#pragma unroll
                for (int ks = 0; ks < 4; ++ks) { fvn[ks] = frag_row(VNT, LDS_, 32 * vt, 16 * ks, lane); fqk[ks] = frag_row(QKl, LDS_, 32 * it, 16 * ks, lane); }
                __builtin_amdgcn_sched_barrier(0);
#pragma unroll
                for (int ks = 0; ks < 4; ++ks) acc = MFMA32(fvn[ks], fqk[ks], acc); }
            const int cs = s - 4, c = d ? 63 - cs : cs;
            bf16_t* op = O + (size_t)(b * SEQ + c * 64 + 32 * it + (lane & 31)) * GDW + h * HD + 32 * vt + 4 * (lane >> 5);
#pragma unroll
            for (int g4 = 0; g4 < 4; ++g4) { u32x2 p; p.x = pk2(acc[4 * g4], acc[4 * g4 + 1]); p.y = pk2(acc[4 * g4 + 2], acc[4 * g4 + 3]); *(GAS u32x2*)(op + 8 * g4) = p; } }
        LBAR();
#pragma unroll
        for (int g4 = 0; g4 < 4; ++g4) { u32x2 p0, p1; p0.x = pk2(S0[4 * g4], S0[4 * g4 + 1]); p0.y = pk2(S0[4 * g4 + 2], S0[4 * g4 + 3]); p1.x = pk2(S1[4 * g4], S1[4 * g4 + 1]); p1.y = pk2(S1[4 * g4 + 2], S1[4 * g4 + 3]);
            *(LAS u32x2*)(ST + (32 * vt0 + (lane & 31)) * LD + 32 * kt + 8 * g4 + 4 * (lane >> 5)) = p0;
            *(LAS u32x2*)(ST + (32 * (vt0 + 1) + (lane & 31)) * LD + 32 * kt + 8 * g4 + 4 * (lane >> 5)) = p1; }
    };
    ScanOps A, B;
    load_ops(A, 0); load_ops(B, 1);
#pragma unroll 1
    for (int s = 0; s < 68; s += 2) { step(A, s); step(B, s + 1); }
    LBAR();
}

struct Args { const float* in[19]; float* out; unsigned char* ws; int ph_lo, ph_hi; };
enum { I_X = 0, I_C, I_CTX, I_CCTX, I_WMOD, I_BMOD, I_N1G, I_N2G, I_WIN, I_CONVW, I_ALOG, I_DTB, I_GNW, I_WOUT, I_WROUTER, I_WGATE, I_WUP, I_WDOWN, I_NORMF };

struct XposeItem { const float* src; int ldn, ncols, k0, n0; bf16_t* dst; int dstK; int mode; };
__device__ __forceinline__ int xpose_row(const XposeItem& it, int n) { return it.mode == 0 ? n : (256 * (n >> 7) + 128 * (it.mode - 1) + (n & 127)); }
__device__ __forceinline__ void xpose_load(const XposeItem& it, f32x4 (&r)[8], int tid) {
    const int n = it.n0 + 4 * (tid & 63);
#pragma unroll
    for (int j = 0; j < 8; ++j) { const int k = it.k0 + (tid >> 6) + 8 * j;
        if (n + 3 < it.ncols) r[j] = *(const GAS f32x4*)(it.src + (size_t)k * it.ldn + n);
        else { f32x4 v = {0.f, 0.f, 0.f, 0.f}; const float* p = it.src + (size_t)k * it.ldn; if (n < it.ncols) v.x = p[n]; if (n + 1 < it.ncols) v.y = p[n + 1]; if (n + 2 < it.ncols) v.z = p[n + 2]; r[j] = v; } }
}
__device__ __forceinline__ void xpose_store_lds(LAS float* T, const f32x4 (&r)[8], int tid) {
#pragma unroll
    for (int j = 0; j < 8; ++j) *(LAS f32x4*)(T + ((tid >> 6) + 8 * j) * 260 + 4 * (tid & 63)) = r[j];
}
__device__ __forceinline__ void xpose_emit(const XposeItem& it, const LAS float* T, int tid) {
    const int kc = tid & 7;
#pragma unroll
    for (int j = 0; j < 4; ++j) { const int nl = (tid >> 3) + 64 * j, n = it.n0 + nl;
        const LAS float* s = T + (8 * kc) * 260 + nl;
        u32x4 o; o.x = pk2(s[0], s[260]); o.y = pk2(s[2 * 260], s[3 * 260]); o.z = pk2(s[4 * 260], s[5 * 260]); o.w = pk2(s[6 * 260], s[7 * 260]);
        if (n < it.ncols) *(GAS u32x4*)(it.dst + (size_t)xpose_row(it, n) * it.dstK + it.k0 + 8 * kc) = o; }
}


__device__ __forceinline__ void moe_convert(LAS unsigned char* L, volatile LAS unsigned* MISC, unsigned* q, const float* wg, const float* wu, const float* wd, bf16_t* WGU, bf16_t* WDN, int maxpulls) {
    int tid_o_ = threadIdx.x; asm volatile("" : "+v"(tid_o_)); const int tid = tid_o_;
    __syncthreads();
    LAS float* T = (LAS float*)L;
    constexpr int NIT = 3 * 3072;
    auto mk = [&](int it) { XposeItem x; if (it < 6144) { const int up = it >= 3072, r0 = it - up * 3072, e = r0 / 192, r = r0 % 192; x.src = (up ? wu : wg) + (size_t)e * D_MODEL * FF; x.ldn = FF; x.ncols = FF; x.k0 = 64 * (r / 6); x.n0 = 256 * (r % 6);
            x.dst = WGU + (size_t)e * 2 * FF * D_MODEL; x.dstK = D_MODEL; x.mode = 1 + up; }
        else { const int r0 = it - 6144, e = r0 / 192, r = r0 % 192; x.src = wd + (size_t)e * FF * D_MODEL; x.ldn = D_MODEL; x.ncols = D_MODEL; x.k0 = 64 * (r / 8); x.n0 = 256 * (r % 8);
            x.dst = WDN + (size_t)e * D_MODEL * FF; x.dstK = FF; x.mode = 0; } return x; };
    f32x4 r[8];
    int pulls = 0;
    if (tid == 0) MISC[18] = maxpulls > 0 ? atomicAdd(q, 1u) : (unsigned)NIT;
    ++pulls;
    __syncthreads();
    int it = (int)MISC[18];
    if (it < NIT) { XposeItem x = mk(it); xpose_load(x, r, tid); }
    for (int qn = 0; it < NIT; ++qn) {
        XposeItem x = mk(it);
        xpose_store_lds(T, r, tid);
        if (tid == 0) MISC[19 + (qn & 1)] = pulls < maxpulls ? atomicAdd(q, 1u) : (unsigned)NIT;
        ++pulls;
        __syncthreads();
        const int nx = (int)MISC[19 + (qn & 1)];
        if (nx < NIT) { XposeItem y = mk(nx); xpose_load(y, r, tid); }
        xpose_emit(x, T, tid);
        __syncthreads();
        it = nx;
    }
}
struct SchedIn {
    const char* A; const char* B; int G, c;
    __device__ __forceinline__ bool next(int i, pg8::Unit& u) const {
        const int L = i * G + c; constexpr int NX = 64 * 21, NC = 4 * 13;
        if (L >= NX + NC) return false;
        int pm, pn;
        if (L < NX) { int wgid = L; { const int q = NX / 8, xcd = wgid % 8, off = wgid / 8; wgid = xcd * q + off; }
            const int nig = 8 * 21, gid = wgid / nig, fm = gid * 8; pm = fm + ((wgid % nig) % 8); pn = (wgid % nig) / 8; }
        else { const int r = L - NX; pm = 64 + r / 13; const int j = r % 13; pn = j < 12 ? 4 + j : 20; }
        u.pm = pm; u.pn = pn; u.aux = 0; u.gidx = nullptr;
        u.a = A + (size_t)pm * 256 * D_MODEL * 2; u.b = B + (size_t)pn * 256 * D_MODEL * 2; return true;
    }
};

struct EpiIn {
    static constexpr bool PERM = true;
    bf16_t* pf; bf16_t* pqkv; bf16_t* pz; float* pab;
    __device__ __forceinline__ void operator()(const f32x4 (&acc)[2][2][4][2], const pg8::Unit& u, int wr, int wc, int fr, int fq) const {
        const int row0 = u.pm * 256 + wr * 64 + fr; const int pn = u.pn;
        if (pn == 20) {
            if (wc == 0) {
#pragma unroll
                for (int ai = 0; ai < 2; ++ai)
#pragma unroll
                    for (int m = 0; m < 4; ++m) { float* rp = pab + (size_t)(row0 + ai * 128 + m * 16) * 32 + 8 * fq;
                        *(GAS f32x4*)rp = acc[ai][0][m][0]; *(GAS f32x4*)(rp + 4) = acc[ai][0][m][1]; }
            }
            return;
        }
        bf16_t* base; int ld, c0;
        if (pn < 4) { base = pf; ld = FW; c0 = pn * 256; } else if (pn < 16) { base = pqkv; ld = 3 * GDW; c0 = (pn - 4) * 256; } else { base = pz; ld = GDW; c0 = (pn - 16) * 256; }
        const int col0 = c0 + wc * 32 + 8 * fq;
#pragma unroll
        for (int ai = 0; ai < 2; ++ai)
#pragma unroll
            for (int m = 0; m < 4; ++m) { bf16_t* rowp = base + (size_t)(row0 + ai * 128 + m * 16) * ld + col0;
#pragma unroll
                for (int bj = 0; bj < 2; ++bj) { const f32x4 v0 = acc[ai][bj][m][0], v1 = acc[ai][bj][m][1];
                    u32x4 w; w.x = pk2(v0[0], v0[1]); w.y = pk2(v0[2], v0[3]); w.z = pk2(v1[0], v1[1]); w.w = pk2(v1[2], v1[3]);
                    *(GAS u32x4*)(rowp + bj * 128) = w; } }
    }
};

struct SchedOut {
    const char* A; const char* B; int G, c;
    __device__ __forceinline__ bool next(int i, pg8::Unit& u) const {
        const int Lq = i * G + c; constexpr int NU = 64 * 8;
        if (Lq >= NU) return false;
        int wgid = Lq; { const int q = NU / 8, xcd = wgid % 8, off = wgid / 8; wgid = xcd * q + off; }
        const int nig = 8 * 8, gid = wgid / nig, fm = gid * 8; const int pm = fm + ((wgid % nig) % 8), pn = (wgid % nig) / 8;
        u.pm = pm; u.pn = pn; u.aux = 0; u.gidx = nullptr;
        u.a = A + (size_t)pm * 256 * D_MODEL * 2; u.b = B + (size_t)pn * 256 * D_MODEL * 2; return true;
    }
};

struct EpiOut {
    static constexpr bool PERM = true;
    const float* x; const float* mod; bf16_t* x2;
    __device__ __forceinline__ void operator()(const f32x4 (&acc)[2][2][4][2], const pg8::Unit& u, int wr, int wc, int fr, int fq) const {
        const int row0 = u.pm * 256 + wr * 64 + fr, col0 = u.pn * 256 + wc * 32 + 8 * fq;
        const float* gt = mod + (u.pm >> 4) * 12288 + 2 * 2048;
        f32x4 gv[2][2];
#pragma unroll
        for (int bj = 0; bj < 2; ++bj)
#pragma unroll
            for (int n = 0; n < 2; ++n) gv[bj][n] = *(const GAS f32x4*)(gt + col0 + bj * 128 + n * 4);
#pragma unroll
        for (int ai = 0; ai < 2; ++ai)
#pragma unroll
            for (int m = 0; m < 4; ++m) { const size_t off = (size_t)(row0 + ai * 128 + m * 16) * D_MODEL + col0;
#pragma unroll
                for (int bj = 0; bj < 2; ++bj) { const f32x4 x0 = *(const GAS f32x4*)(x + off + bj * 128), x1 = *(const GAS f32x4*)(x + off + bj * 128 + 4);
                    const f32x4 y0 = x0 + gv[bj][0] * acc[ai][bj][m][0], y1 = x1 + gv[bj][1] * acc[ai][bj][m][1];
                    u32x4 w; w.x = pk2(y0[0], y0[1]); w.y = pk2(y0[2], y0[3]); w.z = pk2(y1[0], y1[1]); w.w = pk2(y1[2], y1[3]);
                    *(GAS u32x4*)(x2 + off + bj * 128) = w; } }
    }
};


struct SchedGU {
    const char* HX2; const char* W; const int* IDX; int G, c;
    __device__ __forceinline__ bool next(int i, pg8::Unit& u) const {
        const int L = i * G + c; if (L >= 1536) return false;
        int wt, rt;
        if (G == 256) { const int xcd = c & 7, j = c >> 3; wt = (i * 8 + xcd) * 4 + (j >> 3); rt = j & 7; } else { wt = L >> 3; rt = L & 7; }
        const int e = wt / 12, pn = wt % 12, b = rt >> 1, mt = rt & 1;
        u.pm = (b * NE + e) * 2 + mt; u.pn = pn; u.aux = 0;
        u.a = HX2 + (size_t)b * SEQ * D_MODEL * 2; u.gidx = IDX + (b * NE + e) * CAP + mt * 256;
        u.b = W + ((size_t)e * 2 * FF + (size_t)pn * 256) * D_MODEL * 2; return true;
    }
};
struct EpiGU {
    static constexpr bool PERM = true;
    bf16_t* hid;
    __device__ __forceinline__ void operator()(const f32x4 (&acc)[2][2][4][2], const pg8::Unit& u, int wr, int wc, int fr, int fq) const {
        const int row0 = u.pm * 256 + wr * 64 + fr, col0 = u.pn * 128 + wc * 32 + 8 * fq;
#pragma unroll
        for (int ai = 0; ai < 2; ++ai)
#pragma unroll
            for (int m = 0; m < 4; ++m) { const f32x4 g0 = acc[ai][0][m][0], g1 = acc[ai][0][m][1], u0 = acc[ai][1][m][0], u1 = acc[ai][1][m][1];
                u32x4 w; w.x = pk2(silu_f(g0[0]) * u0[0], silu_f(g0[1]) * u0[1]); w.y = pk2(silu_f(g0[2]) * u0[2], silu_f(g0[3]) * u0[3]);
                w.z = pk2(silu_f(g1[0]) * u1[0], silu_f(g1[1]) * u1[1]); w.w = pk2(silu_f(g1[2]) * u1[2], silu_f(g1[3]) * u1[3]);
                *(GAS u32x4*)(hid + (size_t)(row0 + ai * 128 + m * 16) * FF + col0) = w; }
    }
};
struct SchedDN {
    const char* HID; const char* W; int G, c;
    __device__ __forceinline__ bool next(int i, pg8::Unit& u) const {
        const int L = i * G + c; if (L >= 1024) return false;
        int wt, rt;
        if (G == 256) { const int xcd = c & 7, j = c >> 3; wt = (i * 8 + xcd) * 4 + (j >> 3); rt = j & 7; } else { wt = L >> 3; rt = L & 7; }
        const int e = wt >> 3, pn = wt & 7, b = rt >> 1, mt = rt & 1;
        u.pm = (b * NE + e) * 2 + mt; u.pn = pn; u.aux = 0; u.gidx = nullptr;
        u.a = HID + (size_t)u.pm * 256 * FF * 2; u.b = W + ((size_t)e * D_MODEL + (size_t)pn * 256) * FF * 2; return true;
    }
};
struct EpiDN {
    static constexpr bool PERM = true;
    bf16_t* yb; const float* val;
    __device__ __forceinline__ void operator()(const f32x4 (&acc)[2][2][4][2], const pg8::Unit& u, int wr, int wc, int fr, int fq) const {
        const int row0 = u.pm * 256 + wr * 64 + fr, col0 = u.pn * 256 + wc * 32 + 8 * fq;
#pragma unroll
        for (int ai = 0; ai < 2; ++ai)
#pragma unroll
            for (int m = 0; m < 4; ++m) { const int row = row0 + ai * 128 + m * 16; const float vv = val[row]; bf16_t* rowp = yb + (size_t)row * D_MODEL + col0;
#pragma unroll
                for (int bj = 0; bj < 2; ++bj) { const f32x4 v0 = acc[ai][bj][m][0] * vv, v1 = acc[ai][bj][m][1] * vv;
                    u32x4 w; w.x = pk2(v0[0], v0[1]); w.y = pk2(v0[2], v0[3]); w.z = pk2(v1[0], v1[1]); w.w = pk2(v1[2], v1[3]);
                    *(GAS u32x4*)(rowp + bj * 128) = w; } }
    }
};

__device__ __forceinline__ unsigned block_excl_scan(unsigned v, LAS unsigned* scr, int tid, int lane, int wave, unsigned& total) {
    unsigned s = v;
#pragma unroll
    for (int o = 1; o < 64; o <<= 1) { const unsigned t = __shfl_up(s, o); if (lane >= o) s += t; }
    if (lane == 63) scr[wave] = s;
    __syncthreads();
    unsigned base = 0, tot = 0;
#pragma unroll
    for (int w = 0; w < NWAVES; ++w) { const unsigned x = scr[w]; if (w < wave) base += x; tot += x; }
    __syncthreads();
    total = tot; return base + s - v;
}
__device__ __forceinline__ void topk_unit(LAS unsigned char* L, int unit, const float* AFF, int* IDX, float* VAL, int* SLOT) {
    int tid_o_ = threadIdx.x; asm volatile("" : "+v"(tid_o_)); const int tid = tid_o_, lane = tid & 63, wave = __builtin_amdgcn_readfirstlane(tid >> 6);
    LAS unsigned* HIST = (LAS unsigned*)L; LAS unsigned* SH = HIST + 256; LAS unsigned* SCR = SH + 8;
    const int b = unit >> 4, e = unit & 15;
    unsigned key[8];
    { const u32x4 k0 = *(const GAS u32x4*)(AFF + (size_t)unit * SEQ + tid * 8), k1 = *(const GAS u32x4*)(AFF + (size_t)unit * SEQ + tid * 8 + 4);
        key[0] = k0.x; key[1] = k0.y; key[2] = k0.z; key[3] = k0.w; key[4] = k1.x; key[5] = k1.y; key[6] = k1.z; key[7] = k1.w; }
    unsigned prefix = 0;
#pragma unroll 1
    for (int bit = 31; bit >= 0; --bit) { const unsigned cand = prefix | (1u << bit); unsigned c = 0;
#pragma unroll
        for (int q = 0; q < 8; ++q) c += (unsigned)__popcll(__ballot(key[q] >= cand));
        if (lane == 0) HIST[(bit & 1) * 8 + wave] = c;
        __syncthreads();
        unsigned tot = 0;
#pragma unroll
        for (int w = 0; w < NWAVES; ++w) tot += HIST[(bit & 1) * 8 + w];
        if (tot >= (unsigned)CAP) prefix = cand; }
    unsigned gtc = 0;
#pragma unroll
    for (int q = 0; q < 8; ++q) gtc += (key[q] > prefix) ? 1u : 0u;
    unsigned gtot_; (void)block_excl_scan(gtc, SCR, tid, lane, wave, gtot_);
    const unsigned need = (unsigned)CAP - gtot_;
    const unsigned T = prefix;
    unsigned eq = 0;
#pragma unroll
    for (int q = 0; q < 8; ++q) eq += (key[q] == T) ? 1u : 0u;
    unsigned tot; unsigned eqbase = block_excl_scan(eq, SCR, tid, lane, wave, tot);
    unsigned selmask = 0, cnt = 0;
#pragma unroll
    for (int q = 0; q < 8; ++q) { bool sel = key[q] > T; if (key[q] == T) { sel = eqbase < need; ++eqbase; } if (sel) { selmask |= 1u << q; ++cnt; } }
    unsigned slot = block_excl_scan(cnt, SCR, tid, lane, wave, tot);
#pragma unroll
    for (int q = 0; q < 8; ++q) { const int t = tid * 8 + q; int sl = -1;
        if (selmask & (1u << q)) { sl = (int)slot; ++slot; if (sl < CAP) { IDX[unit * CAP + sl] = t; VAL[unit * CAP + sl] = __uint_as_float(key[q]); } else sl = -1; }
        SLOT[((size_t)b * SEQ + t) * NE + e] = sl; }
    __syncthreads();
}
__global__ void __launch_bounds__(NTHREADS, 2) fwd_kernel(Args args) {
    extern __shared__ __attribute__((aligned(16))) unsigned char lds_raw[];
    LAS unsigned char* L = (LAS unsigned char*)lds_raw;
    volatile LAS unsigned* MISC = (volatile LAS unsigned*)(L + MISC_OFF);
    LAS unsigned* TAB = (LAS unsigned*)(L + TAB_OFF);
    const int tid = threadIdx.x, lane = tid & 63, wave = __builtin_amdgcn_readfirstlane(tid >> 6);
    const int G = gridDim.x, bid = blockIdx.x;
    if (tid < 64) MISC[tid] = 0u;
    __syncthreads();
    unsigned char* ws = args.ws;
    unsigned* ctl = (unsigned*)(ws + WS_CTL);
    XcdBarrier bar = xcd_barrier_post(ctl + CW_BAR, MISC + 8);
    const int gw = bid * NWAVES + wave, NGW = G * NWAVES;
    const int lo = args.ph_lo, hi = args.ph_hi;
#define IN(k) (lo <= (k) && (k) < hi)
#ifndef REPMASK
#define REPMASK 0
#endif
#define PH(k) for (int rp_ = 0; rp_ <= ((REPMASK >> (k)) & 1); ++rp_) if (IN(k))
#define RPB do { if (rp_) xcd_barrier(bar); } while (0)
#define OPQ_IDS int tid_o_ = threadIdx.x; asm volatile("" : "+v"(tid_o_)); const int tid = tid_o_, lane = tid & 63; (void)tid; (void)lane
#ifndef REPSUB
#define REPSUB 0
#endif
#define RS(k) for (int rs_ = 0; rs_ <= ((REPSUB >> (k)) & 1); ++rs_)
#ifdef TPROBE_A
    unsigned long long* TSB = (unsigned long long*)(ws + WS_CTL + 512 * 1024);
#define STAMP(k) do { if (bid == 0 && tid == 0) TSB[k] = __builtin_amdgcn_s_memrealtime(); } while (0)
#else
#define STAMP(k) do { } while (0)
#endif
#define SEAM(k) do { if (IN(k) && IN((k) + 1)) xcd_barrier(bar); STAMP((k) + 1); } while (0)
    STAMP(0);

    float* MOD = (float*)(ws + WS_MOD);
    float* TW = (float*)(ws + WS_TW);
    bf16_t* DA = (bf16_t*)(ws + WS_DA); bf16_t* DB = (bf16_t*)(ws + WS_DB); bf16_t* DC = (bf16_t*)(ws + WS_DC);
    bf16_t* WIN = (bf16_t*)(ws + WS_WIN); bf16_t* WOUT = (bf16_t*)(ws + WS_WOUT);
    bf16_t* PF = (bf16_t*)(ws + WS_PF); bf16_t* PQKV = (bf16_t*)(ws + WS_PQKV); bf16_t* PZ = (bf16_t*)(ws + WS_PZ); float* PAB = (float*)(ws + WS_PAB);
    bf16_t* A2 = (bf16_t*)(ws + WS_A2);
    bf16_t* OF = (bf16_t*)(ws + WS_A2 + (size_t)MTOK * D_MODEL * 2); bf16_t* OB = OF + (size_t)MTOK * GDW;
    bf16_t* HX = (bf16_t*)args.out;
    bf16_t* YB = (bf16_t*)args.out;
    bf16_t* X2B = (bf16_t*)(ws + WS_A2 + (size_t)MTOK * D_MODEL * 2);

    PH(0) { RPB; OPQ_IDS;
        if (bid < 192) {
            LAS float* SC = (LAS float*)L;
            LAS float* RED = (LAS float*)(L + 5 * 2048 * 4);
            for (int i = tid; i < 5 * 2048; i += NTHREADS) { const int r = i >> 11, k = i & 2047; const float v = r < 4 ? args.in[I_C][r * 2048 + k] : args.in[I_CCTX][k]; SC[i] = silu_f(v); }
            __syncthreads();
            for (int s = bid; s < 192; s += G) {
                const int cg = lane & 15, ksub = lane >> 4;
                const float* wp = args.in[I_WMOD] + (size_t)(wave * 256 + ksub) * 12288 + s * 64 + cg * 4;
                f32x4 a0 = {0.f, 0.f, 0.f, 0.f}, a1 = a0, a2 = a0, a3 = a0, a4 = a0;
                for (int k = 0; k < 256; k += 32) {
                    f32x4 wv[8];
#pragma unroll
                    for (int j = 0; j < 8; ++j) wv[j] = *(const GAS f32x4*)(wp + (size_t)(k + 4 * j) * 12288);
#pragma unroll
                    for (int j = 0; j < 8; ++j) { const int kk = wave * 256 + k + 4 * j + ksub;
                        a0 += wv[j] * SC[kk]; a1 += wv[j] * SC[2048 + kk]; a2 += wv[j] * SC[4096 + kk]; a3 += wv[j] * SC[6144 + kk]; a4 += wv[j] * SC[8192 + kk]; }
                }
                LAS float* rp = RED + ((wave * 4 + ksub) * 5) * 64 + cg * 4;
                *(LAS f32x4*)(rp) = a0; *(LAS f32x4*)(rp + 64) = a1; *(LAS f32x4*)(rp + 128) = a2; *(LAS f32x4*)(rp + 192) = a3; *(LAS f32x4*)(rp + 256) = a4;
                __syncthreads();
                if (tid < 320) { const int r = tid >> 6, c = tid & 63; float v = 0.f;
#pragma unroll
                    for (int w = 0; w < 32; ++w) v += RED[(w * 5 + r) * 64 + c];
                    MOD[r * 12288 + s * 64 + c] = v + args.in[I_BMOD][s * 64 + c]; }
                __syncthreads();
            }
        }
        if (bid == G - 1) {
            for (int i = tid; i < 4096; i += NTHREADS) { float s, c; sincosf(6.283185307179586f * (float)i / 4096.f, &s, &c); TW[2 * i] = c; TW[2 * i + 1] = s; }
            for (int i = tid; i < 128 * 64; i += NTHREADS) { const int r = i >> 6, n1 = i & 63, a = r & 63; const int m = (a * n1) & 63; float s, c; sincosf(6.283185307179586f * (float)m / 64.f, &s, &c);
                DA[i] = (bf16_t)f2bf(r < 64 ? c : -s); }
        }
        if (bid == G - 2) {
            for (int i = tid; i < 128 * 128; i += NTHREADS) { const int r = i >> 7, rho = i & 127, k2 = r & 63, n2 = rho >> 1, ri = rho & 1; const int m = (k2 * n2) & 63; float s, c; sincosf(6.283185307179586f * (float)m / 64.f, &s, &c);
                const float v = r < 64 ? (ri == 0 ? c : s) : (ri == 0 ? -s : c); DB[i] = (bf16_t)f2bf(v); }
        }
        if (bid == G - 3) {
            const float scale = 0.0013810679320049757f;
            for (int i = tid; i < 128 * 256; i += NTHREADS) { const int cp = i >> 8, kap = i & 255, ri = kap >> 7, c = kap & 127; const int m = (c * cp) & 127; float s, co; sincosf(6.283185307179586f * (float)m / 128.f, &s, &co);
                DC[i] = (bf16_t)f2bf((ri == 0 ? co : s) * scale); }
        }
        for (size_t i = (size_t)bid * NTHREADS + tid; i < (size_t)(INC_PAD - INC) * D_MODEL / 8; i += (size_t)G * NTHREADS) *(GAS u32x4*)(WIN + (size_t)INC * D_MODEL + i * 8) = (u32x4){0u, 0u, 0u, 0u};
        {
            __syncthreads();
            LAS float* T = (LAS float*)L;
            constexpr int N_IN = 32 * 21, N_OUT = 32 * 8, NIT = N_IN + N_OUT;
            auto mk = [&](int it) { XposeItem x; if (it < N_IN) { x.src = args.in[I_WIN]; x.ldn = INC; x.ncols = INC; x.k0 = 64 * (it / 21); x.n0 = 256 * (it % 21); x.dst = WIN; x.dstK = D_MODEL; x.mode = 0; }
                else { const int r = it - N_IN; x.src = args.in[I_WOUT]; x.ldn = D_MODEL; x.ncols = D_MODEL; x.k0 = 64 * (r / 8); x.n0 = 256 * (r % 8); x.dst = WOUT; x.dstK = D_MODEL; x.mode = 0; } return x; };
            f32x4 r[8];
            if (tid == 0) MISC[18] = atomicAdd(ctl + CW_Q0, 1u);
            __syncthreads();
            int it = (int)MISC[18];
            if (it < NIT) { XposeItem x = mk(it); xpose_load(x, r, tid); }
            for (int qn = 0; it < NIT; ++qn) {
                XposeItem x = mk(it);
                xpose_store_lds(T, r, tid);
                if (tid == 0) MISC[19 + (qn & 1)] = atomicAdd(ctl + CW_Q0, 1u);
                __syncthreads();
                const int nx = (int)MISC[19 + (qn & 1)];
                if (nx < NIT) { XposeItem y = mk(nx); xpose_load(y, r, tid); }
                xpose_emit(x, T, tid);
                __syncthreads();
                it = nx;
            }
        }
    }
    SEAM(0);

    PH(1) { RPB; OPQ_IDS;
        const float* g1 = args.in[I_N1G];
        f32x4 ca[8], cb[8]; int curmr = -1;
        const int PW = (MTOK / 2 + NGW - 1) / NGW;
        for (int k = 0; k < PW; ++k) {
            const int p = gw * PW + k;
            if (p >= MTOK / 2) continue;
            const int m0 = 2 * p; const int mr = m0 < MTOK ? (m0 >> 12) : 4;
            if (mr != curmr) { curmr = mr; const float* sh = MOD + mr * 12288; const float* sc = sh + 2048;
#pragma unroll
                for (int j = 0; j < 8; ++j) { const f32x4 gg = *((const GAS f32x4*)g1 + lane + 64 * j), s1 = *((const GAS f32x4*)sc + lane + 64 * j); ca[j] = gg * (s1 + 1.f); cb[j] = *((const GAS f32x4*)sh + lane + 64 * j); } }
            const float* src = m0 < MTOK ? args.in[I_X] + (size_t)m0 * D_MODEL : args.in[I_CTX] + (size_t)(m0 - MTOK) * D_MODEL;
            f32x4 v0[8], v1[8]; float s0 = 0.f, s1_ = 0.f;
#pragma unroll
            for (int j = 0; j < 8; ++j) { v0[j] = *((const GAS f32x4*)src + lane + 64 * j); v1[j] = *((const GAS f32x4*)(src + D_MODEL) + lane + 64 * j); }
#pragma unroll
            for (int j = 0; j < 8; ++j) { s0 += (v0[j].x * v0[j].x + v0[j].y * v0[j].y) + (v0[j].z * v0[j].z + v0[j].w * v0[j].w); s1_ += (v1[j].x * v1[j].x + v1[j].y * v1[j].y) + (v1[j].z * v1[j].z + v1[j].w * v1[j].w); }
#pragma unroll
            for (int o = 1; o < 64; o <<= 1) { s0 += __shfl_xor(s0, o); s1_ += __shfl_xor(s1_, o); }
            const float r0 = __builtin_amdgcn_rsqf(s0 * (1.f / D_MODEL) + EPS), r1 = __builtin_amdgcn_rsqf(s1_ * (1.f / D_MODEL) + EPS);
            GAS u32x2* o0 = (GAS u32x2*)(HX + (size_t)m0 * D_MODEL) + lane; GAS u32x2* o1 = o0 + D_MODEL / 4;
#pragma unroll
            for (int j = 0; j < 8; ++j) { const f32x4 y0 = v0[j] * r0 * ca[j] + cb[j], y1 = v1[j] * r1 * ca[j] + cb[j];
                u32x2 w; w.x = pk2(y0.x, y0.y); w.y = pk2(y0.z, y0.w); o0[64 * j] = w; w.x = pk2(y1.x, y1.y); w.y = pk2(y1.z, y1.w); o1[64 * j] = w; }
        }
        for (int r = gw >> 1; (gw & 1) == 0 && r < MCTX; r += NGW / 2) {
            const float* sh = MOD + 4 * 12288; const float* sc = sh + 2048; const float* src = args.in[I_CTX] + (size_t)r * D_MODEL;
            f32x4 v0[8]; float s0 = 0.f;
#pragma unroll
            for (int j = 0; j < 8; ++j) { v0[j] = *((const GAS f32x4*)src + lane + 64 * j); s0 += (v0[j].x * v0[j].x + v0[j].y * v0[j].y) + (v0[j].z * v0[j].z + v0[j].w * v0[j].w); }
            const float r0 = __builtin_amdgcn_rsqf(wave_sum(s0) * (1.f / D_MODEL) + EPS);
            GAS u32x2* o0 = (GAS u32x2*)(HX + (size_t)(MTOK + r) * D_MODEL) + lane;
#pragma unroll
            for (int j = 0; j < 8; ++j) { const f32x4 gg = *((const GAS f32x4*)g1 + lane + 64 * j), s1 = *((const GAS f32x4*)sc + lane + 64 * j), h1 = *((const GAS f32x4*)sh + lane + 64 * j);
                const f32x4 y0 = v0[j] * r0 * gg * (s1 + 1.f) + h1; u32x2 w; w.x = pk2(y0.x, y0.y); w.y = pk2(y0.z, y0.w); o0[64 * j] = w; }
        }
    }
    SEAM(1);

    PH(2) { RPB; OPQ_IDS;
        SchedIn S{(const char*)HX, (const char*)WIN, G, bid};
        EpiIn E{PF, PQKV, PZ, PAB};
        pg8::gemm_phase<EpiIn, SchedIn, false>(L, TAB, D_MODEL, S, E);
        { constexpr int NU = 64 * 21 + 4 * 13; const int mine = (NU - bid + G - 1) / G, most = (NU + G - 1) / G;
            if (mine < most) moe_convert(L, MISC, ctl + CW_Q2, args.in[I_WGATE], args.in[I_WUP], args.in[I_WDOWN], (bf16_t*)(ws + WS_WGU), (bf16_t*)(ws + WS_WDN), 11 * (most - mine)); }
    }
    SEAM(2);

    PH(3) { RPB; OPQ_IDS;
        RS(0) gdn_chunk_items(L, bid, G, PQKV, PAB, args.in[I_CONVW], args.in[I_ALOG], args.in[I_DTB], ws + WS_G, ctl + CW_Q2, args.in[I_WGATE], args.in[I_WUP], args.in[I_WDOWN], (bf16_t*)(ws + WS_WGU), (bf16_t*)(ws + WS_WDN));
        __syncthreads();
        constexpr int LDF = 136, LDA_ = 72, LDO = 136;
        LAS bf16_t* DAl = (LAS bf16_t*)L;
        LAS bf16_t* Fi = (LAS bf16_t*)(L + 128 * LDA_ * 2);
        LAS bf16_t* Oi = (LAS bf16_t*)(L + 128 * LDA_ * 2 + 64 * LDF * 2);
        for (int i = tid; i < 128 * 64; i += NTHREADS) DAl[(i >> 6) * LDA_ + (i & 63)] = DA[i];
        LBAR();
        RS(1) for (int it = bid; it < BATCH * 64 * 8; it += G) {
            const int g = it & 7, n2 = (it >> 3) & 63, b = it >> 9;
#pragma unroll
            for (int j = 0; j < 2; ++j) { const int idx = tid + 512 * j, row = idx >> 4, ch = idx & 15;
                const u32x4 v = *(const GAS u32x4*)(PF + (size_t)(b * SEQ + 64 * row + n2) * FW + g * 128 + ch * 8);
                *(LAS u32x4*)(Fi + row * LDF + ch * 8) = v; }
            LBAR();
            const int ct = wave & 3, kt = wave >> 2;
            f32x16 are = Z16, aim = Z16;
            { bf16x8 fb_[4], fr_[4], fi_[4];
#pragma unroll
                for (int ks = 0; ks < 4; ++ks) { fb_[ks] = frag_tr(Fi, LDF, 32 * ct, 16 * ks, lane); fr_[ks] = frag_row(DAl, LDA_, 32 * kt, 16 * ks, lane); fi_[ks] = frag_row(DAl, LDA_, 64 + 32 * kt, 16 * ks, lane); }
                __builtin_amdgcn_sched_barrier(0);
#pragma unroll
                for (int ks = 0; ks < 4; ++ks) { are = MFMA32(fr_[ks], fb_[ks], are); aim = MFMA32(fi_[ks], fb_[ks], aim); } }
#pragma unroll
            for (int r = 0; r < 16; ++r) { const int k1 = 32 * kt + crow(r, lane); const int m = (n2 * k1) & 4095; const float c = TW[2 * m], s = TW[2 * m + 1];
                const float re = are[r] * c + aim[r] * s, im = aim[r] * c - are[r] * s;
                Oi[k1 * LDO + 32 * ct + (lane & 31)] = (bf16_t)f2bf(re); Oi[(64 + k1) * LDO + 32 * ct + (lane & 31)] = (bf16_t)f2bf(im); }
            LBAR();
#pragma unroll
            for (int j = 0; j < 4; ++j) { const int idx = tid + 512 * j, row = idx >> 4, ch = idx & 15, ri = row >> 6, k1 = row & 63;
                const u32x4 v = *(const LAS u32x4*)(Oi + row * LDO + ch * 8);
                *(GAS u32x4*)(YB + ((size_t)((b * 64 + k1) * 64 + n2) * 2 + ri) * FW + g * 128 + ch * 8) = v; }
        }
    }
    if (IN(3)) { constexpr int NI = BATCH * NH * 64 + BATCH * NH * 4; const int mine = (NI - bid + G - 1) / G, most = (NI + G - 1) / G;
        if (mine < most) moe_convert(L, MISC, ctl + CW_Q2, args.in[I_WGATE], args.in[I_WUP], args.in[I_WDOWN], (bf16_t*)(ws + WS_WGU), (bf16_t*)(ws + WS_WDN), 4 * (most - mine)); }
    SEAM(3);

    PH(4) { RPB; OPQ_IDS;
    if (bid < 64) {
        RS(2) for (int u = bid; u < 64; u += G) gdn_scan_unit(L, u, ws + WS_G, OF, OB);
    }
    if (bid >= 64) {
        constexpr int LDB_ = 136, LDT = 136, LDZ = 264, LDO2 = 136;
        LAS bf16_t* DBl = (LAS bf16_t*)L;
        LAS bf16_t* DCl = (LAS bf16_t*)(L + 34816);
        LAS bf16_t* W0 = (LAS bf16_t*)(L + 34816 + 65536);
        for (int i = tid; i < 128 * 128; i += NTHREADS) DBl[(i >> 7) * LDB_ + (i & 127)] = DB[i];
        for (int i = tid; i < 128 * 32; i += NTHREADS) { const int row = i >> 5, ch = i & 31; *(LAS u32x4*)(DCl + row * 256 + ((ch ^ (row & 15)) * 8)) = *(const GAS u32x4*)(DC + row * 256 + ch * 8); }
        LBAR();
        for (int qn = 0;; ++qn) {
            if (tid == 0) MISC[16 + (qn & 1)] = atomicAdd(ctl + CW_Q1, 1u);
            LBAR();
            const int it = (int)MISC[16 + (qn & 1)];
            if (it >= BATCH * 64 * 8) break;
            const int g = it & 7, k1 = (it >> 3) & 63, b = it >> 9;
#pragma unroll
            for (int j = 0; j < 4; ++j) { const int idx = tid + 512 * j, row = idx >> 4, ch = idx & 15;
                const u32x4 v = *(const GAS u32x4*)(YB + ((size_t)(b * 64 + k1) * 128 + row) * FW + g * 128 + ch * 8);
                *(LAS u32x4*)(W0 + row * LDT + ch * 8) = v; }
            LBAR();
            const int ct = wave & 3, kt = wave >> 2;
            f32x16 zre = Z16, zim = Z16;
#pragma unroll
            for (int kh = 0; kh < 2; ++kh) { bf16x8 fb_[4], fr_[4], fi_[4];
#pragma unroll
                for (int k4 = 0; k4 < 4; ++k4) { const int ks = 4 * kh + k4; fb_[k4] = frag_tr(W0, LDT, 32 * ct, 16 * ks, lane); fr_[k4] = frag_row(DBl, LDB_, 32 * kt, 16 * ks, lane); fi_[k4] = frag_row(DBl, LDB_, 64 + 32 * kt, 16 * ks, lane); }
                __builtin_amdgcn_sched_barrier(0);
#pragma unroll
                for (int k4 = 0; k4 < 4; ++k4) { zre = MFMA32(fr_[k4], fb_[k4], zre); zim = MFMA32(fi_[k4], fb_[k4], zim); }
                __builtin_amdgcn_sched_barrier(0); }
            LBAR();
#pragma unroll
            for (int r = 0; r < 16; ++r) { const int k2 = 32 * kt + crow(r, lane); const int c = 32 * ct + (lane & 31);
                W0[k2 * LDZ + c] = (bf16_t)f2bf(zre[r]); W0[k2 * LDZ + 128 + c] = (bf16_t)f2bf(zim[r]); }
            LBAR();
            f32x16 yo = Z16;
            { const int mt = wave >> 2, nt2 = wave & 3; const int rowc = 32 * nt2 + (lane & 31);
#pragma unroll
                for (int kq = 0; kq < 2; ++kq) { bf16x8 fa_[8], fb_[8];
#pragma unroll
                    for (int k8 = 0; k8 < 8; ++k8) { const int ks = 8 * kq + k8, chunk = 2 * ks + (lane >> 5);
                        fb_[k8] = *(const LAS bf16x8*)(DCl + rowc * 256 + ((chunk ^ (rowc & 15)) * 8)); fa_[k8] = frag_row(W0, LDZ, 32 * mt, 16 * ks, lane); }
                    __builtin_amdgcn_sched_barrier(0);
#pragma unroll
                    for (int k8 = 0; k8 < 8; ++k8) yo = MFMA32(fa_[k8], fb_[k8], yo);
                    __builtin_amdgcn_sched_barrier(0); } }
            LBAR();
            { const int mt = wave >> 2, nt2 = wave & 3;
#pragma unroll
                for (int r = 0; r < 16; ++r) W0[(32 * mt + crow(r, lane)) * LDO2 + 32 * nt2 + (lane & 31)] = (bf16_t)f2bf(yo[r]); }
            LBAR();
#pragma unroll
            for (int j = 0; j < 2; ++j) { const int idx = tid + 512 * j, k2 = idx >> 4, ch = idx & 15;
                *(GAS u32x4*)(A2 + (size_t)(b * SEQ + k1 + 64 * k2) * D_MODEL + g * 128 + ch * 8) = *(const LAS u32x4*)(W0 + k2 * LDO2 + ch * 8); }
            LBAR();
        }
    }
    moe_convert(L, MISC, ctl + CW_Q2, args.in[I_WGATE], args.in[I_WUP], args.in[I_WDOWN], (bf16_t*)(ws + WS_WGU), (bf16_t*)(ws + WS_WDN), 1 << 30);
    }
    SEAM(4);

    PH(5) { RPB; OPQ_IDS;
        const float* gnw = args.in[I_GNW];
        f32x4 gn0 = *(const GAS f32x4*)(gnw + ((lane * 8) & 127)), gn1 = *(const GAS f32x4*)(gnw + ((lane * 8) & 127) + 4);
        auto ld2 = [&](u32x4 (&a)[2][2], u32x4 (&bq)[2][2], u32x4 (&zz)[2][2], int m) {
#pragma unroll
            for (int t = 0; t < 2; ++t)
#pragma unroll
                for (int half = 0; half < 2; ++half) { const size_t off = (size_t)(m + t) * GDW + half * 512 + lane * 8;
                    a[t][half] = *(const GAS u32x4*)(OF + off); bq[t][half] = *(const GAS u32x4*)(OB + off); zz[t][half] = *(const GAS u32x4*)(PZ + off); } };
        auto do2 = [&](const u32x4 (&a)[2][2], const u32x4 (&bq)[2][2], const u32x4 (&zz)[2][2], int m) {
#pragma unroll
            for (int t = 0; t < 2; ++t)
#pragma unroll
                for (int half = 0; half < 2; ++half) {
                    const unsigned aw[4] = {a[t][half].x, a[t][half].y, a[t][half].z, a[t][half].w}, bw[4] = {bq[t][half].x, bq[t][half].y, bq[t][half].z, bq[t][half].w}, zw[4] = {zz[t][half].x, zz[t][half].y, zz[t][half].z, zz[t][half].w};
                    float o[8]; float ss = 0.f;
#pragma unroll
                    for (int q = 0; q < 4; ++q) { o[2 * q] = bf2f(aw[q] & 0xffffu) + bf2f(bw[q] & 0xffffu); o[2 * q + 1] = bf2f(aw[q] >> 16) + bf2f(bw[q] >> 16); ss += o[2 * q] * o[2 * q] + o[2 * q + 1] * o[2 * q + 1]; }
                    ss += dpp_xor1(ss); ss += dpp_xor2(ss); ss += __shfl_xor(ss, 4); ss += __shfl_xor(ss, 8);
                    const float rstd = __builtin_amdgcn_rsqf(ss * (1.f / HD) + EPS);
                    const float gp[8] = {gn0.x, gn0.y, gn0.z, gn0.w, gn1.x, gn1.y, gn1.z, gn1.w};
                    float y[8];
#pragma unroll
                    for (int q = 0; q < 4; ++q) { const float z0 = bf2f(zw[q] & 0xffffu), z1 = bf2f(zw[q] >> 16); y[2 * q] = o[2 * q] * rstd * gp[2 * q] * silu_f(z0); y[2 * q + 1] = o[2 * q + 1] * rstd * gp[2 * q + 1] * silu_f(z1); }
                    u32x4 w; w.x = pk2(y[0], y[1]); w.y = pk2(y[2], y[3]); w.z = pk2(y[4], y[5]); w.w = pk2(y[6], y[7]);
                    *(GAS u32x4*)(A2 + (size_t)(m + t) * D_MODEL + 1024 + half * 512 + lane * 8) = w; } };
        { u32x4 a0[2][2], b0[2][2], z0[2][2], a1[2][2], b1[2][2], z1[2][2];
            const int st = 2 * NGW; int m = 2 * gw;
            if (m < MTOK) ld2(a0, b0, z0, m);
            for (; m < MTOK; m += 2 * st) {
                if (m + st < MTOK) ld2(a1, b1, z1, m + st);
                do2(a0, b0, z0, m);
                if (m + 2 * st < MTOK) ld2(a0, b0, z0, m + 2 * st);
                if (m + st < MTOK) do2(a1, b1, z1, m + st);
            }
        }
    }
    SEAM(5);

    PH(6) { RPB; OPQ_IDS;
        SchedOut S{(const char*)A2, (const char*)WOUT, G, bid};
        EpiOut E{args.in[I_X], MOD, X2B};
        pg8::gemm_phase<EpiOut, SchedOut, false>(L, TAB, D_MODEL, S, E);
    }
    SEAM(6);

    PH(7) { RPB; OPQ_IDS;
        LAS float* WR = (LAS float*)L;
        for (int i = tid; i < D_MODEL * NE; i += NTHREADS) { const int e = i & 15, k = i >> 4; WR[e * 2048 + ((k >> 2) & 1) * 1024 + (k >> 3) * 4 + (k & 3)] = args.in[I_WROUTER][i]; }
        __syncthreads();
        const float* g2 = args.in[I_N2G];
        bf16_t* HX2 = (bf16_t*)(ws + WS_HX2); float* AFF = (float*)(ws + WS_AFF);
        u32x4 pq0[4], pq1[4];
        if (2 * gw < MTOK) {
#pragma unroll
            for (int jc = 0; jc < 4; ++jc) { pq0[jc] = *((const GAS u32x4*)(X2B + (size_t)(2 * gw) * D_MODEL) + lane + 64 * jc); pq1[jc] = *((const GAS u32x4*)(X2B + (size_t)(2 * gw + 1) * D_MODEL) + lane + 64 * jc); } }
        for (int m0 = 2 * gw; m0 < MTOK; m0 += 2 * NGW) {
            const int b = m0 >> 12;
            const float* sh = MOD + b * 12288 + 3 * 2048; const float* sc = sh + 2048;
            f32x4 v[2][8]; float s0 = 0.f, s1 = 0.f;
            u32x4 cq0[4], cq1[4];
#pragma unroll
            for (int jc = 0; jc < 4; ++jc) { cq0[jc] = pq0[jc]; cq1[jc] = pq1[jc]; }
            { const int mn = m0 + 2 * NGW; if (mn < MTOK) {
#pragma unroll
                for (int jc = 0; jc < 4; ++jc) { pq0[jc] = *((const GAS u32x4*)(X2B + (size_t)mn * D_MODEL) + lane + 64 * jc); pq1[jc] = *((const GAS u32x4*)(X2B + (size_t)(mn + 1) * D_MODEL) + lane + 64 * jc); } } }
#pragma unroll
            for (int jc = 0; jc < 4; ++jc) { const u32x4 q0 = cq0[jc], q1 = cq1[jc];
                v[0][2 * jc] = (f32x4){bf2f(q0.x & 0xffffu), bf2f(q0.x >> 16), bf2f(q0.y & 0xffffu), bf2f(q0.y >> 16)}; v[0][2 * jc + 1] = (f32x4){bf2f(q0.z & 0xffffu), bf2f(q0.z >> 16), bf2f(q0.w & 0xffffu), bf2f(q0.w >> 16)};
                v[1][2 * jc] = (f32x4){bf2f(q1.x & 0xffffu), bf2f(q1.x >> 16), bf2f(q1.y & 0xffffu), bf2f(q1.y >> 16)}; v[1][2 * jc + 1] = (f32x4){bf2f(q1.z & 0xffffu), bf2f(q1.z >> 16), bf2f(q1.w & 0xffffu), bf2f(q1.w >> 16)}; }
#pragma unroll
            for (int j = 0; j < 8; ++j) { s0 += (v[0][j].x * v[0][j].x + v[0][j].y * v[0][j].y) + (v[0][j].z * v[0][j].z + v[0][j].w * v[0][j].w); s1 += (v[1][j].x * v[1][j].x + v[1][j].y * v[1][j].y) + (v[1][j].z * v[1][j].z + v[1][j].w * v[1][j].w); }
#pragma unroll
            for (int o = 1; o < 64; o <<= 1) { s0 += __shfl_xor(s0, o); s1 += __shfl_xor(s1, o); }
            const float r0 = __builtin_amdgcn_rsqf(s0 * (1.f / D_MODEL) + EPS), r1 = __builtin_amdgcn_rsqf(s1 * (1.f / D_MODEL) + EPS);
#pragma unroll
            for (int jc = 0; jc < 4; ++jc) { const int c0 = 8 * (lane + 64 * jc); u32x4 w0, w1;
#pragma unroll
                for (int hh = 0; hh < 2; ++hh) { const f32x4 gg = *(const GAS f32x4*)(g2 + c0 + 4 * hh), sc1 = *(const GAS f32x4*)(sc + c0 + 4 * hh) + 1.f, h1 = *(const GAS f32x4*)(sh + c0 + 4 * hh);
                    const f32x4 y0 = v[0][2 * jc + hh] * r0 * gg * sc1 + h1, y1 = v[1][2 * jc + hh] * r1 * gg * sc1 + h1; v[0][2 * jc + hh] = y0; v[1][2 * jc + hh] = y1;
                    if (hh == 0) { w0.x = pk2(y0.x, y0.y); w0.y = pk2(y0.z, y0.w); w1.x = pk2(y1.x, y1.y); w1.y = pk2(y1.z, y1.w); } else { w0.z = pk2(y0.x, y0.y); w0.w = pk2(y0.z, y0.w); w1.z = pk2(y1.x, y1.y); w1.w = pk2(y1.z, y1.w); } }
                *((GAS u32x4*)(HX2 + (size_t)m0 * D_MODEL) + lane + 64 * jc) = w0; *((GAS u32x4*)(HX2 + (size_t)(m0 + 1) * D_MODEL) + lane + 64 * jc) = w1; }
            float a0[16], a1[16];
#pragma unroll
            for (int eg = 0; eg < 4; ++eg) {
#pragma unroll
                for (int q = 0; q < 4; ++q) { const int e = 4 * eg + q; float c0 = 0.f, c1 = 0.f;
#pragma unroll
                    for (int j = 0; j < 8; ++j) { const f32x4 w4 = *(const LAS f32x4*)(WR + e * 2048 + (j & 1) * 1024 + 4 * (lane + 64 * (j >> 1)));
                        c0 += (v[0][j].x * w4.x + v[0][j].y * w4.y) + (v[0][j].z * w4.z + v[0][j].w * w4.w); c1 += (v[1][j].x * w4.x + v[1][j].y * w4.y) + (v[1][j].z * w4.z + v[1][j].w * w4.w); }
                    a0[e] = c0; a1[e] = c1; }
                asm volatile("" ::: "memory"); }
#pragma unroll
            for (int st = 0; st < 4; ++st) { const int msk = 1 << st, n2 = 8 >> st; const bool up = (lane & msk) != 0;
#pragma unroll
                for (int q = 0; q < 8; ++q) if (q < n2) { const float k0 = up ? a0[q + n2] : a0[q], d0 = up ? a0[q] : a0[q + n2], k1 = up ? a1[q + n2] : a1[q], d1 = up ? a1[q] : a1[q + n2];
                    a0[q] = k0 + __shfl_xor(d0, msk); a1[q] = k1 + __shfl_xor(d1, msk); } }
            float l0 = a0[0], l1 = a1[0]; l0 += __shfl_xor(l0, 16); l1 += __shfl_xor(l1, 16); l0 += __shfl_xor(l0, 32); l1 += __shfl_xor(l1, 32);
            float mx0 = l0, mx1 = l1;
#pragma unroll
            for (int o = 1; o < 16; o <<= 1) { mx0 = fmaxf(mx0, __shfl_xor(mx0, o)); mx1 = fmaxf(mx1, __shfl_xor(mx1, o)); }
            const float e0 = expf(l0 - mx0), e1 = expf(l1 - mx1); float dn0 = e0, dn1 = e1;
#pragma unroll
            for (int o = 1; o < 16; o <<= 1) { dn0 += __shfl_xor(dn0, o); dn1 += __shfl_xor(dn1, o); }
            const int eidx = ((lane & 1) << 3) | ((lane & 2) << 1) | ((lane & 4) >> 1) | ((lane & 8) >> 3);
            if (lane < 16) { float* ap = AFF + ((size_t)b * NE + eidx) * SEQ + (m0 & 4095); f32x2 pr = {e0 / dn0, e1 / dn1}; *(GAS f32x2*)ap = pr; }
        }
    }
    SEAM(7);

    PH(8) { RPB; OPQ_IDS;
        for (int u = bid; u < BATCH * NE; u += G) topk_unit(L, u, (const float*)(ws + WS_AFF), (int*)(ws + WS_IDX), (float*)(ws + WS_VAL), (int*)(ws + WS_SLOT));
    }
    SEAM(8);

    PH(9) { RPB; OPQ_IDS;
        SchedGU S{(const char*)(ws + WS_HX2), (const char*)(ws + WS_WGU), (const int*)(ws + WS_IDX), G, bid};
        EpiGU E{(bf16_t*)(ws + WS_HID)};
        pg8::gemm_phase<EpiGU, SchedGU, true>(L, TAB, D_MODEL, S, E);
    }
    SEAM(9);

    PH(10) { RPB; OPQ_IDS;
        SchedDN S{(const char*)(ws + WS_HID), (const char*)(ws + WS_WDN), G, bid};
        EpiDN E{(bf16_t*)(ws + WS_YB), (const float*)(ws + WS_VAL)};
        pg8::gemm_phase<EpiDN, SchedDN, false>(L, TAB, FF, S, E);
    }
    SEAM(10);

    PH(11) { RPB; OPQ_IDS;
        const float* nf = args.in[I_NORMF]; const bf16_t* YB = (const bf16_t*)(ws + WS_YB); const int* SLOT = (const int*)(ws + WS_SLOT);
        f32x4 cg[8], cn[8]; int curb = -1;
        const int RW = (MTOK + NGW - 1) / NGW;
        for (int k = 0; k < RW; ++k) {
            const int m = gw * RW + k; if (m >= MTOK) break;
            const int b = m >> 12;
            if (b != curb) { curb = b; const float* gt = MOD + b * 12288 + 5 * 2048;
#pragma unroll
                for (int jc = 0; jc < 4; ++jc) { const int c0 = 8 * (lane + 64 * jc); cg[2 * jc] = *(const GAS f32x4*)(gt + c0); cg[2 * jc + 1] = *(const GAS f32x4*)(gt + c0 + 4); cn[2 * jc] = *(const GAS f32x4*)(nf + c0); cn[2 * jc + 1] = *(const GAS f32x4*)(nf + c0 + 4); } }
            f32x4 v[8], y[8];
            u32x4 xq[4];
#pragma unroll
            for (int jc = 0; jc < 4; ++jc) xq[jc] = *((const GAS u32x4*)(X2B + (size_t)m * D_MODEL) + lane + 64 * jc);
            const int myslot = SLOT[(size_t)m * NE + (lane & 15)];
#pragma unroll
            for (int j = 0; j < 8; ++j) y[j] = (f32x4){0.f, 0.f, 0.f, 0.f};
            unsigned emask = (unsigned)(__ballot(myslot >= 0) & 0xffffull);
#pragma unroll 1
            while (emask) {
                int es[4], sl[4];
#pragma unroll
                for (int q = 0; q < 4; ++q) { if (emask) { es[q] = __builtin_ctz(emask); emask &= emask - 1; sl[q] = __builtin_amdgcn_readlane(myslot, es[q]); } else { es[q] = 0; sl[q] = -1; } }
                u32x4 w[4][4];
#pragma unroll
                for (int q = 0; q < 4; ++q) if (sl[q] >= 0) { const GAS u32x4* yr = (const GAS u32x4*)(YB + ((size_t)(b * NE + es[q]) * CAP + sl[q]) * D_MODEL) + lane;
#pragma unroll
                    for (int jc = 0; jc < 4; ++jc) w[q][jc] = yr[64 * jc]; }
#pragma unroll
                for (int q = 0; q < 4; ++q) if (sl[q] >= 0) {
#pragma unroll
                    for (int jc = 0; jc < 4; ++jc) { y[2 * jc].x += bf2f(w[q][jc].x & 0xffffu); y[2 * jc].y += bf2f(w[q][jc].x >> 16); y[2 * jc].z += bf2f(w[q][jc].y & 0xffffu); y[2 * jc].w += bf2f(w[q][jc].y >> 16);
                        y[2 * jc + 1].x += bf2f(w[q][jc].z & 0xffffu); y[2 * jc + 1].y += bf2f(w[q][jc].z >> 16); y[2 * jc + 1].z += bf2f(w[q][jc].w & 0xffffu); y[2 * jc + 1].w += bf2f(w[q][jc].w >> 16); } }
            }
            float s = 0.f;
#pragma unroll
            for (int jc = 0; jc < 4; ++jc) { v[2 * jc] = (f32x4){bf2f(xq[jc].x & 0xffffu), bf2f(xq[jc].x >> 16), bf2f(xq[jc].y & 0xffffu), bf2f(xq[jc].y >> 16)}; v[2 * jc + 1] = (f32x4){bf2f(xq[jc].z & 0xffffu), bf2f(xq[jc].z >> 16), bf2f(xq[jc].w & 0xffffu), bf2f(xq[jc].w >> 16)}; }
#pragma unroll
            for (int j = 0; j < 8; ++j) { v[j] = v[j] + cg[j] * y[j]; s += (v[j].x * v[j].x + v[j].y * v[j].y) + (v[j].z * v[j].z + v[j].w * v[j].w); }
            const float rstd = __builtin_amdgcn_rsqf(wave_sum(s) * (1.f / D_MODEL) + EPS);
            float* orow = args.out + (size_t)m * D_MODEL;
#pragma unroll
            for (int jc = 0; jc < 4; ++jc) { const int c0 = 8 * (lane + 64 * jc); *(GAS f32x4*)(orow + c0) = v[2 * jc] * rstd * cn[2 * jc]; *(GAS f32x4*)(orow + c0 + 4) = v[2 * jc + 1] * rstd * cn[2 * jc + 1]; }
        }
    }
#ifdef TPROBE_A
    __syncthreads();
    if (bid == 0 && tid == 0) { asm volatile("s_waitcnt vmcnt(0)" ::: "memory"); const unsigned long long te = __builtin_amdgcn_s_memrealtime(); TSB[12] = te;
        const float ta = (float)(TSB[TPROBE_A + 1] - TSB[TPROBE_A]) * 0.1f, tb = (float)(TSB[TPROBE_B + 1] - TSB[TPROBE_B]) * 0.1f;
        args.out[0] = ta; for (int i = 1; i <= 100; ++i) args.out[i] = tb; }
#endif
#undef IN
#undef SEAM
}

constexpr int NPHASES = 12;

extern "C" void kernel_launch(void* const* d_in, const int* in_sizes, int n_in, void* d_out, int out_size, void* d_ws, size_t ws_size, hipStream_t stream) {
    static int grid = 0;
    if (grid == 0) {
        if (n_in != 19 || out_size != MTOK * D_MODEL || ws_size < WS_END) { fprintf(stderr, "kernel_launch: unexpected shapes (n_in %d out %d ws %zu)\n", n_in, out_size, ws_size); grid = -1; return; }
        int dev = 0, cus = 0, per_cu = 0;
        if (hipGetDevice(&dev) != hipSuccess || hipDeviceGetAttribute(&cus, hipDeviceAttributeMultiprocessorCount, dev) != hipSuccess) { grid = -1; return; }
        if (hipFuncSetAttribute((const void*)fwd_kernel, hipFuncAttributeMaxDynamicSharedMemorySize, LDS_BYTES) != hipSuccess) { grid = -1; return; }
        if (hipOccupancyMaxActiveBlocksPerMultiprocessor(&per_cu, (const void*)fwd_kernel, NTHREADS, LDS_BYTES) != hipSuccess || per_cu < 1) { fprintf(stderr, "occupancy query: %d\n", per_cu); grid = -1; return; }
        grid = cus;
    }
    if (grid < 0) return;
    if (hipMemsetAsync((char*)d_ws + WS_CTL, 0, CTL_ZERO_BYTES, stream) != hipSuccess) return;
    Args a{};
    for (int i = 0; i < 19; ++i) a.in[i] = (const float*)d_in[i];
    a.out = (float*)d_out; a.ws = (unsigned char*)d_ws; a.ph_lo = 0; a.ph_hi = NPHASES;
    hipLaunchKernelGGL(fwd_kernel, dim3(grid), dim3(NTHREADS), LDS_BYTES, stream, a);
}
```

```cpp
#include <hip/hip_runtime.h>
#include <cstdio>
#include <cstdint>

#define GAS __attribute__((address_space(1)))
#define LAS __attribute__((address_space(3)))
typedef unsigned short bf16_t;
typedef short bf16x8 __attribute__((ext_vector_type(8)));
typedef short s16x4 __attribute__((ext_vector_type(4)));
typedef float f32x2 __attribute__((ext_vector_type(2)));
typedef float f32x4 __attribute__((ext_vector_type(4)));
typedef float f32x16 __attribute__((ext_vector_type(16)));
typedef unsigned u32x2 __attribute__((ext_vector_type(2)));
typedef unsigned u32x4 __attribute__((ext_vector_type(4)));
typedef __bf16 bf16x2_t __attribute__((ext_vector_type(2)));

constexpr int NWAVES = 8, NTHREADS = 512;
constexpr int D_MODEL = 2048, BATCH = 4, SEQ = 4096, MTOK = BATCH * SEQ, CTX = 256, MCTX = BATCH * CTX, MALL = MTOK + MCTX;
constexpr int FW = 1024, GDW = 1024, NH = 8, HD = 128, INC = 5152, INC_PAD = 5376;
constexpr int NE = 16, CAP = 512, FF = 1536;
constexpr float EPS = 1e-6f;

constexpr size_t MiB = 1u << 20;
constexpr size_t WS_CTL = 0, CTL_ZERO_BYTES = 1 * MiB;
constexpr size_t WS_MOD = 1 * MiB;
constexpr size_t WS_TW = WS_MOD + 256 * 1024;
constexpr size_t WS_DA = WS_TW + 32 * 1024;
constexpr size_t WS_DB = WS_DA + 16 * 1024;
constexpr size_t WS_DC = WS_DB + 32 * 1024;
constexpr size_t WS_WIN = 2 * MiB;
constexpr size_t WS_WOUT = WS_WIN + (size_t)INC_PAD * D_MODEL * 2;
constexpr size_t WS_WGU = WS_WOUT + (size_t)D_MODEL * D_MODEL * 2;
constexpr size_t WS_WDN = WS_WGU + (size_t)NE * 2 * FF * D_MODEL * 2;
constexpr size_t WS_PF = WS_WDN + (size_t)NE * D_MODEL * FF * 2;
constexpr size_t WS_PQKV = WS_PF + (size_t)MTOK * FW * 2;
constexpr size_t WS_PZ = WS_PQKV + (size_t)MALL * 3 * GDW * 2;
constexpr size_t WS_PAB = WS_PZ + (size_t)MTOK * GDW * 2;
constexpr size_t WS_G = WS_PAB + (size_t)MALL * 32 * 4;
constexpr size_t WS_HX2 = WS_G;
constexpr size_t WS_HID = WS_HX2 + (size_t)MTOK * D_MODEL * 2;
constexpr size_t WS_YB = WS_HID + (size_t)BATCH * NE * CAP * FF * 2;
constexpr size_t WS_AFF = WS_YB + (size_t)BATCH * NE * CAP * D_MODEL * 2;
constexpr size_t WS_IDX = WS_AFF + (size_t)BATCH * NE * SEQ * 4;
constexpr size_t WS_VAL = WS_IDX + (size_t)BATCH * NE * CAP * 4;
constexpr size_t WS_SLOT = WS_VAL + (size_t)BATCH * NE * CAP * 4;
constexpr size_t WS_A2 = WS_PF;
constexpr size_t WS_END = 800 * MiB;
static_assert(WS_SLOT + (size_t)MTOK * NE * 4 <= WS_END, "ws map");


constexpr int RING_BYTES = 131072;
constexpr int TAB_OFF = RING_BYTES;
constexpr int MISC_OFF = TAB_OFF + 16384;
constexpr int LDS_BYTES = MISC_OFF + 256;

constexpr int CW_BAR = 4096;
constexpr int CW_Q0 = 8128, CW_Q1 = 8192, CW_Q2 = 8256;

__device__ __forceinline__ unsigned f2bf(float f) { unsigned u = __builtin_bit_cast(unsigned, f); return (u + 0x7fffu + ((u >> 16) & 1u)) >> 16; }
__device__ __forceinline__ float bf2f(unsigned h) { return __builtin_bit_cast(float, h << 16); }
__device__ __forceinline__ unsigned pk2(float lo, float hi) { f32x2 v = {lo, hi}; bf16x2_t b = __builtin_convertvector(v, bf16x2_t); return __builtin_bit_cast(unsigned, b); }
__device__ __forceinline__ float wave_sum(float v) {
#pragma unroll
    for (int o = 1; o < 64; o <<= 1) v += __shfl_xor(v, o);
    return v;
}
__device__ __forceinline__ float dpp_xor1(float v) { return __builtin_bit_cast(float, __builtin_amdgcn_mov_dpp(__builtin_bit_cast(int, v), 0xB1, 0xf, 0xf, true)); }
__device__ __forceinline__ float dpp_xor2(float v) { return __builtin_bit_cast(float, __builtin_amdgcn_mov_dpp(__builtin_bit_cast(int, v), 0x4E, 0xf, 0xf, true)); }
__device__ __forceinline__ float silu_f(float v) { return v * __builtin_amdgcn_rcpf(1.f + __expf(-v)); }
#define LDS_WAIT() asm volatile("s_waitcnt lgkmcnt(0)" ::: "memory")
#define LBAR() do { asm volatile("s_waitcnt lgkmcnt(0)" ::: "memory"); __builtin_amdgcn_s_barrier(); asm volatile("" ::: "memory"); } while (0)

#define XB_TMO      128
#define XB_XCNT(j)  (256  + 64 * (j))
#define XB_XSUB(j)  (1280 + 64 * (j))
#define XB_XGEN(j)  (2304 + 64 * (j))
#define XB_TOP      3328
#define XB_TOPGEN   3392
#define XCD_BAR_WORDS 3456
#define XB_SPIN_CAP (1u << 18)
__device__ __forceinline__ unsigned xb_ld(unsigned* p)              { return __hip_atomic_load(p, __ATOMIC_RELAXED, __HIP_MEMORY_SCOPE_AGENT); }
__device__ __forceinline__ unsigned xb_add(unsigned* p, unsigned v) { return __hip_atomic_fetch_add(p, v, __ATOMIC_RELAXED, __HIP_MEMORY_SCOPE_AGENT); }
__device__ __forceinline__ unsigned xb_xcc_id() { return (unsigned)__builtin_amdgcn_s_getreg((3 << 11) | 20) & 0xFu; }
#define XB_SPIN(cond, bar) do { unsigned _sp = 0; while (cond) { __builtin_amdgcn_s_sleep(1); \
    if ((++_sp & 255u) == 0u) { if (xb_ld(&(bar)[XB_TMO])) break; if (_sp > XB_SPIN_CAP) { atomicAdd(&(bar)[XB_TMO], 1u); break; } } } } while (0)
struct XcdBarrier { unsigned* bar; unsigned x; volatile LAS unsigned* st; };
__device__ __forceinline__ XcdBarrier xcd_barrier_post(unsigned* bar, volatile LAS unsigned* st) {
    XcdBarrier b; b.bar = bar; b.x = xb_xcc_id(); b.st = st;
    if (threadIdx.x == 0) (void)xb_add(&bar[XB_XCNT(b.x)], 1u);
    return b;
}
__device__ __forceinline__ void xcd_barrier_complete(unsigned* bar, unsigned x, unsigned& nloc, unsigned& nx) {
    const unsigned G = gridDim.x * gridDim.y * gridDim.z;
    unsigned sum, cnt, mine, sp = 0u;
    for (;;) {
        sum = 0u; cnt = 0u; mine = 0u;
#pragma unroll
        for (unsigned j = 0; j < 16; ++j) { const unsigned c = xb_ld(&bar[XB_XCNT(j)]); sum += c; cnt += (c > 0u) ? 1u : 0u; mine = (j == x) ? c : mine; }
        if (sum == G) break;
        __builtin_amdgcn_s_sleep(1);
        if ((++sp & 255u) == 0u) { if (xb_ld(&bar[XB_TMO])) break; if (sp > XB_SPIN_CAP) { atomicAdd(&bar[XB_TMO], 1u); break; } }
    }
    nloc = mine > 0u ? mine : 1u; nx = cnt > 0u ? cnt : 1u;
}
__device__ __forceinline__ void xcd_barrier(const XcdBarrier& b) {
    asm volatile("s_waitcnt vmcnt(0)" ::: "memory");
    __syncthreads();
    if (threadIdx.x == 0) {
        unsigned* bar = b.bar;
        __builtin_amdgcn_s_waitcnt(0);
        unsigned nloc = b.st[0], nx = b.st[1];
        if (nloc == 0u) { xcd_barrier_complete(bar, b.x, nloc, nx); b.st[0] = nloc; b.st[1] = nx; }
        const unsigned old = xb_add(&bar[XB_XSUB(b.x)], 1u);
        const unsigned gen = old / nloc;
        if (old + 1u == (gen + 1u) * nloc) {
            __builtin_amdgcn_fence(__ATOMIC_RELEASE, "agent");
            asm volatile("s_waitcnt vmcnt(0)" ::: "memory");
            const unsigned og = xb_add(&bar[XB_TOP], 1u);
            const unsigned tg = og / nx;
            if (og + 1u == (tg + 1u) * nx) xb_add(&bar[XB_TOPGEN], 1u);
            else XB_SPIN(xb_ld(&bar[XB_TOPGEN]) == tg, bar);
            __builtin_amdgcn_fence(__ATOMIC_ACQUIRE, "agent");
            xb_add(&bar[XB_XGEN(b.x)], 1u);
            asm volatile("s_waitcnt vmcnt(0)" ::: "memory");
        } else {
            XB_SPIN(xb_ld(&bar[XB_XGEN(b.x)]) == gen, bar);
            __builtin_amdgcn_fence(__ATOMIC_ACQUIRE, "agent");
            asm volatile("s_waitcnt vmcnt(0)" ::: "memory");
        }
    }
    __syncthreads();
}

namespace pg8 {
constexpr int BM = 256, BK = 64, HALF = 128, HTB = HALF * BK * 2, STAGE_BYTES = 8 * HTB, NXCD = 8, WGM = 8;
__host__ __device__ __forceinline__ int lds_byte(int r, int c) { const int st = (r >> 4) * 2 + (c >> 5), rr = r & 15, cc = c & 31, ob = rr * 64 + cc * 2; return st * 1024 + (ob ^ (((ob >> 9) & 1) << 5)); }
__host__ __device__ __forceinline__ void stage_rc(int b, int& R, int& C) { const int st = b / 1024, sb = b % 1024, swz = sb ^ (((sb >> 9) & 1) << 5); R = (st >> 1) * 16 + swz / 64; C = (st & 1) * 32 + (swz % 64) / 2; }
__host__ __device__ __forceinline__ int perm32(int rho) { const int n = rho >> 4, i = rho & 15; return 8 * (i >> 2) + 4 * n + (i & 3); }

struct Unit { const char* a; const char* b; const int* gidx; int pm, pn, aux; };

template <class Epi, class Sched, bool GATHER>
__device__ __forceinline__ void gemm_phase(LAS unsigned char* lds, LAS unsigned* tab, const int K, const Sched& S, const Epi& E) {
    int tid_ = threadIdx.x; asm volatile("" : "+v"(tid_));
    const int tid = tid_, wid = __builtin_amdgcn_readfirstlane(tid >> 6), lane = tid & 63, wr = wid >> 2, wc = wid & 3, fr = lane & 15, fq = lane >> 4;
    const int nt = K / BK;
    unsigned voffA[2], voffB[2];
#pragma unroll
    for (int i = 0; i < 2; ++i) { int R, C; stage_rc(tid * 16 + i * 8192, R, C); const int Rb = Epi::PERM ? ((R & ~31) + perm32(R & 31)) : R;
        voffA[i] = (unsigned)(R * K + C) * 2u; voffB[i] = (unsigned)(Rb * K + C) * 2u; }
    const size_t kstep = (size_t)(BK * 2);
    const size_t hstep = (size_t)HALF * K * 2;
    const unsigned ldsw = (unsigned)wid * 1024u;
    const int aoff = lds_byte(wr * 64 + fr, fq * 8), boff = lds_byte(wc * 32 + fr, fq * 8);
#define PG8_SA(b, h) (((b) * 2 + (h)) * HTB)
#define PG8_SB(b, h) ((4 + (b) * 2 + (h)) * HTB)
#define PG8_STAGE(bufoff, gbase, voff) do { _Pragma("unroll") for (int _i = 0; _i < 2; ++_i) \
        __builtin_amdgcn_global_load_lds((const unsigned*)((const char*)(gbase) + (voff)[_i]), (LAS unsigned*)(lds + (bufoff) + ldsw + _i * 8192), 16, 0, 0); } while (0)
#define PG8_STAGE_A(bufoff, gbase, par, h) do { if constexpr (GATHER) { _Pragma("unroll") for (int _i = 0; _i < 2; ++_i) { const unsigned _o = tab[(((par) * 2 + (h)) * 2 + _i) * 512 + tid]; \
            __builtin_amdgcn_global_load_lds((const unsigned*)((const char*)(gbase) + _o), (LAS unsigned*)(lds + (bufoff) + ldsw + _i * 8192), 16, 0, 0); } } \
        else { PG8_STAGE(bufoff, (gbase) + (h) * hstep, voffA); } } while (0)
#define PG8_LDA(dst, b, h) do { _Pragma("unroll") for (int m = 0; m < 4; ++m) _Pragma("unroll") for (int k = 0; k < 2; ++k) dst[m][k] = *(const LAS bf16x8*)(lds + PG8_SA(b, h) + aoff + m * 2048 + k * 1024); } while (0)
#define PG8_LDB(dst, b, h) do { _Pragma("unroll") for (int n = 0; n < 2; ++n) _Pragma("unroll") for (int k = 0; k < 2; ++k) dst[n][k] = *(const LAS bf16x8*)(lds + PG8_SB(b, h) + boff + n * 2048 + k * 1024); } while (0)
#define PG8_MMA(ai, bj, At, Bt) do { __builtin_amdgcn_s_setprio(1); _Pragma("unroll") for (int m = 0; m < 4; ++m) _Pragma("unroll") for (int n = 0; n < 2; ++n) _Pragma("unroll") for (int k = 0; k < 2; ++k) \
        acc[ai][bj][m][n] = __builtin_amdgcn_mfma_f32_16x16x32_bf16(Bt[n][k], At[m][k], acc[ai][bj][m][n], 0, 0, 0); __builtin_amdgcn_s_setprio(0); } while (0)
#define PG8_WAIT_V(n) asm volatile("s_waitcnt vmcnt(" #n ")" ::: "memory")
#define PG8_WAIT_L(n) asm volatile("s_waitcnt lgkmcnt(" #n ")" ::: "memory")
#define PG8_BAR __builtin_amdgcn_s_barrier()
#define PG8_SCHED __builtin_amdgcn_sched_barrier(0)
#define PG8_FILL(par, u) do { if constexpr (GATHER) { _Pragma("unroll") for (int _h = 0; _h < 2; ++_h) _Pragma("unroll") for (int _i = 0; _i < 2; ++_i) { int R_, C_; stage_rc(tid * 16 + _i * 8192, R_, C_); \
        const int row_ = (u).gidx[_h * HALF + R_]; tab[(((par) * 2 + _h) * 2 + _i) * 512 + tid] = (unsigned)(row_ * K + C_) * 2u; } } } while (0)
    Unit cur, nxt; int ui = 0; int par = 0;
    if (!S.next(0, cur)) return;
    f32x4 acc[2][2][4][2];
#pragma unroll
    for (int a = 0; a < 2; ++a)
#pragma unroll
        for (int b = 0; b < 2; ++b)
#pragma unroll
            for (int m = 0; m < 4; ++m)
#pragma unroll
                for (int n = 0; n < 2; ++n) acc[a][b][m][n] = (f32x4){0.f, 0.f, 0.f, 0.f};
    bf16x8 At[4][2], B0[2][2], B1[2][2];
    const char* cA = cur.a; const char* cB = cur.b;
    PG8_FILL(0, cur);
    PG8_STAGE(PG8_SB(0, 0), cB, voffB); PG8_STAGE(PG8_SB(0, 1), cB + hstep, voffB); PG8_STAGE_A(PG8_SA(0, 0), cA, 0, 0); PG8_STAGE_A(PG8_SA(0, 1), cA, 0, 1);
    if (wr == 1) PG8_BAR;
    PG8_WAIT_V(2); PG8_BAR;
    PG8_STAGE(PG8_SB(1, 0), cB + kstep, voffB); PG8_STAGE_A(PG8_SA(1, 0), cA + kstep, 0, 0); PG8_STAGE(PG8_SB(1, 1), cB + hstep + kstep, voffB);
    PG8_WAIT_V(6); PG8_BAR;
    for (;;) {
        const bool has_next = S.next(ui + 1, nxt);
        const char* nA = has_next ? nxt.a : cA; const char* nB = has_next ? nxt.b : cB;
        const int npar = has_next ? (par ^ 1) : par;
        for (int t = 0; t < nt; t += 2) {
            const bool last = (t == nt - 2);
            const char* a1 = cA + (size_t)(t + 1) * kstep;
            const char* a2 = last ? nA : cA + (size_t)(t + 2) * kstep; const char* b2 = last ? nB : cB + (size_t)(t + 2) * kstep;
            const char* a3 = a2 + kstep; const char* b3 = b2 + kstep;
            const int p2 = last ? npar : par;
            if (last && has_next) PG8_FILL(npar, nxt);
            PG8_LDB(B0, 0, 0); PG8_LDB(B1, 0, 1); PG8_SCHED; PG8_LDA(At, 0, 0); PG8_STAGE_A(PG8_SA(1, 1), a1, par, 1);
            PG8_WAIT_V(8); PG8_WAIT_L(0); PG8_BAR; PG8_MMA(0, 0, At, B0); PG8_MMA(0, 1, At, B1); PG8_BAR; PG8_SCHED;
            PG8_LDA(At, 0, 1); PG8_STAGE(PG8_SB(0, 0), b2, voffB); PG8_STAGE(PG8_SB(0, 1), b2 + hstep, voffB); PG8_STAGE_A(PG8_SA(0, 0), a2, p2, 0);
            PG8_WAIT_V(8); PG8_WAIT_L(0); PG8_BAR; PG8_MMA(1, 0, At, B0); PG8_MMA(1, 1, At, B1); PG8_BAR; PG8_SCHED;
            PG8_LDB(B0, 1, 0); PG8_LDB(B1, 1, 1); PG8_SCHED; PG8_LDA(At, 1, 0); PG8_STAGE_A(PG8_SA(0, 1), a2, p2, 1);
            PG8_WAIT_V(8); PG8_WAIT_L(0); PG8_BAR; PG8_MMA(0, 0, At, B0); PG8_MMA(0, 1, At, B1); PG8_BAR; PG8_SCHED;
            PG8_LDA(At, 1, 1); PG8_STAGE(PG8_SB(1, 0), b3, voffB); PG8_STAGE(PG8_SB(1, 1), b3 + hstep, voffB); PG8_STAGE_A(PG8_SA(1, 0), a3, p2, 0);
            PG8_WAIT_V(8); PG8_WAIT_L(0); PG8_BAR; PG8_MMA(1, 0, At, B0); PG8_MMA(1, 1, At, B1); PG8_BAR; PG8_SCHED;
        }
        if (wr == 0) PG8_BAR;
        E(acc, cur, wr, wc, fr, fq);
        if (!has_next) break;
#pragma unroll
        for (int a = 0; a < 2; ++a)
#pragma unroll
            for (int b = 0; b < 2; ++b)
#pragma unroll
                for (int m = 0; m < 4; ++m)
#pragma unroll
                    for (int n = 0; n < 2; ++n) acc[a][b][m][n] = (f32x4){0.f, 0.f, 0.f, 0.f};
        cur = nxt; cA = nA; cB = nB; par = npar; ++ui;
        if (wr == 1) PG8_BAR;
    }
    PG8_WAIT_V(0);
    PG8_BAR;
#undef PG8_SA
#undef PG8_SB
#undef PG8_STAGE
#undef PG8_STAGE_A
#undef PG8_LDA
#undef PG8_LDB
#undef PG8_MMA
#undef PG8_WAIT_V
#undef PG8_WAIT_L
#undef PG8_BAR
#undef PG8_SCHED
#undef PG8_FILL
}
}

__device__ __forceinline__ bf16x8 frag_row(const LAS bf16_t* base, int ld, int r0, int k0, int lane) {
    return *(const LAS bf16x8*)(base + (r0 + (lane & 31)) * ld + k0 + 8 * (lane >> 5));
}
__device__ __forceinline__ bf16x8 frag_tr(const LAS bf16_t* base, int ld, int r0, int k0, int lane) {
    const int h = lane >> 5, blk = (lane >> 4) & 1, q = (lane & 15) >> 2, p = lane & 3;
    const LAS bf16_t* a0 = base + (k0 + 8 * h + q) * ld + r0 + 16 * blk + 4 * p;
    const s16x4 lo = __builtin_bit_cast(s16x4, __builtin_amdgcn_ds_read_tr16_b64_v4i16((LAS s16x4*)a0));
    const s16x4 hi = __builtin_bit_cast(s16x4, __builtin_amdgcn_ds_read_tr16_b64_v4i16((LAS s16x4*)(a0 + 4 * ld)));
    return (bf16x8){lo[0], lo[1], lo[2], lo[3], hi[0], hi[1], hi[2], hi[3]};
}
__device__ __forceinline__ int crow(int r, int lane) { return (r & 3) + 8 * (r >> 2) + 4 * (lane >> 5); }
#define MFMA32(a, b, c) __builtin_amdgcn_mfma_f32_32x32x16_bf16((a), (b), (c), 0, 0, 0)
constexpr f32x16 Z16 = {0.f, 0.f, 0.f, 0.f, 0.f, 0.f, 0.f, 0.f, 0.f, 0.f, 0.f, 0.f, 0.f, 0.f, 0.f, 0.f};


constexpr int CVT_BLOCK_ITEMS = 3 * 3072;
struct CvtJob { f32x4 v[8]; int item; };
__device__ __forceinline__ void cvt_issue(CvtJob& c, int item, int lane, const float* wg, const float* wu, const float* wd) {
    c.item = item;
    if (item < 0) return;
    const int kc = lane & 7, ng = lane >> 3; const int bi = item >> 3, sub = item & 7;
    const float* src; int ldn, k0, n0;
    if (bi < 6144) { const int up = bi >= 3072, r0 = bi - up * 3072, e = r0 / 192, r = r0 % 192; src = (up ? wu : wg) + (size_t)e * D_MODEL * FF; ldn = FF; k0 = 64 * (r / 6); n0 = 256 * (r % 6) + 32 * sub; }
    else { const int r0 = bi - 6144, e = r0 / 192, r = r0 % 192; src = wd + (size_t)e * FF * D_MODEL; ldn = D_MODEL; k0 = 64 * (r / 8); n0 = 256 * (r % 8) + 32 * sub; }
    const float* p = src + (size_t)(k0 + 8 * kc) * ldn + n0 + 4 * ng;
#pragma unroll
    for (int i = 0; i < 8; ++i) c.v[i] = *(const GAS f32x4*)(p + (size_t)i * ldn);
}
__device__ __forceinline__ void cvt_finish(const CvtJob& c, int lane, bf16_t* WGU, bf16_t* WDN) {
    const int item = c.item;
    if (item < 0) return;
    const int kc = lane & 7, ng = lane >> 3; const int bi = item >> 3, sub = item & 7;
    bf16_t* dst; int dstK, k0, n0, mode;
    if (bi < 6144) { const int up = bi >= 3072, r0 = bi - up * 3072, e = r0 / 192, r = r0 % 192; dst = WGU + (size_t)e * 2 * FF * D_MODEL; dstK = D_MODEL; k0 = 64 * (r / 6); n0 = 256 * (r % 6) + 32 * sub; mode = 1 + up; }
    else { const int r0 = bi - 6144, e = r0 / 192, r = r0 % 192; dst = WDN + (size_t)e * D_MODEL * FF; dstK = FF; k0 = 64 * (r / 8); n0 = 256 * (r % 8) + 32 * sub; mode = 0; }
    const int n = n0 + 4 * ng;
    const int row0 = mode == 0 ? n : (256 * (n >> 7) + 128 * (mode - 1) + (n & 127));
    bf16_t* o = dst + (size_t)row0 * dstK + k0 + 8 * kc;
#pragma unroll
    for (int j = 0; j < 4; ++j) { u32x4 w; w.x = pk2(c.v[0][j], c.v[1][j]); w.y = pk2(c.v[2][j], c.v[3][j]); w.z = pk2(c.v[4][j], c.v[5][j]); w.w = pk2(c.v[6][j], c.v[7][j]);
        *(GAS u32x4*)(o + (size_t)j * dstK) = w; }
}
struct CvtShadow { int base, left; };
__device__ __forceinline__ int cvt_next(CvtShadow& cs, unsigned* q, int lane) {
    if (cs.left == 0) { if (cs.base == -2) return -1; unsigned v = 0; if (lane == 0) v = atomicAdd(q, 1u); const int b = (int)__builtin_amdgcn_readfirstlane(v);
        if (b >= CVT_BLOCK_ITEMS) { cs.base = -2; return -1; } cs.base = b * 8; cs.left = 8; }
    const int it = cs.base + (8 - cs.left); --cs.left; return it;
}
constexpr int REC_W = 0, REC_UT = 16384, REC_QD = 32768, REC_KDT = 49152, REC_QK = 65536, REC_GT = 73728, REC_BYTES = 73984;
constexpr int NREC_X = BATCH * NH * 2 * 64, NREC = NREC_X + BATCH * NH * 2 * 4;
__device__ __forceinline__ size_t rec_index(bool isctx, int b, int h, int d, int c) { return isctx ? (size_t)(NREC_X + ((b * NH + h) * 2 + d) * 4 + c) : (size_t)(((b * NH + h) * 2 + d) * 64 + c); }
__device__ __forceinline__ float softplus_f(float v) { return v > 20.f ? v : log1pf(__expf(v)); }

struct GdnItem { bool isctx; int b, h, c, rowbase, vlo, vhi; };
__device__ __forceinline__ GdnItem gdn_decode(int item) {
    GdnItem I;
    if (item < BATCH * NH * 64) { I.isctx = false; I.b = item >> 9; I.h = (item >> 6) & 7; I.c = item & 63; I.rowbase = I.b * SEQ + I.c * 64; I.vlo = 0; I.vhi = 64; }
    else { const int j = item - BATCH * NH * 64; I.isctx = true; I.b = j >> 5; I.h = (j >> 2) & 7; I.c = j & 3; I.rowbase = MTOK + I.b * CTX + I.c * 64; I.vlo = -I.c * 64; I.vhi = CTX - I.c * 64; }
    return I;
}
struct GdnPre { u32x4 raw[7]; f32x4 cw; float ga, gb; };
__device__ __forceinline__ void gdn_prefetch(GdnPre& P, const GdnItem& I, int tid, int lane, int wave, const bf16_t* PQKV, const float* PAB, const float* convw) {
#pragma unroll
    for (int e = 0; e < 7; ++e) { const int idx = tid + 512 * e; u32x4 v = {0u, 0u, 0u, 0u};
        if (idx < 3 * 68 * 16) { const int ch = idx & 15, rr = (idx >> 4) % 68, t = (idx >> 4) / 68; const int rel = rr - 2;
            if (rel >= I.vlo && rel < I.vhi) v = *(const GAS u32x4*)(PQKV + (size_t)(I.rowbase + rel) * (3 * GDW) + t * GDW + I.h * HD + ch * 8); }
        P.raw[e] = v; }
    if (tid < 480) { const int t = tid / 160, j = (tid % 160) >> 5, c4 = tid & 31; P.cw = *(const GAS f32x4*)(convw + j * (3 * GDW) + t * GDW + I.h * HD + c4 * 4); }
    if (wave < 2) { const int d = wave; const int i = d ? 63 - lane : lane; const int m = I.rowbase + i; P.ga = PAB[(size_t)m * 32 + d * 8 + I.h]; P.gb = PAB[(size_t)m * 32 + 16 + d * 8 + I.h]; }
}

__device__ __forceinline__ void gdn_chunk_items(LAS unsigned char* L, int first, int stride, const bf16_t* PQKV, const float* PAB, const float* convw, const float* a_log, const float* dt_bias, unsigned char* GREC,
                                                unsigned* cvq, const float* wg, const float* wu, const float* wd, bf16_t* WGU, bf16_t* WDN) {
    const int tid_f_ = threadIdx.x, wave = __builtin_amdgcn_readfirstlane(tid_f_ >> 6);
    constexpr int LD = 136, LDT_ = 72, NITEMS = BATCH * NH * 64 + BATCH * NH * 4;
    LAS bf16_t* QN = (LAS bf16_t*)L; LAS bf16_t* KN = (LAS bf16_t*)(L + 17408); LAS bf16_t* VI = (LAS bf16_t*)(L + 34816);
    LAS bf16_t* RAW = (LAS bf16_t*)(L + 52224);
    LAS bf16_t* TB = (LAS bf16_t*)(L + 52224); LAS bf16_t* TBG = (LAS bf16_t*)(L + 70656);
    LAS float* MPD = (LAS float*)(L + 89088);
    LAS bf16_t* MB = (LAS bf16_t*)(L + 97280);
    LAS bf16_t* TI = (LAS bf16_t*)(L + 52224);
    LAS bf16_t* PI = (LAS bf16_t*)(L + 70656);
    LAS float* GC = (LAS float*)(L + 122880); LAS float* BETA = GC + 128; LAS float* EGC = GC + 256; LAS float* EKD = GC + 384; LAS float* GTOT = (LAS float*)(L + 115712);
    LAS float* CW = (LAS float*)(L + 124928);
    LAS bf16_t* QKB = (LAS bf16_t*)(L + 124928);
    if (first >= NITEMS) return;
    CvtShadow cs; cs.base = -1; cs.left = 0; CvtJob cj; cj.item = -1;
#ifndef CVT_SHADOW
#define CVT_SHADOW 0
#endif
#if CVT_SHADOW
#define CVT_HOOK_ISSUE() cvt_issue(cj, cvt_next(cs, cvq, lane), lane, wg, wu, wd)
#define CVT_HOOK_FINISH() cvt_finish(cj, lane, WGU, WDN)
#else
#define CVT_HOOK_ISSUE() do { } while (0)
#define CVT_HOOK_FINISH() do { } while (0)
#endif
    GdnPre P;
    { int t0_ = tid_f_; asm volatile("" : "+v"(t0_)); const GdnItem I0 = gdn_decode(first); gdn_prefetch(P, I0, t0_, t0_ & 63, wave, PQKV, PAB, convw); }
#pragma unroll 1
    for (int item = first; item < NITEMS; item += stride) {
        int tid_o_ = tid_f_; asm volatile("" : "+v"(tid_o_)); const int tid = tid_o_, lane = tid & 63;
        const GdnItem I = gdn_decode(item);
        const bool isctx = I.isctx; const int b = I.b, h = I.h, c = I.c;
#pragma unroll
        for (int e = 0; e < 7; ++e) { const int idx = tid + 512 * e; if (idx < 3 * 68 * 16) { const int ch = idx & 15, rr = (idx >> 4) % 68, t = (idx >> 4) / 68; *(LAS u32x4*)(RAW + (t * 68 + rr) * LD + ch * 8) = P.raw[e]; } }
        if (tid < 480) { const int t = tid / 160, j = (tid % 160) >> 5, c4 = tid & 31; *(LAS f32x4*)(CW + (t * 5 + j) * 128 + c4 * 4) = P.cw; }
        if (wave < 2) { const int d = wave; const int i = d ? 63 - lane : lane;
            const float g = -__expf(a_log[d * 8 + h]) * softplus_f(P.ga + dt_bias[d * 8 + h]);
            float s = g;
#pragma unroll
            for (int o = 1; o < 64; o <<= 1) { const float t = __shfl_up(s, o); if (lane >= o) s += t; }
            const float gt_ = __shfl(s, 63);
            GC[d * 64 + i] = s; EGC[d * 64 + i] = __expf(s); EKD[d * 64 + i] = __expf(gt_ - s); BETA[d * 64 + i] = __builtin_amdgcn_rcpf(1.f + __expf(-P.gb));
            if (lane == 63) GTOT[d] = s; }
        LBAR();
        { const int nxt = item + stride; if (nxt < NITEMS) { const GdnItem In = gdn_decode(nxt); gdn_prefetch(P, In, tid, lane, wave, PQKV, PAB, convw); } }
#ifndef REPG
#define REPG 0
#endif
#define GS(k) for (int gq_ = 0; gq_ <= ((REPG >> (k)) & 1); ++gq_)
        GS(1) {
        CVT_HOOK_ISSUE();
        { int tt = tid; asm volatile("" : "+v"(tt)); const int cgp = tt & 31, tg = tt >> 5;
#pragma unroll
            for (int t = 0; t < 3; ++t) {
                f32x4 w[5];
#pragma unroll
                for (int j = 0; j < 5; ++j) w[j] = *(const LAS f32x4*)(CW + (t * 5 + j) * 128 + 4 * cgp);
                f32x4 x[8];
#pragma unroll
                for (int rr = 0; rr < 8; ++rr) { const u32x2 q = *(const LAS u32x2*)(RAW + (t * 68 + 4 * tg + rr) * LD + 4 * cgp); x[rr] = (f32x4){bf2f(q.x & 0xffffu), bf2f(q.x >> 16), bf2f(q.y & 0xffffu), bf2f(q.y >> 16)}; }
                f32x4 y[4]; float ss[4];
#pragma unroll
                for (int k = 0; k < 4; ++k) { f32x4 acc = w[0] * x[k];
#pragma unroll
                    for (int j = 1; j < 5; ++j) acc += w[j] * x[k + j];
                    acc.x = silu_f(acc.x); acc.y = silu_f(acc.y); acc.z = silu_f(acc.z); acc.w = silu_f(acc.w);
                    y[k] = acc; ss[k] = (acc.x * acc.x + acc.y * acc.y) + (acc.z * acc.z + acc.w * acc.w); }
                if (t < 2) {
#pragma unroll
                    for (int k = 0; k < 4; ++k) { float v = ss[k]; v += dpp_xor1(v); v += dpp_xor2(v); v += __shfl_xor(v, 4); v += __shfl_xor(v, 8); v += __shfl_xor(v, 16);
                        float sc = __builtin_amdgcn_rsqf(v + EPS); if (t == 0) sc *= 0.08838834764831845f; y[k] = y[k] * sc; } }
                LAS bf16_t* dst = (t == 0 ? QN : (t == 1 ? KN : VI)) + (4 * tg) * LD + 4 * cgp;
#pragma unroll
                for (int k = 0; k < 4; ++k) { u32x2 o; o.x = pk2(y[k].x, y[k].y); o.y = pk2(y[k].z, y[k].w); *(LAS u32x2*)(dst + k * LD) = o; }
            }
        }
        CVT_HOOK_FINISH();
        LBAR();
        }
        GS(2) {
        { const int which = wave >> 2, ti = (wave >> 1) & 1, tj = wave & 1; f32x16 acc = Z16;
            { bf16x8 fa[8], fb[8];
#pragma unroll
                for (int ks = 0; ks < 8; ++ks) { fa[ks] = frag_row(which ? QN : KN, LD, 32 * ti, 16 * ks, lane); fb[ks] = frag_row(KN, LD, 32 * tj, 16 * ks, lane); }
                __builtin_amdgcn_sched_barrier(0);
#pragma unroll
                for (int ks = 0; ks < 8; ++ks) acc = MFMA32(fa[ks], fb[ks], acc); }
            const int j = 32 * tj + (lane & 31); const float g0j = GC[j], g1j = GC[64 + j];
#pragma unroll
            for (int g4 = 0; g4 < 4; ++g4) { const int i0 = 32 * ti + 8 * g4 + 4 * (lane >> 5);
                const f32x4 g0i = *(const LAS f32x4*)(GC + i0), g1i = *(const LAS f32x4*)(GC + 64 + i0), b0i = *(const LAS f32x4*)(BETA + i0), b1i = *(const LAS f32x4*)(BETA + 64 + i0);
#pragma unroll
                for (int e = 0; e < 4; ++e) { const int i = i0 + e; const float a_ = acc[4 * g4 + e];
                    const bool lo = j < i, hi = j > i;
                    const float ex = __expf(lo ? (g0i[e] - g0j) : (hi ? (g1i[e] - g1j) : 0.f));
                    if (which == 0) { const float v = a_ * ex * (lo ? b0i[e] : b1i[e]); const float v0 = lo ? v : 0.f, v1 = hi ? v : 0.f; const int il = 63 - i, jl = 63 - j;
                        MB[(0 * 64 + i) * LDT_ + j] = (bf16_t)f2bf(v0); MB[(1 * 64 + il) * LDT_ + jl] = (bf16_t)f2bf(v1);
                        if ((i >> 4) == (j >> 4)) { MPD[((0 * 4 + (i >> 4)) * 16 + (i & 15)) * 16 + (j & 3) * 4 + ((j & 15) >> 2)] = v0; MPD[((1 * 4 + (il >> 4)) * 16 + (il & 15)) * 16 + (jl & 3) * 4 + ((jl & 15) >> 2)] = v1; } }
                    else { const float v = a_ * ex; QKB[(0 * 64 + i) * LDT_ + j] = (bf16_t)f2bf(hi ? 0.f : v); QKB[(1 * 64 + i) * LDT_ + j] = (bf16_t)f2bf(lo ? 0.f : v); } } }
        }
        LBAR();
        }
        GS(3) {
        CVT_HOOK_ISSUE();
        { const int d = wave >> 2, a_ = wave & 3; const int c = lane >> 2, r = lane & 3; float T[4] = {0.f, 0.f, 0.f, 0.f};
            LAS bf16_t* TId = TI + d * 64 * LDT_;
            { LAS unsigned* z = (LAS unsigned*)(TId + 16 * a_ * LDT_);
#pragma unroll
                for (int e = 0; e < 9; ++e) z[lane + 64 * e] = 0u; }
            const LAS float* mp = MPD + ((d * 4 + a_) * 16) * 16 + r * 4;
            f32x4 md[16];
#pragma unroll
            for (int rr = 0; rr < 16; ++rr) md[rr] = *(const LAS f32x4*)(mp + rr * 16);
#pragma unroll
            for (int rr = 0; rr < 16; ++rr) { float acc = (md[rr].x * T[0] + md[rr].y * T[1]) + (md[rr].z * T[2] + md[rr].w * T[3]);
                acc += dpp_xor1(acc); acc += dpp_xor2(acc);
                const float t = (rr == c ? 1.f : 0.f) - acc;
                if (r == (rr & 3)) T[rr >> 2] = t; }
            LDS_WAIT();
#pragma unroll
            for (int q = 0; q < 4; ++q) TId[(16 * a_ + 4 * q + r) * LDT_ + 16 * a_ + c] = (bf16_t)f2bf(T[q]);
        }
        LBAR();
        { const int d = wave >> 2, hsel = wave & 3; LAS bf16_t* TId = TI + d * 64 * LDT_; LAS bf16_t* PId = PI + d * 64 * LDT_; const LAS bf16_t* MBd = MB + d * 64 * LDT_;
            if (hsel < 2) { const int o = 32 * hsel;
                f32x16 p = Z16;
#pragma unroll
                for (int ks = 0; ks < 2; ++ks) p = MFMA32(frag_row(MBd, LDT_, o, o + 16 * ks, lane), frag_tr(TId, LDT_, o, o + 16 * ks, lane), p);
#pragma unroll
                for (int rg = 0; rg < 16; ++rg) PId[(o + crow(rg, lane)) * LDT_ + o + (lane & 31)] = (bf16_t)f2bf(p[rg]);
                LDS_WAIT();
                f32x16 q = Z16;
#pragma unroll
                for (int ks = 0; ks < 2; ++ks) q = MFMA32(frag_row(TId, LDT_, o, o + 16 * ks, lane), frag_tr(PId, LDT_, o, o + 16 * ks, lane), q);
                if ((lane & 31) < 16) {
#pragma unroll
                    for (int rg = 8; rg < 16; ++rg) TId[(o + crow(rg, lane)) * LDT_ + o + (lane & 31)] = (bf16_t)f2bf(-q[rg]); } }
        }
        LBAR();
        { const int d = wave >> 2, hsel = wave & 3; LAS bf16_t* TId = TI + d * 64 * LDT_; LAS bf16_t* PId = PI + d * 64 * LDT_; const LAS bf16_t* MBd = MB + d * 64 * LDT_;
            if (hsel == 0) {
                f32x16 p = Z16;
#pragma unroll
                for (int ks = 0; ks < 2; ++ks) p = MFMA32(frag_row(MBd, LDT_, 32, 16 * ks, lane), frag_tr(TId, LDT_, 0, 16 * ks, lane), p);
#pragma unroll
                for (int rg = 0; rg < 16; ++rg) PId[(32 + crow(rg, lane)) * LDT_ + (lane & 31)] = (bf16_t)f2bf(p[rg]);
                LDS_WAIT();
                f32x16 q = Z16;
#pragma unroll
                for (int ks = 0; ks < 2; ++ks) q = MFMA32(frag_row(TId, LDT_, 32, 32 + 16 * ks, lane), frag_tr(PId, LDT_, 0, 32 + 16 * ks, lane), q);
#pragma unroll
                for (int rg = 0; rg < 16; ++rg) TId[(32 + crow(rg, lane)) * LDT_ + (lane & 31)] = (bf16_t)f2bf(-q[rg]); }
        }
        LBAR();
        { int tt = tid; asm volatile("" : "+v"(tt)); const int d = tt >> 8, t2 = tt & 255;
            if (d == 0) {
#pragma unroll
                for (int e = 0; e < 16; ++e) { const int idx = t2 + 256 * e, i = idx >> 6, j = idx & 63; const float t = bf2f(TI[i * LDT_ + j]); const float bj = BETA[j];
                    TB[i * LDT_ + j] = (bf16_t)f2bf(t * bj); TBG[i * LDT_ + j] = (bf16_t)f2bf(t * bj * EGC[j]); } }
            else {
#pragma unroll
                for (int e = 0; e < 8; ++e) { const int idx = t2 + 256 * e, p = idx >> 6, q = idx & 63, p2 = 63 - p, q2 = 63 - q;
                    const float ta = bf2f(TI[(64 + p) * LDT_ + q]), tb = bf2f(TI[(64 + p2) * LDT_ + q2]); const float b1 = BETA[64 + q], b2 = BETA[64 + q2];
                    TB[(64 + p) * LDT_ + q] = (bf16_t)f2bf(tb * b1); TB[(64 + p2) * LDT_ + q2] = (bf16_t)f2bf(ta * b2);
                    TBG[(64 + p) * LDT_ + q] = (bf16_t)f2bf(tb * b1 * EGC[64 + q]); TBG[(64 + p2) * LDT_ + q2] = (bf16_t)f2bf(ta * b2 * EGC[64 + q2]); } }
        }
        CVT_HOOK_FINISH();
        LBAR();
        }
        GS(4) {
        CVT_HOOK_ISSUE();
        { const int d = wave >> 2, wq = wave & 3; unsigned char* rec = GREC + rec_index(isctx, b, h, d, c) * REC_BYTES;
            bf16_t* uT = (bf16_t*)(rec + REC_UT); bf16_t* wout = (bf16_t*)(rec + REC_W);
#pragma unroll
            for (int it = 0; it < 2; ++it) { f32x16 au = Z16, aw = Z16;
                { bf16x8 f1[4], f2[4], f3[4], f4[4];
#pragma unroll
                    for (int ks = 0; ks < 4; ++ks) { f1[ks] = frag_row(TB + d * 64 * LDT_, LDT_, 32 * it, 16 * ks, lane); f2[ks] = frag_tr(VI, LD, 32 * wq, 16 * ks, lane);
                        f3[ks] = frag_tr(KN, LD, 32 * wq, 16 * ks, lane); f4[ks] = frag_row(TBG + d * 64 * LDT_, LDT_, 32 * it, 16 * ks, lane); }
                    __builtin_amdgcn_sched_barrier(0);
#pragma unroll
                    for (int ks = 0; ks < 4; ++ks) { au = MFMA32(f1[ks], f2[ks], au); aw = MFMA32(f3[ks], f4[ks], aw); } }
#pragma unroll
                for (int g4 = 0; g4 < 4; ++g4) { u32x2 pu, pw; pu.x = pk2(au[4 * g4], au[4 * g4 + 1]); pu.y = pk2(au[4 * g4 + 2], au[4 * g4 + 3]); pw.x = pk2(aw[4 * g4], aw[4 * g4 + 1]); pw.y = pk2(aw[4 * g4 + 2], aw[4 * g4 + 3]);
                    *(GAS u32x2*)(uT + (32 * wq + (lane & 31)) * 64 + 32 * it + 8 * g4 + 4 * (lane >> 5)) = pu;
                    *(GAS u32x2*)(wout + (32 * it + (lane & 31)) * 128 + 32 * wq + 8 * g4 + 4 * (lane >> 5)) = pw; } }
        }
        { int tt = tid; asm volatile("" : "+v"(tt)); const int d = tt >> 8, t2 = tt & 255; unsigned char* rec = GREC + rec_index(isctx, b, h, d, c) * REC_BYTES; const float gtot = GTOT[d];
#pragma unroll
            for (int e = 0; e < 4; ++e) { const int idx = t2 + 256 * e, i = idx >> 4, ch = idx & 15; const float sc = EGC[d * 64 + i];
                const u32x4 v = *(const LAS u32x4*)(QN + i * LD + ch * 8); const unsigned rw[4] = {v.x, v.y, v.z, v.w}; u32x4 o; unsigned ow[4];
#pragma unroll
                for (int q = 0; q < 4; ++q) ow[q] = pk2(bf2f(rw[q] & 0xffffu) * sc, bf2f(rw[q] >> 16) * sc);
                o.x = ow[0]; o.y = ow[1]; o.z = ow[2]; o.w = ow[3];
                *(GAS u32x4*)(rec + REC_QD + (i * 128 + ch * 8) * 2) = o; }
#pragma unroll
            for (int e = 0; e < 4; ++e) { const int idx = t2 + 256 * e, k = idx >> 3, ci = idx & 7; float o[8];
#pragma unroll
                for (int q = 0; q < 8; ++q) { const int i = 8 * ci + q; o[q] = bf2f(KN[i * LD + k]) * EKD[d * 64 + i]; }
                u32x4 w; w.x = pk2(o[0], o[1]); w.y = pk2(o[2], o[3]); w.z = pk2(o[4], o[5]); w.w = pk2(o[6], o[7]);
                *(GAS u32x4*)(rec + REC_KDT + (k * 64 + 8 * ci) * 2) = w; }
#pragma unroll
            for (int e = 0; e < 2; ++e) { const int idx = t2 + 256 * e, i = idx >> 3, cj = idx & 7;
                *(GAS u32x4*)(rec + REC_QK + (i * 64 + 8 * cj) * 2) = *(const LAS u32x4*)(QKB + (d * 64 + i) * LDT_ + 8 * cj); }
            if (t2 == 0) *(float*)(rec + REC_GT) = __expf(gtot);
        }
        CVT_HOOK_FINISH();
        LBAR();
        }
    }
    while (cs.left > 0) { cvt_issue(cj, cvt_next(cs, cvq, tid_f_ & 63), tid_f_ & 63, wg, wu, wd); cvt_finish(cj, tid_f_ & 63, WGU, WDN); }
#undef CVT_HOOK_ISSUE
#undef CVT_HOOK_FINISH
}

__device__ __forceinline__ void gdn_scan_unit(LAS unsigned char* L, int unit, const unsigned char* GREC, bf16_t* OF, bf16_t* OB) {
    int tid_o_ = threadIdx.x; asm volatile("" : "+v"(tid_o_)); const int tid = tid_o_, lane = tid & 63, wave = __builtin_amdgcn_readfirstlane(tid >> 6);
    constexpr int LD = 136, LDS_ = 72;
    LAS bf16_t* ST = (LAS bf16_t*)L;
    LAS bf16_t* Wl = (LAS bf16_t*)(L + 34816);
    LAS bf16_t* QDl = (LAS bf16_t*)(L + 52224);
    LAS bf16_t* KDTl = (LAS bf16_t*)(L + 69632);
    LAS bf16_t* QKl = (LAS bf16_t*)(L + 88064);
    LAS bf16_t* VNT = (LAS bf16_t*)(L + 97280);
    const int b = unit >> 4, h = (unit >> 1) & 7, d = unit & 1;
    bf16_t* O = d ? OB : OF;
    for (int i = tid; i < 128 * LD / 8; i += NTHREADS) *(LAS u32x4*)(ST + i * 8) = (u32x4){0u, 0u, 0u, 0u};
    f32x16 S0 = Z16, S1 = Z16;
    const int kt = wave >> 1, vt0 = 2 * (wave & 1);
    struct ScanOps { u32x4 rg[7]; u32x2 u[4]; float gt; };
    auto rec_of = [&](int s) -> const unsigned char* { const bool isctx = s < 4; const int cs = isctx ? s : s - 4; const int c = isctx ? (d ? 3 - cs : cs) : (d ? 63 - cs : cs);
        return GREC + rec_index(isctx, b, h, d, c) * REC_BYTES; };
    auto load_ops = [&](ScanOps& o, int s) { const unsigned char* rec = rec_of(s); const bool withq = s >= 4;
#pragma unroll
        for (int e = 0; e < 2; ++e) { const int idx = tid + 512 * e; o.rg[e] = __builtin_nontemporal_load((const GAS u32x4*)(rec + REC_W + idx * 16)); o.rg[4 + e] = __builtin_nontemporal_load((const GAS u32x4*)(rec + REC_KDT + idx * 16)); }
        if (withq) {
#pragma unroll
            for (int e = 0; e < 2; ++e) { const int idx = tid + 512 * e; o.rg[2 + e] = __builtin_nontemporal_load((const GAS u32x4*)(rec + REC_QD + idx * 16)); }
            o.rg[6] = __builtin_nontemporal_load((const GAS u32x4*)(rec + REC_QK + tid * 16)); }
        { const int it = wave >> 2, vt = wave & 3; const bf16_t* uT = (const bf16_t*)(rec + REC_UT) + (32 * vt + (lane & 31)) * 64 + 32 * it + 4 * (lane >> 5);
#pragma unroll
            for (int g4 = 0; g4 < 4; ++g4) o.u[g4] = *(const GAS u32x2*)(uT + 8 * g4); }
        o.gt = *(const float*)(rec + REC_GT);
    };
    auto step = [&](ScanOps& o, int s) {
        const bool isctx = s < 4;
#pragma unroll
        for (int e = 0; e < 2; ++e) { const int idx = tid + 512 * e; *(LAS u32x4*)(Wl + (idx >> 4) * LD + (idx & 15) * 8) = o.rg[e]; *(LAS u32x4*)(KDTl + (idx >> 3) * LDS_ + (idx & 7) * 8) = o.rg[4 + e]; }
        if (!isctx) {
#pragma unroll
            for (int e = 0; e < 2; ++e) { const int idx = tid + 512 * e; *(LAS u32x4*)(QDl + (idx >> 4) * LD + (idx & 15) * 8) = o.rg[2 + e]; }
            *(LAS u32x4*)(QKl + (tid >> 3) * LDS_ + (tid & 7) * 8) = o.rg[6]; }
        const float gt = o.gt; u32x2 uc[4];
#pragma unroll
        for (int g4 = 0; g4 < 4; ++g4) uc[g4] = o.u[g4];
        LBAR();
        if (s + 2 < 68) load_ops(o, s + 2);
        const int it = wave >> 2, vt = wave & 3;
        { bf16x8 fw[8], fs[8];
#pragma unroll
            for (int ks = 0; ks < 8; ++ks) { fw[ks] = frag_row(Wl, LD, 32 * it, 16 * ks, lane); fs[ks] = frag_row(ST, LD, 32 * vt, 16 * ks, lane); }
            __builtin_amdgcn_sched_barrier(0);
            f32x16 acc = Z16;
#pragma unroll
            for (int ks = 0; ks < 8; ++ks) acc = MFMA32(fw[ks], fs[ks], acc);
#pragma unroll
            for (int g4 = 0; g4 < 4; ++g4) { const u32x2 uu = uc[g4];
                const float v0 = bf2f(uu.x & 0xffffu) - acc[4 * g4], v1 = bf2f(uu.x >> 16) - acc[4 * g4 + 1], v2 = bf2f(uu.y & 0xffffu) - acc[4 * g4 + 2], v3 = bf2f(uu.y >> 16) - acc[4 * g4 + 3];
                u32x2 p; p.x = pk2(v0, v1); p.y = pk2(v2, v3);
                *(LAS u32x2*)(VNT + (32 * vt + (lane & 31)) * LDS_ + 32 * it + 8 * g4 + 4 * (lane >> 5)) = p; } }
        LBAR();
        bf16x8 fk[4], fv0[4], fv1[4];
#pragma unroll
        for (int ks = 0; ks < 4; ++ks) { fk[ks] = frag_row(KDTl, LDS_, 32 * kt, 16 * ks, lane); fv0[ks] = frag_row(VNT, LDS_, 32 * vt0, 16 * ks, lane); fv1[ks] = frag_row(VNT, LDS_, 32 * (vt0 + 1), 16 * ks, lane); }
        __builtin_amdgcn_sched_barrier(0);
        { S0 = S0 * gt; S1 = S1 * gt;
#pragma unroll
            for (int ks = 0; ks < 4; ++ks) { S0 = MFMA32(fk[ks], fv0[ks], S0); S1 = MFMA32(fk[ks], fv1[ks], S1); } }
        if (!isctx) { f32x16 acc = Z16;
            { bf16x8 fq[8], fs[8];
#pragma unroll
                for (int ks = 0; ks < 8; ++ks) { fs[ks] = frag_row(ST, LD, 32 * vt, 16 * ks, lane); fq[ks] = frag_row(QDl, LD, 32 * it, 16 * ks, lane); }
                __builtin_amdgcn_sched_barrier(0);
#pragma unroll
                for (int ks = 0; ks < 8; ++ks) acc = MFMA32(fs[ks], fq[ks], acc); }
            { bf16x8 fvn[4], fqk[4];
#pragma unroll
                for (int ks = 0; ks < 4; ++ks) { fvn[ks] = frag_row(VNT, LDS_, 32 * vt, 16 * ks, lane); fqk[ks] = frag_row(QKl, LDS_, 32 * it, 16 * ks, lane); }
                __builtin_amdgcn_sched_barrier(0);
#pragma unroll
                for (int ks = 0; ks < 4; ++ks) acc = MFMA32(fvn[ks], fqk[ks], acc); }
            const int cs = s - 4, c = d ? 63 - cs : cs;
            bf16_t* op = O + (size_t)(b * SEQ + c * 64 + 32 * it + (lane & 31)) * GDW + h * HD + 32 * vt + 4 * (lane >> 5);
#pragma unroll
            for (int g4 = 0; g4 < 4; ++g4) { u32x2 p; p.x = pk2(acc[4 * g4], acc[4 * g4 + 1]); p.y = pk2(acc[4 * g4 + 2], acc[4 * g4 + 3]); *(GAS u32x2*)(op + 8 * g4) = p; } }
        LBAR();
#pragma unroll
        for (int g4 = 0; g4 < 4; ++g4) { u32x2 p0, p1; p0.x = pk2(S0[4 * g4], S0[4 * g4 + 1]); p0.y = pk2(S0[4 * g4 + 2], S0[4 * g4 + 3]); p1.x = pk2(S1[4 * g4], S1[4 * g4 + 1]); p1.y = pk2(S1[4 * g4 + 2], S1[4 * g4 + 3]);
            *(LAS u32x2*)(ST + (32 * vt0 + (lane & 31)) * LD + 32 * kt + 8 * g4 + 4 * (lane >> 5)) = p0;
            *(LAS u32x2*)(ST + (32 * (vt0 + 1) + (lane & 31)) * LD + 32 * kt + 8 * g4 + 4 * (lane >> 5)) = p1; }
    };
    ScanOps A, B;
    load_ops(A, 0); load_ops(B, 1);
#pragma unroll 1
    for (int s = 0; s < 68; s += 2) { step(A, s); step(B, s + 1); }
    LBAR();
}

struct Args { const float* in[19]; float* out; unsigned char* ws; int ph_lo, ph_hi; };
enum { I_X = 0, I_C, I_CTX, I_CCTX, I_WMOD, I_BMOD, I_N1G, I_N2G, I_WIN, I_CONVW, I_ALOG, I_DTB, I_GNW, I_WOUT, I_WROUTER, I_WGATE, I_WUP, I_WDOWN, I_NORMF };

struct XposeItem { const float* src; int ldn, ncols, k0, n0; bf16_t* dst; int dstK; int mode; };
__device__ __forceinline__ int xpose_row(const XposeItem& it, int n) { return it.mode == 0 ? n : (256 * (n >> 7) + 128 * (it.mode - 1) + (n & 127)); }
__device__ __forceinline__ void xpose_load(const XposeItem& it, f32x4 (&r)[8], int tid) {
    const int n = it.n0 + 4 * (tid & 63);
#pragma unroll
    for (int j = 0; j < 8; ++j) { const int k = it.k0 + (tid >> 6) + 8 * j;
        if (n + 3 < it.ncols) r[j] = __builtin_nontemporal_load((const GAS f32x4*)(it.src + (size_t)k * it.ldn + n));
        else { f32x4 v = {0.f, 0.f, 0.f, 0.f}; const float* p = it.src + (size_t)k * it.ldn; if (n < it.ncols) v.x = p[n]; if (n + 1 < it.ncols) v.y = p[n + 1]; if (n + 2 < it.ncols) v.z = p[n + 2]; r[j] = v; } }
}
__device__ __forceinline__ void xpose_store_lds(LAS float* T, const f32x4 (&r)[8], int tid) {
#pragma unroll
    for (int j = 0; j < 8; ++j) *(LAS f32x4*)(T + ((tid >> 6) + 8 * j) * 260 + 4 * (tid & 63)) = r[j];
}
__device__ __forceinline__ void xpose_emit(const XposeItem& it, const LAS float* T, int tid) {
    const int kc = tid & 7;
#pragma unroll
    for (int j = 0; j < 4; ++j) { const int nl = (tid >> 3) + 64 * j, n = it.n0 + nl;
        const LAS float* s = T + (8 * kc) * 260 + nl;
        u32x4 o; o.x = pk2(s[0], s[260]); o.y = pk2(s[2 * 260], s[3 * 260]); o.z = pk2(s[4 * 260], s[5 * 260]); o.w = pk2(s[6 * 260], s[7 * 260]);
        if (n < it.ncols) __builtin_nontemporal_store(o, (GAS u32x4*)(it.dst + (size_t)xpose_row(it, n) * it.dstK + it.k0 + 8 * kc)); }
}


__device__ __forceinline__ void moe_convert(LAS unsigned char* L, volatile LAS unsigned* MISC, unsigned* q, const float* wg, const float* wu, const float* wd, bf16_t* WGU, bf16_t* WDN, int maxpulls) {
    int tid_o_ = threadIdx.x; asm volatile("" : "+v"(tid_o_)); const int tid = tid_o_;
    __syncthreads();
    LAS float* T = (LAS float*)L;
    constexpr int NIT = 3 * 3072;
    auto mk = [&](int it) { XposeItem x; if (it < 6144) { const int up = it >= 3072, r0 = it - up * 3072, e = r0 / 192, r = r0 % 192; x.src = (up ? wu : wg) + (size_t)e * D_MODEL * FF; x.ldn = FF; x.ncols = FF; x.k0 = 64 * (r / 6); x.n0 = 256 * (r % 6);
            x.dst = WGU + (size_t)e * 2 * FF * D_MODEL; x.dstK = D_MODEL; x.mode = 1 + up; }
        else { const int r0 = it - 6144, e = r0 / 192, r = r0 % 192; x.src = wd + (size_t)e * FF * D_MODEL; x.ldn = D_MODEL; x.ncols = D_MODEL; x.k0 = 64 * (r / 8); x.n0 = 256 * (r % 8);
            x.dst = WDN + (size_t)e * D_MODEL * FF; x.dstK = FF; x.mode = 0; } return x; };
    f32x4 r[8];
    int pulls = 0;
    if (tid == 0) MISC[18] = maxpulls > 0 ? atomicAdd(q, 1u) : (unsigned)NIT;
    ++pulls;
    __syncthreads();
    int it = (int)MISC[18];
    if (it < NIT) { XposeItem x = mk(it); xpose_load(x, r, tid); }
    for (int qn = 0; it < NIT; ++qn) {
        XposeItem x = mk(it);
        xpose_store_lds(T, r, tid);
        if (tid == 0) MISC[19 + (qn & 1)] = pulls < maxpulls ? atomicAdd(q, 1u) : (unsigned)NIT;
        ++pulls;
        __syncthreads();
        const int nx = (int)MISC[19 + (qn & 1)];
        if (nx < NIT) { XposeItem y = mk(nx); xpose_load(y, r, tid); }
        xpose_emit(x, T, tid);
        __syncthreads();
        it = nx;
    }
}
struct SchedIn {
    const char* A; const char* B; int G, c;
    __device__ __forceinline__ bool next(int i, pg8::Unit& u) const {
        const int L = i * G + c; constexpr int NX = 64 * 21, NC = 4 * 13;
        if (L >= NX + NC) return false;
        int pm, pn;
        if (L < NX) { int wgid = L; { const int q = NX / 8, xcd = wgid % 8, off = wgid / 8; wgid = xcd * q + off; }
            const int nig = 8 * 21, gid = wgid / nig, fm = gid * 8; pm = fm + ((wgid % nig) % 8); pn = (wgid % nig) / 8; }
        else { const int r = L - NX; pm = 64 + r / 13; const int j = r % 13; pn = j < 12 ? 4 + j : 20; }
        u.pm = pm; u.pn = pn; u.aux = 0; u.gidx = nullptr;
        u.a = A + (size_t)pm * 256 * D_MODEL * 2; u.b = B + (size_t)pn * 256 * D_MODEL * 2; return true;
    }
};

struct EpiIn {
    static constexpr bool PERM = true;
    bf16_t* pf; bf16_t* pqkv; bf16_t* pz; float* pab;
    __device__ __forceinline__ void operator()(const f32x4 (&acc)[2][2][4][2], const pg8::Unit& u, int wr, int wc, int fr, int fq) const {
        const int row0 = u.pm * 256 + wr * 64 + fr; const int pn = u.pn;
        if (pn == 20) {
            if (wc == 0) {
#pragma unroll
                for (int ai = 0; ai < 2; ++ai)
#pragma unroll
                    for (int m = 0; m < 4; ++m) { float* rp = pab + (size_t)(row0 + ai * 128 + m * 16) * 32 + 8 * fq;
                        *(GAS f32x4*)rp = acc[ai][0][m][0]; *(GAS f32x4*)(rp + 4) = acc[ai][0][m][1]; }
            }
            return;
        }
        bf16_t* base; int ld, c0;
        if (pn < 4) { base = pf; ld = FW; c0 = pn * 256; } else if (pn < 16) { base = pqkv; ld = 3 * GDW; c0 = (pn - 4) * 256; } else { base = pz; ld = GDW; c0 = (pn - 16) * 256; }
        const int col0 = c0 + wc * 32 + 8 * fq;
#pragma unroll
        for (int ai = 0; ai < 2; ++ai)
#pragma unroll
            for (int m = 0; m < 4; ++m) { bf16_t* rowp = base + (size_t)(row0 + ai * 128 + m * 16) * ld + col0;
#pragma unroll
                for (int bj = 0; bj < 2; ++bj) { const f32x4 v0 = acc[ai][bj][m][0], v1 = acc[ai][bj][m][1];
                    u32x4 w; w.x = pk2(v0[0], v0[1]); w.y = pk2(v0[2], v0[3]); w.z = pk2(v1[0], v1[1]); w.w = pk2(v1[2], v1[3]);
                    *(GAS u32x4*)(rowp + bj * 128) = w; } }
    }
};

struct SchedOut {
    const char* A; const char* B; int G, c;
    __device__ __forceinline__ bool next(int i, pg8::Unit& u) const {
        const int Lq = i * G + c; constexpr int NU = 64 * 8;
        if (Lq >= NU) return false;
        int wgid = Lq; { const int q = NU / 8, xcd = wgid % 8, off = wgid / 8; wgid = xcd * q + off; }
        const int nig = 8 * 8, gid = wgid / nig, fm = gid * 8; const int pm = fm + ((wgid % nig) % 8), pn = (wgid % nig) / 8;
        u.pm = pm; u.pn = pn; u.aux = 0; u.gidx = nullptr;
        u.a = A + (size_t)pm * 256 * D_MODEL * 2; u.b = B + (size_t)pn * 256 * D_MODEL * 2; return true;
    }
};

struct EpiOut {
    static constexpr bool PERM = true;
    const float* x; const float* mod; bf16_t* x2;
    __device__ __forceinline__ void operator()(const f32x4 (&acc)[2][2][4][2], const pg8::Unit& u, int wr, int wc, int fr, int fq) const {
        const int row0 = u.pm * 256 + wr * 64 + fr, col0 = u.pn * 256 + wc * 32 + 8 * fq;
        const float* gt = mod + (u.pm >> 4) * 12288 + 2 * 2048;
        f32x4 gv[2][2];
#pragma unroll
        for (int bj = 0; bj < 2; ++bj)
#pragma unroll
            for (int n = 0; n < 2; ++n) gv[bj][n] = *(const GAS f32x4*)(gt + col0 + bj * 128 + n * 4);
#pragma unroll
        for (int ai = 0; ai < 2; ++ai)
#pragma unroll
            for (int m = 0; m < 4; ++m) { const size_t off = (size_t)(row0 + ai * 128 + m * 16) * D_MODEL + col0;
#pragma unroll
                for (int bj = 0; bj < 2; ++bj) { const f32x4 x0 = *(const GAS f32x4*)(x + off + bj * 128), x1 = *(const GAS f32x4*)(x + off + bj * 128 + 4);
                    const f32x4 y0 = x0 + gv[bj][0] * acc[ai][bj][m][0], y1 = x1 + gv[bj][1] * acc[ai][bj][m][1];
                    u32x4 w; w.x = pk2(y0[0], y0[1]); w.y = pk2(y0[2], y0[3]); w.z = pk2(y1[0], y1[1]); w.w = pk2(y1[2], y1[3]);
                    *(GAS u32x4*)(x2 + off + bj * 128) = w; } }
    }
};


struct SchedGU {
    const char* HX2; const char* W; const int* IDX; int G, c;
    __device__ __forceinline__ bool next(int i, pg8::Unit& u) const {
        const int L = i * G + c; if (L >= 1536) return false;
        int wt, rt;
        if (G == 256) { const int xcd = c & 7, j = c >> 3; wt = (i * 8 + xcd) * 4 + (j >> 3); rt = j & 7; } else { wt = L >> 3; rt = L & 7; }
        const int e = wt / 12, pn = wt % 12, b = rt >> 1, mt = rt & 1;
        u.pm = (b * NE + e) * 2 + mt; u.pn = pn; u.aux = 0;
        u.a = HX2 + (size_t)b * SEQ * D_MODEL * 2; u.gidx = IDX + (b * NE + e) * CAP + mt * 256;
        u.b = W + ((size_t)e * 2 * FF + (size_t)pn * 256) * D_MODEL * 2; return true;
    }
};
struct EpiGU {
    static constexpr bool PERM = true;
    bf16_t* hid;
    __device__ __forceinline__ void operator()(const f32x4 (&acc)[2][2][4][2], const pg8::Unit& u, int wr, int wc, int fr, int fq) const {
        const int row0 = u.pm * 256 + wr * 64 + fr, col0 = u.pn * 128 + wc * 32 + 8 * fq;
#pragma unroll
        for (int ai = 0; ai < 2; ++ai)
#pragma unroll
            for (int m = 0; m < 4; ++m) { const f32x4 g0 = acc[ai][0][m][0], g1 = acc[ai][0][m][1], u0 = acc[ai][1][m][0], u1 = acc[ai][1][m][1];
                u32x4 w; w.x = pk2(silu_f(g0[0]) * u0[0], silu_f(g0[1]) * u0[1]); w.y = pk2(silu_f(g0[2]) * u0[2], silu_f(g0[3]) * u0[3]);
                w.z = pk2(silu_f(g1[0]) * u1[0], silu_f(g1[1]) * u1[1]); w.w = pk2(silu_f(g1[2]) * u1[2], silu_f(g1[3]) * u1[3]);
                *(GAS u32x4*)(hid + (size_t)(row0 + ai * 128 + m * 16) * FF + col0) = w; }
    }
};
struct SchedDN {
    const char* HID; const char* W; int G, c;
    __device__ __forceinline__ bool next(int i, pg8::Unit& u) const {
        const int L = i * G + c; if (L >= 1024) return false;
        int wt, rt;
        if (G == 256) { const int xcd = c & 7, j = c >> 3; wt = (i * 8 + xcd) * 4 + (j >> 3); rt = j & 7; } else { wt = L >> 3; rt = L & 7; }
        const int e = wt >> 3, pn = wt & 7, b = rt >> 1, mt = rt & 1;
        u.pm = (b * NE + e) * 2 + mt; u.pn = pn; u.aux = 0; u.gidx = nullptr;
        u.a = HID + (size_t)u.pm * 256 * FF * 2; u.b = W + ((size_t)e * D_MODEL + (size_t)pn * 256) * FF * 2; return true;
    }
};
struct EpiDN {
    static constexpr bool PERM = true;
    bf16_t* yb; const float* val;
    __device__ __forceinline__ void operator()(const f32x4 (&acc)[2][2][4][2], const pg8::Unit& u, int wr, int wc, int fr, int fq) const {
        const int row0 = u.pm * 256 + wr * 64 + fr, col0 = u.pn * 256 + wc * 32 + 8 * fq;
#pragma unroll
        for (int ai = 0; ai < 2; ++ai)
#pragma unroll
            for (int m = 0; m < 4; ++m) { const int row = row0 + ai * 128 + m * 16; const float vv = val[row]; bf16_t* rowp = yb + (size_t)row * D_MODEL + col0;
#pragma unroll
                for (int bj = 0; bj < 2; ++bj) { const f32x4 v0 = acc[ai][bj][m][0] * vv, v1 = acc[ai][bj][m][1] * vv;
                    u32x4 w; w.x = pk2(v0[0], v0[1]); w.y = pk2(v0[2], v0[3]); w.z = pk2(v1[0], v1[1]); w.w = pk2(v1[2], v1[3]);
                    *(GAS u32x4*)(rowp + bj * 128) = w; } }
    }
};

__device__ __forceinline__ unsigned block_excl_scan(unsigned v, LAS unsigned* scr, int tid, int lane, int wave, unsigned& total) {
    unsigned s = v;
#pragma unroll
    for (int o = 1; o < 64; o <<= 1) { const unsigned t = __shfl_up(s, o); if (lane >= o) s += t; }
    if (lane == 63) scr[wave] = s;
    __syncthreads();
    unsigned base = 0, tot = 0;
#pragma unroll
    for (int w = 0; w < NWAVES; ++w) { const unsigned x = scr[w]; if (w < wave) base += x; tot += x; }
    __syncthreads();
    total = tot; return base + s - v;
}
__device__ __forceinline__ void topk_unit(LAS unsigned char* L, int unit, const float* AFF, int* IDX, float* VAL, int* SLOT) {
    int tid_o_ = threadIdx.x; asm volatile("" : "+v"(tid_o_)); const int tid = tid_o_, lane = tid & 63, wave = __builtin_amdgcn_readfirstlane(tid >> 6);
    LAS unsigned* HIST = (LAS unsigned*)L; LAS unsigned* SH = HIST + 256; LAS unsigned* SCR = SH + 8;
    const int b = unit >> 4, e = unit & 15;
    unsigned key[8];
    { const u32x4 k0 = *(const GAS u32x4*)(AFF + (size_t)unit * SEQ + tid * 8), k1 = *(const GAS u32x4*)(AFF + (size_t)unit * SEQ + tid * 8 + 4);
        key[0] = k0.x; key[1] = k0.y; key[2] = k0.z; key[3] = k0.w; key[4] = k1.x; key[5] = k1.y; key[6] = k1.z; key[7] = k1.w; }
    unsigned prefix = 0;
#pragma unroll 1
    for (int bit = 31; bit >= 0; --bit) { const unsigned cand = prefix | (1u << bit); unsigned c = 0;
#pragma unroll
        for (int q = 0; q < 8; ++q) c += (unsigned)__popcll(__ballot(key[q] >= cand));
        if (lane == 0) HIST[(bit & 1) * 8 + wave] = c;
        __syncthreads();
        unsigned tot = 0;
#pragma unroll
        for (int w = 0; w < NWAVES; ++w) tot += HIST[(bit & 1) * 8 + w];
        if (tot >= (unsigned)CAP) prefix = cand; }
    unsigned gtc = 0;
#pragma unroll
    for (int q = 0; q < 8; ++q) gtc += (key[q] > prefix) ? 1u : 0u;
    unsigned gtot_; (void)block_excl_scan(gtc, SCR, tid, lane, wave, gtot_);
    const unsigned need = (unsigned)CAP - gtot_;
    const unsigned T = prefix;
    unsigned eq = 0;
#pragma unroll
    for (int q = 0; q < 8; ++q) eq += (key[q] == T) ? 1u : 0u;
    unsigned tot; unsigned eqbase = block_excl_scan(eq, SCR, tid, lane, wave, tot);
    unsigned selmask = 0, cnt = 0;
#pragma unroll
    for (int q = 0; q < 8; ++q) { bool sel = key[q] > T; if (key[q] == T) { sel = eqbase < need; ++eqbase; } if (sel) { selmask |= 1u << q; ++cnt; } }
    unsigned slot = block_excl_scan(cnt, SCR, tid, lane, wave, tot);
#pragma unroll
    for (int q = 0; q < 8; ++q) { const int t = tid * 8 + q; int sl = -1;
        if (selmask & (1u << q)) { sl = (int)slot; ++slot; if (sl < CAP) { IDX[unit * CAP + sl] = t; VAL[unit * CAP + sl] = __uint_as_float(key[q]); } else sl = -1; }
        SLOT[((size_t)b * SEQ + t) * NE + e] = sl; }
    __syncthreads();
}
__global__ void __launch_bounds__(NTHREADS, 2) fwd_kernel(Args args) {
    extern __shared__ __attribute__((aligned(16))) unsigned char lds_raw[];
    LAS unsigned char* L = (LAS unsigned char*)lds_raw;
    volatile LAS unsigned* MISC = (volatile LAS unsigned*)(L + MISC_OFF);
    LAS unsigned* TAB = (LAS unsigned*)(L + TAB_OFF);
    const int tid = threadIdx.x, lane = tid & 63, wave = __builtin_amdgcn_readfirstlane(tid >> 6);
    const int G = gridDim.x, bid = blockIdx.x;
    if (tid < 64) MISC[tid] = 0u;
    __syncthreads();
    unsigned char* ws = args.ws;
    unsigned* ctl = (unsigned*)(ws + WS_CTL);
    XcdBarrier bar = xcd_barrier_post(ctl + CW_BAR, MISC + 8);
    const int gw = bid * NWAVES + wave, NGW = G * NWAVES;
    const int lo = args.ph_lo, hi = args.ph_hi;
#define IN(k) (lo <= (k) && (k) < hi)
#ifndef REPMASK
#define REPMASK 0
#endif
#define PH(k) for (int rp_ = 0; rp_ <= ((REPMASK >> (k)) & 1); ++rp_) if (IN(k))
#define RPB do { if (rp_) xcd_barrier(bar); } while (0)
#define OPQ_IDS int tid_o_ = threadIdx.x; asm volatile("" : "+v"(tid_o_)); const int tid = tid_o_, lane = tid & 63; (void)tid; (void)lane
#ifndef REPSUB
#define REPSUB 0
#endif
#define RS(k) for (int rs_ = 0; rs_ <= ((REPSUB >> (k)) & 1); ++rs_)
#ifdef TPROBE_A
    unsigned long long* TSB = (unsigned long long*)(ws + WS_CTL + 512 * 1024);
#define STAMP(k) do { if (bid == 0 && tid == 0) TSB[k] = __builtin_amdgcn_s_memrealtime(); } while (0)
#else
#define STAMP(k) do { } while (0)
#endif
#define SEAM(k) do { if (IN(k) && IN((k) + 1)) xcd_barrier(bar); STAMP((k) + 1); } while (0)
    STAMP(0);

    float* MOD = (float*)(ws + WS_MOD);
    float* TW = (float*)(ws + WS_TW);
    bf16_t* DA = (bf16_t*)(ws + WS_DA); bf16_t* DB = (bf16_t*)(ws + WS_DB); bf16_t* DC = (bf16_t*)(ws + WS_DC);
    bf16_t* WIN = (bf16_t*)(ws + WS_WIN); bf16_t* WOUT = (bf16_t*)(ws + WS_WOUT);
    bf16_t* PF = (bf16_t*)(ws + WS_PF); bf16_t* PQKV = (bf16_t*)(ws + WS_PQKV); bf16_t* PZ = (bf16_t*)(ws + WS_PZ); float* PAB = (float*)(ws + WS_PAB);
    bf16_t* A2 = (bf16_t*)(ws + WS_A2);
    bf16_t* OF = (bf16_t*)(ws + WS_A2 + (size_t)MTOK * D_MODEL * 2); bf16_t* OB = OF + (size_t)MTOK * GDW;
    bf16_t* HX = (bf16_t*)args.out;
    bf16_t* YB = (bf16_t*)args.out;
    bf16_t* X2B = (bf16_t*)(ws + WS_A2 + (size_t)MTOK * D_MODEL * 2);

    PH(0) { RPB; OPQ_IDS;
        if (bid < 192) {
            LAS float* SC = (LAS float*)L;
            LAS float* RED = (LAS float*)(L + 5 * 2048 * 4);
            for (int i = tid; i < 5 * 2048; i += NTHREADS) { const int r = i >> 11, k = i & 2047; const float v = r < 4 ? args.in[I_C][r * 2048 + k] : args.in[I_CCTX][k]; SC[i] = silu_f(v); }
            __syncthreads();
            for (int s = bid; s < 192; s += G) {
                const int cg = lane & 15, ksub = lane >> 4;
                const float* wp = args.in[I_WMOD] + (size_t)(wave * 256 + ksub) * 12288 + s * 64 + cg * 4;
                f32x4 a0 = {0.f, 0.f, 0.f, 0.f}, a1 = a0, a2 = a0, a3 = a0, a4 = a0;
                for (int k = 0; k < 256; k += 32) {
                    f32x4 wv[8];
#pragma unroll
                    for (int j = 0; j < 8; ++j) wv[j] = __builtin_nontemporal_load((const GAS f32x4*)(wp + (size_t)(k + 4 * j) * 12288));
#pragma unroll
                    for (int j = 0; j < 8; ++j) { const int kk = wave * 256 + k + 4 * j + ksub;
                        a0 += wv[j] * SC[kk]; a1 += wv[j] * SC[2048 + kk]; a2 += wv[j] * SC[4096 + kk]; a3 += wv[j] * SC[6144 + kk]; a4 += wv[j] * SC[8192 + kk]; }
                }
                LAS float* rp = RED + ((wave * 4 + ksub) * 5) * 64 + cg * 4;
                *(LAS f32x4*)(rp) = a0; *(LAS f32x4*)(rp + 64) = a1; *(LAS f32x4*)(rp + 128) = a2; *(LAS f32x4*)(rp + 192) = a3; *(LAS f32x4*)(rp + 256) = a4;
                __syncthreads();
                if (tid < 320) { const int r = tid >> 6, c = tid & 63; float v = 0.f;
#pragma unroll
                    for (int w = 0; w < 32; ++w) v += RED[(w * 5 + r) * 64 + c];
                    MOD[r * 12288 + s * 64 + c] = v + args.in[I_BMOD][s * 64 + c]; }
                __syncthreads();
            }
        }
        if (bid == G - 1) {
            for (int i = tid; i < 4096; i += NTHREADS) { float s, c; sincosf(6.283185307179586f * (float)i / 4096.f, &s, &c); TW[2 * i] = c; TW[2 * i + 1] = s; }
            for (int i = tid; i < 128 * 64; i += NTHREADS) { const int r = i >> 6, n1 = i & 63, a = r & 63; const int m = (a * n1) & 63; float s, c; sincosf(6.283185307179586f * (float)m / 64.f, &s, &c);
                DA[i] = (bf16_t)f2bf(r < 64 ? c : -s); }
        }
        if (bid == G - 2) {
            for (int i = tid; i < 128 * 128; i += NTHREADS) { const int r = i >> 7, rho = i & 127, k2 = r & 63, n2 = rho >> 1, ri = rho & 1; const int m = (k2 * n2) & 63; float s, c; sincosf(6.283185307179586f * (float)m / 64.f, &s, &c);
                const float v = r < 64 ? (ri == 0 ? c : s) : (ri == 0 ? -s : c); DB[i] = (bf16_t)f2bf(v); }
        }
        if (bid == G - 3) {
            const float scale = 0.0013810679320049757f;
            for (int i = tid; i < 128 * 256; i += NTHREADS) { const int cp = i >> 8, kap = i & 255, ri = kap >> 7, c = kap & 127; const int m = (c * cp) & 127; float s, co; sincosf(6.283185307179586f * (float)m / 128.f, &s, &co);
                DC[i] = (bf16_t)f2bf((ri == 0 ? co : s) * scale); }
        }
        for (size_t i = (size_t)bid * NTHREADS + tid; i < (size_t)(INC_PAD - INC) * D_MODEL / 8; i += (size_t)G * NTHREADS) *(GAS u32x4*)(WIN + (size_t)INC * D_MODEL + i * 8) = (u32x4){0u, 0u, 0u, 0u};
        {
            __syncthreads();
            LAS float* T = (LAS float*)L;
            constexpr int N_IN = 32 * 21, N_OUT = 32 * 8, NIT = N_IN + N_OUT;
            auto mk = [&](int it) { XposeItem x; if (it < N_IN) { x.src = args.in[I_WIN]; x.ldn = INC; x.ncols = INC; x.k0 = 64 * (it / 21); x.n0 = 256 * (it % 21); x.dst = WIN; x.dstK = D_MODEL; x.mode = 0; }
                else { const int r = it - N_IN; x.src = args.in[I_WOUT]; x.ldn = D_MODEL; x.ncols = D_MODEL; x.k0 = 64 * (r / 8); x.n0 = 256 * (r % 8); x.dst = WOUT; x.dstK = D_MODEL; x.mode = 0; } return x; };
            f32x4 r[8];
            if (tid == 0) MISC[18] = atomicAdd(ctl + CW_Q0, 1u);
            __syncthreads();
            int it = (int)MISC[18];
            if (it < NIT) { XposeItem x = mk(it); xpose_load(x, r, tid); }
            for (int qn = 0; it < NIT; ++qn) {
                XposeItem x = mk(it);
                xpose_store_lds(T, r, tid);
                if (tid == 0) MISC[19 + (qn & 1)] = atomicAdd(ctl + CW_Q0, 1u);
                __syncthreads();
                const int nx = (int)MISC[19 + (qn & 1)];
                if (nx < NIT) { XposeItem y = mk(nx); xpose_load(y, r, tid); }
                xpose_emit(x, T, tid);
                __syncthreads();
                it = nx;
            }
        }
    }
    SEAM(0);

    PH(1) { RPB; OPQ_IDS;
        const float* g1 = args.in[I_N1G];
        f32x4 ca[8], cb[8]; int curmr = -1;
        const int PW = (MTOK / 2 + NGW - 1) / NGW;
        for (int k = 0; k < PW; ++k) {
            const int p = gw * PW + k;
            if (p >= MTOK / 2) continue;
            const int m0 = 2 * p; const int mr = m0 < MTOK ? (m0 >> 12) : 4;
            if (mr != curmr) { curmr = mr; const float* sh = MOD + mr * 12288; const float* sc = sh + 2048;
#pragma unroll
                for (int j = 0; j < 8; ++j) { const f32x4 gg = *((const GAS f32x4*)g1 + lane + 64 * j), s1 = *((const GAS f32x4*)sc + lane + 64 * j); ca[j] = gg * (s1 + 1.f); cb[j] = *((const GAS f32x4*)sh + lane + 64 * j); } }
            const float* src = m0 < MTOK ? args.in[I_X] + (size_t)m0 * D_MODEL : args.in[I_CTX] + (size_t)(m0 - MTOK) * D_MODEL;
            f32x4 v0[8], v1[8]; float s0 = 0.f, s1_ = 0.f;
#pragma unroll
            for (int j = 0; j < 8; ++j) { v0[j] = __builtin_nontemporal_load((const GAS f32x4*)src + lane + 64 * j); v1[j] = __builtin_nontemporal_load((const GAS f32x4*)(src + D_MODEL) + lane + 64 * j); }
#pragma unroll
            for (int j = 0; j < 8; ++j) { s0 += (v0[j].x * v0[j].x + v0[j].y * v0[j].y) + (v0[j].z * v0[j].z + v0[j].w * v0[j].w); s1_ += (v1[j].x * v1[j].x + v1[j].y * v1[j].y) + (v1[j].z * v1[j].z + v1[j].w * v1[j].w); }
#pragma unroll
            for (int o = 1; o < 64; o <<= 1) { s0 += __shfl_xor(s0, o); s1_ += __shfl_xor(s1_, o); }
            const float r0 = __builtin_amdgcn_rsqf(s0 * (1.f / D_MODEL) + EPS), r1 = __builtin_amdgcn_rsqf(s1_ * (1.f / D_MODEL) + EPS);
            GAS u32x2* o0 = (GAS u32x2*)(HX + (size_t)m0 * D_MODEL) + lane; GAS u32x2* o1 = o0 + D_MODEL / 4;
#pragma unroll
            for (int j = 0; j < 8; ++j) { const f32x4 y0 = v0[j] * r0 * ca[j] + cb[j], y1 = v1[j] * r1 * ca[j] + cb[j];
                u32x2 w; w.x = pk2(y0.x, y0.y); w.y = pk2(y0.z, y0.w); o0[64 * j] = w; w.x = pk2(y1.x, y1.y); w.y = pk2(y1.z, y1.w); o1[64 * j] = w; }
        }
        for (int r = gw >> 1; (gw & 1) == 0 && r < MCTX; r += NGW / 2) {
            const float* sh = MOD + 4 * 12288; const float* sc = sh + 2048; const float* src = args.in[I_CTX] + (size_t)r * D_MODEL;
            f32x4 v0[8]; float s0 = 0.f;
#pragma unroll
            for (int j = 0; j < 8; ++j) { v0[j] = *((const GAS f32x4*)src + lane + 64 * j); s0 += (v0[j].x * v0[j].x + v0[j].y * v0[j].y) + (v0[j].z * v0[j].z + v0[j].w * v0[j].w); }
            const float r0 = __builtin_amdgcn_rsqf(wave_sum(s0) * (1.f / D_MODEL) + EPS);
            GAS u32x2* o0 = (GAS u32x2*)(HX + (size_t)(MTOK + r) * D_MODEL) + lane;
#pragma unroll
            for (int j = 0; j < 8; ++j) { const f32x4 gg = *((const GAS f32x4*)g1 + lane + 64 * j), s1 = *((const GAS f32x4*)sc + lane + 64 * j), h1 = *((const GAS f32x4*)sh + lane + 64 * j);
                const f32x4 y0 = v0[j] * r0 * gg * (s1 + 1.f) + h1; u32x2 w; w.x = pk2(y0.x, y0.y); w.y = pk2(y0.z, y0.w); o0[64 * j] = w; }
        }
    }
    SEAM(1);

    PH(2) { RPB; OPQ_IDS;
        SchedIn S{(const char*)HX, (const char*)WIN, G, bid};
        EpiIn E{PF, PQKV, PZ, PAB};
        pg8::gemm_phase<EpiIn, SchedIn, false>(L, TAB, D_MODEL, S, E);
        { constexpr int NU = 64 * 21 + 4 * 13; const int mine = (NU - bid + G - 1) / G, most = (NU + G - 1) / G;
            if (mine < most) moe_convert(L, MISC, ctl + CW_Q2, args.in[I_WGATE], args.in[I_WUP], args.in[I_WDOWN], (bf16_t*)(ws + WS_WGU), (bf16_t*)(ws + WS_WDN), 11 * (most - mine)); }
    }
    SEAM(2);

    PH(3) { RPB; OPQ_IDS;
        RS(0) gdn_chunk_items(L, bid, G, PQKV, PAB, args.in[I_CONVW], args.in[I_ALOG], args.in[I_DTB], ws + WS_G, ctl + CW_Q2, args.in[I_WGATE], args.in[I_WUP], args.in[I_WDOWN], (bf16_t*)(ws + WS_WGU), (bf16_t*)(ws + WS_WDN));
        __syncthreads();
        constexpr int LDF = 136, LDA_ = 72, LDO = 136;
        LAS bf16_t* DAl = (LAS bf16_t*)L;
        LAS bf16_t* Fi = (LAS bf16_t*)(L + 128 * LDA_ * 2);
        LAS bf16_t* Oi = (LAS bf16_t*)(L + 128 * LDA_ * 2 + 64 * LDF * 2);
        for (int i = tid; i < 128 * 64; i += NTHREADS) DAl[(i >> 6) * LDA_ + (i & 63)] = DA[i];
        LBAR();
        RS(1) for (int it = bid; it < BATCH * 64 * 8; it += G) {
            const int g = it & 7, n2 = (it >> 3) & 63, b = it >> 9;
#pragma unroll
            for (int j = 0; j < 2; ++j) { const int idx = tid + 512 * j, row = idx >> 4, ch = idx & 15;
                const u32x4 v = *(const GAS u32x4*)(PF + (size_t)(b * SEQ + 64 * row + n2) * FW + g * 128 + ch * 8);
                *(LAS u32x4*)(Fi + row * LDF + ch * 8) = v; }
            LBAR();
            const int ct = wave & 3, kt = wave >> 2;
            f32x16 are = Z16, aim = Z16;
            { bf16x8 fb_[4], fr_[4], fi_[4];
#pragma unroll
                for (int ks = 0; ks < 4; ++ks) { fb_[ks] = frag_tr(Fi, LDF, 32 * ct, 16 * ks, lane); fr_[ks] = frag_row(DAl, LDA_, 32 * kt, 16 * ks, lane); fi_[ks] = frag_row(DAl, LDA_, 64 + 32 * kt, 16 * ks, lane); }
                __builtin_amdgcn_sched_barrier(0);
#pragma unroll
                for (int ks = 0; ks < 4; ++ks) { are = MFMA32(fr_[ks], fb_[ks], are); aim = MFMA32(fi_[ks], fb_[ks], aim); } }
#pragma unroll
            for (int r = 0; r < 16; ++r) { const int k1 = 32 * kt + crow(r, lane); const int m = (n2 * k1) & 4095; const float c = TW[2 * m], s = TW[2 * m + 1];
                const float re = are[r] * c + aim[r] * s, im = aim[r] * c - are[r] * s;
                Oi[k1 * LDO + 32 * ct + (lane & 31)] = (bf16_t)f2bf(re); Oi[(64 + k1) * LDO + 32 * ct + (lane & 31)] = (bf16_t)f2bf(im); }
            LBAR();
#pragma unroll
            for (int j = 0; j < 4; ++j) { const int idx = tid + 512 * j, row = idx >> 4, ch = idx & 15, ri = row >> 6, k1 = row & 63;
                const u32x4 v = *(const LAS u32x4*)(Oi + row * LDO + ch * 8);
                *(GAS u32x4*)(YB + ((size_t)((b * 64 + k1) * 64 + n2) * 2 + ri) * FW + g * 128 + ch * 8) = v; }
        }
    }
    if (IN(3)) { constexpr int NI = BATCH * NH * 64 + BATCH * NH * 4; const int mine = (NI - bid + G - 1) / G, most = (NI + G - 1) / G;
        if (mine < most) moe_convert(L, MISC, ctl + CW_Q2, args.in[I_WGATE], args.in[I_WUP], args.in[I_WDOWN], (bf16_t*)(ws + WS_WGU), (bf16_t*)(ws + WS_WDN), 4 * (most - mine)); }
    SEAM(3);

    PH(4) { RPB; OPQ_IDS;
    if (bid < 64) {
        RS(2) for (int u = bid; u < 64; u += G) gdn_scan_unit(L, u, ws + WS_G, OF, OB);
    }
    if (bid >= 64) {
        constexpr int LDB_ = 136, LDT = 136, LDZ = 264, LDO2 = 136;
        LAS bf16_t* DBl = (LAS bf16_t*)L;
        LAS bf16_t* DCl = (LAS bf16_t*)(L + 34816);
        LAS bf16_t* W0 = (LAS bf16_t*)(L + 34816 + 65536);
        for (int i = tid; i < 128 * 128; i += NTHREADS) DBl[(i >> 7) * LDB_ + (i & 127)] = DB[i];
        for (int i = tid; i < 128 * 32; i += NTHREADS) { const int row = i >> 5, ch = i & 31; *(LAS u32x4*)(DCl + row * 256 + ((ch ^ (row & 15)) * 8)) = *(const GAS u32x4*)(DC + row * 256 + ch * 8); }
        LBAR();
        for (int qn = 0;; ++qn) {
            if (tid == 0) MISC[16 + (qn & 1)] = atomicAdd(ctl + CW_Q1, 1u);
            LBAR();
            const int it = (int)MISC[16 + (qn & 1)];
            if (it >= BATCH * 64 * 8) break;
            const int g = it & 7, k1 = (it >> 3) & 63, b = it >> 9;
#pragma unroll
            for (int j = 0; j < 4; ++j) { const int idx = tid + 512 * j, row = idx >> 4, ch = idx & 15;
                const u32x4 v = *(const GAS u32x4*)(YB + ((size_t)(b * 64 + k1) * 128 + row) * FW + g * 128 + ch * 8);
                *(LAS u32x4*)(W0 + row * LDT + ch * 8) = v; }
            LBAR();
            const int ct = wave & 3, kt = wave >> 2;
            f32x16 zre = Z16, zim = Z16;
#pragma unroll
            for (int kh = 0; kh < 2; ++kh) { bf16x8 fb_[4], fr_[4], fi_[4];
#pragma unroll
                for (int k4 = 0; k4 < 4; ++k4) { const int ks = 4 * kh + k4; fb_[k4] = frag_tr(W0, LDT, 32 * ct, 16 * ks, lane); fr_[k4] = frag_row(DBl, LDB_, 32 * kt, 16 * ks, lane); fi_[k4] = frag_row(DBl, LDB_, 64 + 32 * kt, 16 * ks, lane); }
                __builtin_amdgcn_sched_barrier(0);
#pragma unroll
                for (int k4 = 0; k4 < 4; ++k4) { zre = MFMA32(fr_[k4], fb_[k4], zre); zim = MFMA32(fi_[k4], fb_[k4], zim); }
                __builtin_amdgcn_sched_barrier(0); }
            LBAR();
#pragma unroll
            for (int r = 0; r < 16; ++r) { const int k2 = 32 * kt + crow(r, lane); const int c = 32 * ct + (lane & 31);
                W0[k2 * LDZ + c] = (bf16_t)f2bf(zre[r]); W0[k2 * LDZ + 128 + c] = (bf16_t)f2bf(zim[r]); }
            LBAR();
            f32x16 yo = Z16;
            { const int mt = wave >> 2, nt2 = wave & 3; const int rowc = 32 * nt2 + (lane & 31);
#pragma unroll
                for (int kq = 0; kq < 2; ++kq) { bf16x8 fa_[8], fb_[8];
#pragma unroll
                    for (int k8 = 0; k8 < 8; ++k8) { const int ks = 8 * kq + k8, chunk = 2 * ks + (lane >> 5);
                        fb_[k8] = *(const LAS bf16x8*)(DCl + rowc * 256 + ((chunk ^ (rowc & 15)) * 8)); fa_[k8] = frag_row(W0, LDZ, 32 * mt, 16 * ks, lane); }
                    __builtin_amdgcn_sched_barrier(0);
#pragma unroll
                    for (int k8 = 0; k8 < 8; ++k8) yo = MFMA32(fa_[k8], fb_[k8], yo);
                    __builtin_amdgcn_sched_barrier(0); } }
            LBAR();
            { const int mt = wave >> 2, nt2 = wave & 3;
#pragma unroll
                for (int r = 0; r < 16; ++r) W0[(32 * mt + crow(r, lane)) * LDO2 + 32 * nt2 + (lane & 31)] = (bf16_t)f2bf(yo[r]); }
            LBAR();
#pragma unroll
            for (int j = 0; j < 2; ++j) { const int idx = tid + 512 * j, k2 = idx >> 4, ch = idx & 15;
                *(GAS u32x4*)(A2 + (size_t)(b * SEQ + k1 + 64 * k2) * D_MODEL + g * 128 + ch * 8) = *(const LAS u32x4*)(W0 + k2 * LDO2 + ch * 8); }
            LBAR();
        }
    }
    moe_convert(L, MISC, ctl + CW_Q2, args.in[I_WGATE], args.in[I_WUP], args.in[I_WDOWN], (bf16_t*)(ws + WS_WGU), (bf16_t*)(ws + WS_WDN), 1 << 30);
    }
    SEAM(4);

    PH(5) { RPB; OPQ_IDS;
        const float* gnw = args.in[I_GNW];
        f32x4 gn0 = *(const GAS f32x4*)(gnw + ((lane * 8) & 127)), gn1 = *(const GAS f32x4*)(gnw + ((lane * 8) & 127) + 4);
        auto ld2 = [&](u32x4 (&a)[2][2], u32x4 (&bq)[2][2], u32x4 (&zz)[2][2], int m) {
#pragma unroll
            for (int t = 0; t < 2; ++t)
#pragma unroll
                for (int half = 0; half < 2; ++half) { const size_t off = (size_t)(m + t) * GDW + half * 512 + lane * 8;
                    a[t][half] = *(const GAS u32x4*)(OF + off); bq[t][half] = *(const GAS u32x4*)(OB + off); zz[t][half] = *(const GAS u32x4*)(PZ + off); } };
        auto do2 = [&](const u32x4 (&a)[2][2], const u32x4 (&bq)[2][2], const u32x4 (&zz)[2][2], int m) {
#pragma unroll
            for (int t = 0; t < 2; ++t)
#pragma unroll
                for (int half = 0; half < 2; ++half) {
                    const unsigned aw[4] = {a[t][half].x, a[t][half].y, a[t][half].z, a[t][half].w}, bw[4] = {bq[t][half].x, bq[t][half].y, bq[t][half].z, bq[t][half].w}, zw[4] = {zz[t][half].x, zz[t][half].y, zz[t][half].z, zz[t][half].w};
                    float o[8]; float ss = 0.f;
#pragma unroll
                    for (int q = 0; q < 4; ++q) { o[2 * q] = bf2f(aw[q] & 0xffffu) + bf2f(bw[q] & 0xffffu); o[2 * q + 1] = bf2f(aw[q] >> 16) + bf2f(bw[q] >> 16); ss += o[2 * q] * o[2 * q] + o[2 * q + 1] * o[2 * q + 1]; }
                    ss += dpp_xor1(ss); ss += dpp_xor2(ss); ss += __shfl_xor(ss, 4); ss += __shfl_xor(ss, 8);
                    const float rstd = __builtin_amdgcn_rsqf(ss * (1.f / HD) + EPS);
                    const float gp[8] = {gn0.x, gn0.y, gn0.z, gn0.w, gn1.x, gn1.y, gn1.z, gn1.w};
                    float y[8];
#pragma unroll
                    for (int q = 0; q < 4; ++q) { const float z0 = bf2f(zw[q] & 0xffffu), z1 = bf2f(zw[q] >> 16); y[2 * q] = o[2 * q] * rstd * gp[2 * q] * silu_f(z0); y[2 * q + 1] = o[2 * q + 1] * rstd * gp[2 * q + 1] * silu_f(z1); }
                    u32x4 w; w.x = pk2(y[0], y[1]); w.y = pk2(y[2], y[3]); w.z = pk2(y[4], y[5]); w.w = pk2(y[6], y[7]);
                    *(GAS u32x4*)(A2 + (size_t)(m + t) * D_MODEL + 1024 + half * 512 + lane * 8) = w; } };
        { u32x4 a0[2][2], b0[2][2], z0[2][2], a1[2][2], b1[2][2], z1[2][2];
            const int st = 2 * NGW; int m = 2 * gw;
            if (m < MTOK) ld2(a0, b0, z0, m);
            for (; m < MTOK; m += 2 * st) {
                if (m + st < MTOK) ld2(a1, b1, z1, m + st);
                do2(a0, b0, z0, m);
                if (m + 2 * st < MTOK) ld2(a0, b0, z0, m + 2 * st);
                if (m + st < MTOK) do2(a1, b1, z1, m + st);
            }
        }
    }
    SEAM(5);

    PH(6) { RPB; OPQ_IDS;
        SchedOut S{(const char*)A2, (const char*)WOUT, G, bid};
        EpiOut E{args.in[I_X], MOD, X2B};
        pg8::gemm_phase<EpiOut, SchedOut, false>(L, TAB, D_MODEL, S, E);
    }
    SEAM(6);

    PH(7) { RPB; OPQ_IDS;
        LAS float* WR = (LAS float*)L;
        for (int i = tid; i < D_MODEL * NE; i += NTHREADS) { const int e = i & 15, k = i >> 4; WR[e * 2048 + ((k >> 2) & 1) * 1024 + (k >> 3) * 4 + (k & 3)] = args.in[I_WROUTER][i]; }
        __syncthreads();
        const float* g2 = args.in[I_N2G];
        bf16_t* HX2 = (bf16_t*)(ws + WS_HX2); float* AFF = (float*)(ws + WS_AFF);
        u32x4 pq0[4], pq1[4];
        if (2 * gw < MTOK) {
#pragma unroll
            for (int jc = 0; jc < 4; ++jc) { pq0[jc] = *((const GAS u32x4*)(X2B + (size_t)(2 * gw) * D_MODEL) + lane + 64 * jc); pq1[jc] = *((const GAS u32x4*)(X2B + (size_t)(2 * gw + 1) * D_MODEL) + lane + 64 * jc); } }
        for (int m0 = 2 * gw; m0 < MTOK; m0 += 2 * NGW) {
            const int b = m0 >> 12;
            const float* sh = MOD + b * 12288 + 3 * 2048; const float* sc = sh + 2048;
            f32x4 v[2][8]; float s0 = 0.f, s1 = 0.f;
            u32x4 cq0[4], cq1[4];
#pragma unroll
            for (int jc = 0; jc < 4; ++jc) { cq0[jc] = pq0[jc]; cq1[jc] = pq1[jc]; }
            { const int mn = m0 + 2 * NGW; if (mn < MTOK) {
#pragma unroll
                for (int jc = 0; jc < 4; ++jc) { pq0[jc] = *((const GAS u32x4*)(X2B + (size_t)mn * D_MODEL) + lane + 64 * jc); pq1[jc] = *((const GAS u32x4*)(X2B + (size_t)(mn + 1) * D_MODEL) + lane + 64 * jc); } } }
#pragma unroll
            for (int jc = 0; jc < 4; ++jc) { const u32x4 q0 = cq0[jc], q1 = cq1[jc];
                v[0][2 * jc] = (f32x4){bf2f(q0.x & 0xffffu), bf2f(q0.x >> 16), bf2f(q0.y & 0xffffu), bf2f(q0.y >> 16)}; v[0][2 * jc + 1] = (f32x4){bf2f(q0.z & 0xffffu), bf2f(q0.z >> 16), bf2f(q0.w & 0xffffu), bf2f(q0.w >> 16)};
                v[1][2 * jc] = (f32x4){bf2f(q1.x & 0xffffu), bf2f(q1.x >> 16), bf2f(q1.y & 0xffffu), bf2f(q1.y >> 16)}; v[1][2 * jc + 1] = (f32x4){bf2f(q1.z & 0xffffu), bf2f(q1.z >> 16), bf2f(q1.w & 0xffffu), bf2f(q1.w >> 16)}; }
#pragma unroll
            for (int j = 0; j < 8; ++j) { s0 += (v[0][j].x * v[0][j].x + v[0][j].y * v[0][j].y) + (v[0][j].z * v[0][j].z + v[0][j].w * v[0][j].w); s1 += (v[1][j].x * v[1][j].x + v[1][j].y * v[1][j].y) + (v[1][j].z * v[1][j].z + v[1][j].w * v[1][j].w); }
#pragma unroll
            for (int o = 1; o < 64; o <<= 1) { s0 += __shfl_xor(s0, o); s1 += __shfl_xor(s1, o); }
            const float r0 = __builtin_amdgcn_rsqf(s0 * (1.f / D_MODEL) + EPS), r1 = __builtin_amdgcn_rsqf(s1 * (1.f / D_MODEL) + EPS);
#pragma unroll
            for (int jc = 0; jc < 4; ++jc) { const int c0 = 8 * (lane + 64 * jc); u32x4 w0, w1;
#pragma unroll
                for (int hh = 0; hh < 2; ++hh) { const f32x4 gg = *(const GAS f32x4*)(g2 + c0 + 4 * hh), sc1 = *(const GAS f32x4*)(sc + c0 + 4 * hh) + 1.f, h1 = *(const GAS f32x4*)(sh + c0 + 4 * hh);
                    const f32x4 y0 = v[0][2 * jc + hh] * r0 * gg * sc1 + h1, y1 = v[1][2 * jc + hh] * r1 * gg * sc1 + h1; v[0][2 * jc + hh] = y0; v[1][2 * jc + hh] = y1;
                    if (hh == 0) { w0.x = pk2(y0.x, y0.y); w0.y = pk2(y0.z, y0.w); w1.x = pk2(y1.x, y1.y); w1.y = pk2(y1.z, y1.w); } else { w0.z = pk2(y0.x, y0.y); w0.w = pk2(y0.z, y0.w); w1.z = pk2(y1.x, y1.y); w1.w = pk2(y1.z, y1.w); } }
                *((GAS u32x4*)(HX2 + (size_t)m0 * D_MODEL) + lane + 64 * jc) = w0; *((GAS u32x4*)(HX2 + (size_t)(m0 + 1) * D_MODEL) + lane + 64 * jc) = w1; }
            float a0[16], a1[16];
#pragma unroll
            for (int eg = 0; eg < 4; ++eg) {
#pragma unroll
                for (int q = 0; q < 4; ++q) { const int e = 4 * eg + q; float c0 = 0.f, c1 = 0.f;
#pragma unroll
                    for (int j = 0; j < 8; ++j) { const f32x4 w4 = *(const LAS f32x4*)(WR + e * 2048 + (j & 1) * 1024 + 4 * (lane + 64 * (j >> 1)));
                        c0 += (v[0][j].x * w4.x + v[0][j].y * w4.y) + (v[0][j].z * w4.z + v[0][j].w * w4.w); c1 += (v[1][j].x * w4.x + v[1][j].y * w4.y) + (v[1][j].z * w4.z + v[1][j].w * w4.w); }
                    a0[e] = c0; a1[e] = c1; }
                asm volatile("" ::: "memory"); }
#pragma unroll
            for (int st = 0; st < 4; ++st) { const int msk = 1 << st, n2 = 8 >> st; const bool up = (lane & msk) != 0;
#pragma unroll
                for (int q = 0; q < 8; ++q) if (q < n2) { const float k0 = up ? a0[q + n2] : a0[q], d0 = up ? a0[q] : a0[q + n2], k1 = up ? a1[q + n2] : a1[q], d1 = up ? a1[q] : a1[q + n2];
                    a0[q] = k0 + __shfl_xor(d0, msk); a1[q] = k1 + __shfl_xor(d1, msk); } }
            float l0 = a0[0], l1 = a1[0]; l0 += __shfl_xor(l0, 16); l1 += __shfl_xor(l1, 16); l0 += __shfl_xor(l0, 32); l1 += __shfl_xor(l1, 32);
            float mx0 = l0, mx1 = l1;
#pragma unroll
            for (int o = 1; o < 16; o <<= 1) { mx0 = fmaxf(mx0, __shfl_xor(mx0, o)); mx1 = fmaxf(mx1, __shfl_xor(mx1, o)); }
            const float e0 = expf(l0 - mx0), e1 = expf(l1 - mx1); float dn0 = e0, dn1 = e1;
#pragma unroll
            for (int o = 1; o < 16; o <<= 1) { dn0 += __shfl_xor(dn0, o); dn1 += __shfl_xor(dn1, o); }
            const int eidx = ((lane & 1) << 3) | ((lane & 2) << 1) | ((lane & 4) >> 1) | ((lane & 8) >> 3);
            if (lane < 16) { float* ap = AFF + ((size_t)b * NE + eidx) * SEQ + (m0 & 4095); f32x2 pr = {e0 / dn0, e1 / dn1}; *(GAS f32x2*)ap = pr; }
        }
    }
    SEAM(7);

    PH(8) { RPB; OPQ_IDS;
        for (int u = bid; u < BATCH * NE; u += G) topk_unit(L, u, (const float*)(ws + WS_AFF), (int*)(ws + WS_IDX), (float*)(ws + WS_VAL), (int*)(ws + WS_SLOT));
    }
    SEAM(8);

    PH(9) { RPB; OPQ_IDS;
        SchedGU S{(const char*)(ws + WS_HX2), (const char*)(ws + WS_WGU), (const int*)(ws + WS_IDX), G, bid};
        EpiGU E{(bf16_t*)(ws + WS_HID)};
        pg8::gemm_phase<EpiGU, SchedGU, true>(L, TAB, D_MODEL, S, E);
    }
    SEAM(9);

    PH(10) { RPB; OPQ_IDS;
        SchedDN S{(const char*)(ws + WS_HID), (const char*)(ws + WS_WDN), G, bid};
        EpiDN E{(bf16_t*)(ws + WS_YB), (const float*)(ws + WS_VAL)};
        pg8::gemm_phase<EpiDN, SchedDN, false>(L, TAB, FF, S, E);
    }
    SEAM(10);

    PH(11) { RPB; OPQ_IDS;
        const float* nf = args.in[I_NORMF]; const bf16_t* YB = (const bf16_t*)(ws + WS_YB); const int* SLOT = (const int*)(ws + WS_SLOT);
        f32x4 cg[8], cn[8]; int curb = -1;
        const int RW = (MTOK + NGW - 1) / NGW;
        for (int k = 0; k < RW; ++k) {
            const int m = gw * RW + k; if (m >= MTOK) break;
            const int b = m >> 12;
            if (b != curb) { curb = b; const float* gt = MOD + b * 12288 + 5 * 2048;
#pragma unroll
                for (int jc = 0; jc < 4; ++jc) { const int c0 = 8 * (lane + 64 * jc); cg[2 * jc] = *(const GAS f32x4*)(gt + c0); cg[2 * jc + 1] = *(const GAS f32x4*)(gt + c0 + 4); cn[2 * jc] = *(const GAS f32x4*)(nf + c0); cn[2 * jc + 1] = *(const GAS f32x4*)(nf + c0 + 4); } }
            f32x4 v[8], y[8];
            u32x4 xq[4];
#pragma unroll
            for (int jc = 0; jc < 4; ++jc) xq[jc] = *((const GAS u32x4*)(X2B + (size_t)m * D_MODEL) + lane + 64 * jc);
            const int myslot = SLOT[(size_t)m * NE + (lane & 15)];
#pragma unroll
            for (int j = 0; j < 8; ++j) y[j] = (f32x4){0.f, 0.f, 0.f, 0.f};
            unsigned emask = (unsigned)(__ballot(myslot >= 0) & 0xffffull);
#pragma unroll 1
            while (emask) {
                int es[4], sl[4];
#pragma unroll
                for (int q = 0; q < 4; ++q) { if (emask) { es[q] = __builtin_ctz(emask); emask &= emask - 1; sl[q] = __builtin_amdgcn_readlane(myslot, es[q]); } else { es[q] = 0; sl[q] = -1; } }
                u32x4 w[4][4];
#pragma unroll
                for (int q = 0; q < 4; ++q) if (sl[q] >= 0) { const GAS u32x4* yr = (const GAS u32x4*)(YB + ((size_t)(b * NE + es[q]) * CAP + sl[q]) * D_MODEL) + lane;
#pragma unroll
                    for (int jc = 0; jc < 4; ++jc) w[q][jc] = yr[64 * jc]; }
#pragma unroll
                for (int q = 0; q < 4; ++q) if (sl[q] >= 0) {
#pragma unroll
                    for (int jc = 0; jc < 4; ++jc) { y[2 * jc].x += bf2f(w[q][jc].x & 0xffffu); y[2 * jc].y += bf2f(w[q][jc].x >> 16); y[2 * jc].z += bf2f(w[q][jc].y & 0xffffu); y[2 * jc].w += bf2f(w[q][jc].y >> 16);
                        y[2 * jc + 1].x += bf2f(w[q][jc].z & 0xffffu); y[2 * jc + 1].y += bf2f(w[q][jc].z >> 16); y[2 * jc + 1].z += bf2f(w[q][jc].w & 0xffffu); y[2 * jc + 1].w += bf2f(w[q][jc].w >> 16); } }
            }
            float s = 0.f;
#pragma unroll
            for (int jc = 0; jc < 4; ++jc) { v[2 * jc] = (f32x4){bf2f(xq[jc].x & 0xffffu), bf2f(xq[jc].x >> 16), bf2f(xq[jc].y & 0xffffu), bf2f(xq[jc].y >> 16)}; v[2 * jc + 1] = (f32x4){bf2f(xq[jc].z & 0xffffu), bf2f(xq[jc].z >> 16), bf2f(xq[jc].w & 0xffffu), bf2f(xq[jc].w >> 16)}; }
#pragma unroll
            for (int j = 0; j < 8; ++j) { v[j] = v[j] + cg[j] * y[j]; s += (v[j].x * v[j].x + v[j].y * v[j].y) + (v[j].z * v[j].z + v[j].w * v[j].w); }
            const float rstd = __builtin_amdgcn_rsqf(wave_sum(s) * (1.f / D_MODEL) + EPS);
            float* orow = args.out + (size_t)m * D_MODEL;
#pragma unroll
            for (int jc = 0; jc < 4; ++jc) { const int c0 = 8 * (lane + 64 * jc); __builtin_nontemporal_store(v[2 * jc] * rstd * cn[2 * jc], (GAS f32x4*)(orow + c0)); __builtin_nontemporal_store(v[2 * jc + 1] * rstd * cn[2 * jc + 1], (GAS f32x4*)(orow + c0 + 4)); }
        }
    }
#ifdef TPROBE_A
    __syncthreads();
    if (bid == 0 && tid == 0) { asm volatile("s_waitcnt vmcnt(0)" ::: "memory"); const unsigned long long te = __builtin_amdgcn_s_memrealtime(); TSB[12] = te;
        const float ta = (float)(TSB[TPROBE_A + 1] - TSB[TPROBE_A]) * 0.1f, tb = (float)(TSB[TPROBE_B + 1] - TSB[TPROBE_B]) * 0.1f;
        args.out[0] = ta; for (int i = 1; i <= 100; ++i) args.out[i] = tb; }
#endif
#undef IN
#undef SEAM
}

constexpr int NPHASES = 12;

extern "C" void kernel_launch(void* const* d_in, const int* in_sizes, int n_in, void* d_out, int out_size, void* d_ws, size_t ws_size, hipStream_t stream) {
    static int grid = 0;
    if (grid == 0) {
        if (n_in != 19 || out_size != MTOK * D_MODEL || ws_size < WS_END) { fprintf(stderr, "kernel_launch: unexpected shapes (n_in %d out %d ws %zu)\n", n_in, out_size, ws_size); grid = -1; return; }
        int dev = 0, cus = 0, per_cu = 0;
        if (hipGetDevice(&dev) != hipSuccess || hipDeviceGetAttribute(&cus, hipDeviceAttributeMultiprocessorCount, dev) != hipSuccess) { grid = -1; return; }
        if (hipFuncSetAttribute((const void*)fwd_kernel, hipFuncAttributeMaxDynamicSharedMemorySize, LDS_BYTES) != hipSuccess) { grid = -1; return; }
        if (hipOccupancyMaxActiveBlocksPerMultiprocessor(&per_cu, (const void*)fwd_kernel, NTHREADS, LDS_BYTES) != hipSuccess || per_cu < 1) { fprintf(stderr, "occupancy query: %d\n", per_cu); grid = -1; return; }
        grid = cus;
    }
    if (grid < 0) return;
    if (hipMemsetAsync((char*)d_ws + WS_CTL, 0, CTL_ZERO_BYTES, stream) != hipSuccess) return;
    Args a{};
    for (int i = 0; i < 19; ++i) a.in[i] = (const float*)d_in[i];
    a.out = (float*)d_out; a.ws = (unsigned char*)d_ws; a.ph_lo = 0; a.ph_hi = NPHASES;
    hipLaunchKernelGGL(fwd_kernel, dim3(grid), dim3(NTHREADS), LDS_BYTES, stream, a);
}
```

```cpp
#include <hip/hip_runtime.h>
#include <cstdio>
#include <cstdint>

#define GAS __attribute__((address_space(1)))
#define LAS __attribute__((address_space(3)))
typedef unsigned short bf16_t;
typedef short bf16x8 __attribute__((ext_vector_type(8)));
typedef short s16x4 __attribute__((ext_vector_type(4)));
typedef float f32x2 __attribute__((ext_vector_type(2)));
typedef float f32x4 __attribute__((ext_vector_type(4)));
typedef float f32x16 __attribute__((ext_vector_type(16)));
typedef unsigned u32x2 __attribute__((ext_vector_type(2)));
typedef unsigned u32x4 __attribute__((ext_vector_type(4)));
typedef __bf16 bf16x2_t __attribute__((ext_vector_type(2)));

constexpr int NWAVES = 8, NTHREADS = 512;
constexpr int D_MODEL = 2048, BATCH = 4, SEQ = 4096, MTOK = BATCH * SEQ, CTX = 256, MCTX = BATCH * CTX, MALL = MTOK + MCTX;
constexpr int FW = 1024, GDW = 1024, NH = 8, HD = 128, INC = 5152, INC_PAD = 5376;
constexpr int NE = 16, CAP = 512, FF = 1536;
constexpr float EPS = 1e-6f;

constexpr size_t MiB = 1u << 20;
constexpr size_t WS_CTL = 0, CTL_ZERO_BYTES = 1 * MiB;
constexpr size_t WS_MOD = 1 * MiB;
constexpr size_t WS_TW = WS_MOD + 256 * 1024;
constexpr size_t WS_DA = WS_TW + 32 * 1024;
constexpr size_t WS_DB = WS_DA + 16 * 1024;
constexpr size_t WS_DC = WS_DB + 32 * 1024;
constexpr size_t WS_WIN = 2 * MiB;
constexpr size_t WS_WOUT = WS_WIN + (size_t)INC_PAD * D_MODEL * 2;
constexpr size_t WS_WGU = WS_WOUT + (size_t)D_MODEL * D_MODEL * 2;
constexpr size_t WS_WDN = WS_WGU + (size_t)NE * 2 * FF * D_MODEL * 2;
constexpr size_t WS_PF = WS_WDN + (size_t)NE * D_MODEL * FF * 2;
constexpr size_t WS_PQKV = WS_PF + (size_t)MTOK * FW * 2;
constexpr size_t WS_PZ = WS_PQKV + (size_t)MALL * 3 * GDW * 2;
constexpr size_t WS_PAB = WS_PZ + (size_t)MTOK * GDW * 2;
constexpr size_t WS_G = WS_PAB + (size_t)MALL * 32 * 4;
constexpr size_t WS_HX2 = WS_G;
constexpr size_t WS_HID = WS_HX2 + (size_t)MTOK * D_MODEL * 2;
constexpr size_t WS_YB = WS_HID + (size_t)BATCH * NE * CAP * FF * 2;
constexpr size_t WS_AFF = WS_YB + (size_t)BATCH * NE * CAP * D_MODEL * 2;
constexpr size_t WS_IDX = WS_AFF + (size_t)BATCH * NE * SEQ * 4;
constexpr size_t WS_VAL = WS_IDX + (size_t)BATCH * NE * CAP * 4;
constexpr size_t WS_SLOT = WS_VAL + (size_t)BATCH * NE * CAP * 4;
constexpr size_t WS_A2 = WS_PF;
constexpr size_t WS_HXC = WS_G + (size_t)(BATCH * NH * 2 * 68) * 73984;
constexpr size_t WS_END = 800 * MiB;
static_assert(WS_HXC + (size_t)MCTX * D_MODEL * 2 <= WS_END, "ws map: HX context rows");
static_assert(WS_SLOT + (size_t)MTOK * NE * 4 <= WS_END, "ws map");


constexpr int RING_BYTES = 131072;
constexpr int TAB_OFF = RING_BYTES;
constexpr int MISC_OFF = TAB_OFF + 16384;
constexpr int LDS_BYTES = MISC_OFF + 256;

constexpr int CW_BAR = 4096;
constexpr int CW_Q0 = 8128, CW_Q1 = 8192, CW_Q2 = 8256;

__device__ __forceinline__ unsigned f2bf(float f) { unsigned u = __builtin_bit_cast(unsigned, f); return (u + 0x7fffu + ((u >> 16) & 1u)) >> 16; }
__device__ __forceinline__ float bf2f(unsigned h) { return __builtin_bit_cast(float, h << 16); }
__device__ __forceinline__ unsigned pk2(float lo, float hi) { f32x2 v = {lo, hi}; bf16x2_t b = __builtin_convertvector(v, bf16x2_t); return __builtin_bit_cast(unsigned, b); }
__device__ __forceinline__ float wave_sum(float v) {
#pragma unroll
    for (int o = 1; o < 64; o <<= 1) v += __shfl_xor(v, o);
    return v;
}
__device__ __forceinline__ float dpp_xor1(float v) { return __builtin_bit_cast(float, __builtin_amdgcn_mov_dpp(__builtin_bit_cast(int, v), 0xB1, 0xf, 0xf, true)); }
__device__ __forceinline__ float dpp_xor2(float v) { return __builtin_bit_cast(float, __builtin_amdgcn_mov_dpp(__builtin_bit_cast(int, v), 0x4E, 0xf, 0xf, true)); }
__device__ __forceinline__ float silu_f(float v) { return v * __builtin_amdgcn_rcpf(1.f + __expf(-v)); }
#define LDS_WAIT() asm volatile("s_waitcnt lgkmcnt(0)" ::: "memory")
#define LBAR() do { asm volatile("s_waitcnt lgkmcnt(0)" ::: "memory"); __builtin_amdgcn_s_barrier(); asm volatile("" ::: "memory"); } while (0)

#define XB_TMO      128
#define XB_XCNT(j)  (256  + 64 * (j))
#define XB_XSUB(j)  (1280 + 64 * (j))
#define XB_XGEN(j)  (2304 + 64 * (j))
#define XB_TOP      3328
#define XB_TOPGEN   3392
#define XCD_BAR_WORDS 3456
#define XB_SPIN_CAP (1u << 18)
__device__ __forceinline__ unsigned xb_ld(unsigned* p)              { return __hip_atomic_load(p, __ATOMIC_RELAXED, __HIP_MEMORY_SCOPE_AGENT); }
__device__ __forceinline__ unsigned xb_add(unsigned* p, unsigned v) { return __hip_atomic_fetch_add(p, v, __ATOMIC_RELAXED, __HIP_MEMORY_SCOPE_AGENT); }
__device__ __forceinline__ unsigned xb_xcc_id() { return (unsigned)__builtin_amdgcn_s_getreg((3 << 11) | 20) & 0xFu; }
#define XB_SPIN(cond, bar) do { unsigned _sp = 0; while (cond) { __builtin_amdgcn_s_sleep(1); \
    if ((++_sp & 255u) == 0u) { if (xb_ld(&(bar)[XB_TMO])) break; if (_sp > XB_SPIN_CAP) { atomicAdd(&(bar)[XB_TMO], 1u); break; } } } } while (0)
struct XcdBarrier { unsigned* bar; unsigned x; volatile LAS unsigned* st; };
__device__ __forceinline__ XcdBarrier xcd_barrier_post(unsigned* bar, volatile LAS unsigned* st) {
    XcdBarrier b; b.bar = bar; b.x = xb_xcc_id(); b.st = st;
    if (threadIdx.x == 0) (void)xb_add(&bar[XB_XCNT(b.x)], 1u);
    return b;
}
__device__ __forceinline__ void xcd_barrier_complete(unsigned* bar, unsigned x, unsigned& nloc, unsigned& nx) {
    const unsigned G = gridDim.x * gridDim.y * gridDim.z;
    unsigned sum, cnt, mine, sp = 0u;
    for (;;) {
        sum = 0u; cnt = 0u; mine = 0u;
#pragma unroll
        for (unsigned j = 0; j < 16; ++j) { const unsigned c = xb_ld(&bar[XB_XCNT(j)]); sum += c; cnt += (c > 0u) ? 1u : 0u; mine = (j == x) ? c : mine; }
        if (sum == G) break;
        __builtin_amdgcn_s_sleep(1);
        if ((++sp & 255u) == 0u) { if (xb_ld(&bar[XB_TMO])) break; if (sp > XB_SPIN_CAP) { atomicAdd(&bar[XB_TMO], 1u); break; } }
    }
    nloc = mine > 0u ? mine : 1u; nx = cnt > 0u ? cnt : 1u;
}
__device__ __forceinline__ void xcd_barrier(const XcdBarrier& b) {
    asm volatile("s_waitcnt vmcnt(0)" ::: "memory");
    __syncthreads();
    if (threadIdx.x == 0) {
        unsigned* bar = b.bar;
        __builtin_amdgcn_s_waitcnt(0);
        unsigned nloc = b.st[0], nx = b.st[1];
        if (nloc == 0u) { xcd_barrier_complete(bar, b.x, nloc, nx); b.st[0] = nloc; b.st[1] = nx; }
        const unsigned old = xb_add(&bar[XB_XSUB(b.x)], 1u);
        const unsigned gen = old / nloc;
        if (old + 1u == (gen + 1u) * nloc) {
            __builtin_amdgcn_fence(__ATOMIC_RELEASE, "agent");
            asm volatile("s_waitcnt vmcnt(0)" ::: "memory");
            const unsigned og = xb_add(&bar[XB_TOP], 1u);
            const unsigned tg = og / nx;
            if (og + 1u == (tg + 1u) * nx) xb_add(&bar[XB_TOPGEN], 1u);
            else XB_SPIN(xb_ld(&bar[XB_TOPGEN]) == tg, bar);
            __builtin_amdgcn_fence(__ATOMIC_ACQUIRE, "agent");
            xb_add(&bar[XB_XGEN(b.x)], 1u);
            asm volatile("s_waitcnt vmcnt(0)" ::: "memory");
        } else {
            XB_SPIN(xb_ld(&bar[XB_XGEN(b.x)]) == gen, bar);
            __builtin_amdgcn_fence(__ATOMIC_ACQUIRE, "agent");
            asm volatile("s_waitcnt vmcnt(0)" ::: "memory");
        }
    }
    __syncthreads();
}

namespace pg8 {
constexpr int BM = 256, BK = 64, HALF = 128, HTB = HALF * BK * 2, STAGE_BYTES = 8 * HTB, NXCD = 8, WGM = 8;
__host__ __device__ __forceinline__ int lds_byte(int r, int c) { const int st = (r >> 4) * 2 + (c >> 5), rr = r & 15, cc = c & 31, ob = rr * 64 + cc * 2; return st * 1024 + (ob ^ (((ob >> 9) & 1) << 5)); }
__host__ __device__ __forceinline__ void stage_rc(int b, int& R, int& C) { const int st = b / 1024, sb = b % 1024, swz = sb ^ (((sb >> 9) & 1) << 5); R = (st >> 1) * 16 + swz / 64; C = (st & 1) * 32 + (swz % 64) / 2; }
__host__ __device__ __forceinline__ int perm32(int rho) { const int n = rho >> 4, i = rho & 15; return 8 * (i >> 2) + 4 * n + (i & 3); }

struct Unit { const char* a; const char* b; const int* gidx; int pm, pn, aux; };

template <class Epi, class Sched, bool GATHER>
__device__ __forceinline__ void gemm_phase(LAS unsigned char* lds, LAS unsigned* tab, const int K, const Sched& S, const Epi& E) {
    int tid_ = threadIdx.x; asm volatile("" : "+v"(tid_));
    const int tid = tid_, wid = __builtin_amdgcn_readfirstlane(tid >> 6), lane = tid & 63, wr = wid >> 2, wc = wid & 3, fr = lane & 15, fq = lane >> 4;
    const int nt = K / BK;
    unsigned voffA[2], voffB[2];
#pragma unroll
    for (int i = 0; i < 2; ++i) { int R, C; stage_rc(tid * 16 + i * 8192, R, C); const int Rb = Epi::PERM ? ((R & ~31) + perm32(R & 31)) : R;
        voffA[i] = (unsigned)(R * K + C) * 2u; voffB[i] = (unsigned)(Rb * K + C) * 2u; }
    const size_t kstep = (size_t)(BK * 2);
    const size_t hstep = (size_t)HALF * K * 2;
    const unsigned ldsw = (unsigned)wid * 1024u;
    const int aoff = lds_byte(wr * 64 + fr, fq * 8), boff = lds_byte(wc * 32 + fr, fq * 8);
#define PG8_SA(b, h) (((b) * 2 + (h)) * HTB)
#define PG8_SB(b, h) ((4 + (b) * 2 + (h)) * HTB)
#define PG8_STAGE(bufoff, gbase, voff) do { _Pragma("unroll") for (int _i = 0; _i < 2; ++_i) \
        __builtin_amdgcn_global_load_lds((const unsigned*)((const char*)(gbase) + (voff)[_i]), (LAS unsigned*)(lds + (bufoff) + ldsw + _i * 8192), 16, 0, 0); } while (0)
#define PG8_STAGE_A(bufoff, gbase, par, h) do { if constexpr (GATHER) { _Pragma("unroll") for (int _i = 0; _i < 2; ++_i) { const unsigned _o = tab[(((par) * 2 + (h)) * 2 + _i) * 512 + tid]; \
            __builtin_amdgcn_global_load_lds((const unsigned*)((const char*)(gbase) + _o), (LAS unsigned*)(lds + (bufoff) + ldsw + _i * 8192), 16, 0, 0); } } \
        else { PG8_STAGE(bufoff, (gbase) + (h) * hstep, voffA); } } while (0)
#define PG8_LDA(dst, b, h) do { _Pragma("unroll") for (int m = 0; m < 4; ++m) _Pragma("unroll") for (int k = 0; k < 2; ++k) dst[m][k] = *(const LAS bf16x8*)(lds + PG8_SA(b, h) + aoff + m * 2048 + k * 1024); } while (0)
#define PG8_LDB(dst, b, h) do { _Pragma("unroll") for (int n = 0; n < 2; ++n) _Pragma("unroll") for (int k = 0; k < 2; ++k) dst[n][k] = *(const LAS bf16x8*)(lds + PG8_SB(b, h) + boff + n * 2048 + k * 1024); } while (0)
#define PG8_MMA(ai, bj, At, Bt) do { __builtin_amdgcn_s_setprio(1); _Pragma("unroll") for (int m = 0; m < 4; ++m) _Pragma("unroll") for (int n = 0; n < 2; ++n) _Pragma("unroll") for (int k = 0; k < 2; ++k) \
        acc[ai][bj][m][n] = __builtin_amdgcn_mfma_f32_16x16x32_bf16(Bt[n][k], At[m][k], acc[ai][bj][m][n], 0, 0, 0); __builtin_amdgcn_s_setprio(0); } while (0)
#define PG8_WAIT_V(n) asm volatile("s_waitcnt vmcnt(" #n ")" ::: "memory")
#define PG8_WAIT_L(n) asm volatile("s_waitcnt lgkmcnt(" #n ")" ::: "memory")
#define PG8_BAR __builtin_amdgcn_s_barrier()
#define PG8_SCHED __builtin_amdgcn_sched_barrier(0)
#define PG8_FILL(par, u) do { if constexpr (GATHER) { _Pragma("unroll") for (int _h = 0; _h < 2; ++_h) _Pragma("unroll") for (int _i = 0; _i < 2; ++_i) { int R_, C_; stage_rc(tid * 16 + _i * 8192, R_, C_); \
        const int row_ = (u).gidx[_h * HALF + R_]; tab[(((par) * 2 + _h) * 2 + _i) * 512 + tid] = (unsigned)(row_ * K + C_) * 2u; } } } while (0)
    Unit cur, nxt; int ui = 0; int par = 0;
    if (!S.next(0, cur)) return;
    f32x4 acc[2][2][4][2];
#pragma unroll
    for (int a = 0; a < 2; ++a)
#pragma unroll
        for (int b = 0; b < 2; ++b)
#pragma unroll
            for (int m = 0; m < 4; ++m)
#pragma unroll
                for (int n = 0; n < 2; ++n) acc[a][b][m][n] = (f32x4){0.f, 0.f, 0.f, 0.f};
    bf16x8 At[4][2], B0[2][2], B1[2][2];
    const char* cA = cur.a; const char* cB = cur.b;
    PG8_FILL(0, cur);
    PG8_STAGE(PG8_SB(0, 0), cB, voffB); PG8_STAGE(PG8_SB(0, 1), cB + hstep, voffB); PG8_STAGE_A(PG8_SA(0, 0), cA, 0, 0); PG8_STAGE_A(PG8_SA(0, 1), cA, 0, 1);
    if (wr == 1) PG8_BAR;
    PG8_WAIT_V(2); PG8_BAR;
    PG8_STAGE(PG8_SB(1, 0), cB + kstep, voffB); PG8_STAGE_A(PG8_SA(1, 0), cA + kstep, 0, 0); PG8_STAGE(PG8_SB(1, 1), cB + hstep + kstep, voffB);
    PG8_WAIT_V(6); PG8_BAR;
    for (;;) {
        const bool has_next = S.next(ui + 1, nxt);
        const char* nA = has_next ? nxt.a : cA; const char* nB = has_next ? nxt.b : cB;
        const int npar = has_next ? (par ^ 1) : par;
        for (int t = 0; t < nt; t += 2) {
            const bool last = (t == nt - 2);
            const char* a1 = cA + (size_t)(t + 1) * kstep;
            const char* a2 = last ? nA : cA + (size_t)(t + 2) * kstep; const char* b2 = last ? nB : cB + (size_t)(t + 2) * kstep;
            const char* a3 = a2 + kstep; const char* b3 = b2 + kstep;
            const int p2 = last ? npar : par;
            if (last && has_next) PG8_FILL(npar, nxt);
            PG8_LDB(B0, 0, 0); PG8_LDB(B1, 0, 1); PG8_SCHED; PG8_LDA(At, 0, 0); PG8_STAGE_A(PG8_SA(1, 1), a1, par, 1);
            PG8_WAIT_V(8); PG8_WAIT_L(0); PG8_BAR; PG8_MMA(0, 0, At, B0); PG8_MMA(0, 1, At, B1); PG8_BAR; PG8_SCHED;
            PG8_LDA(At, 0, 1); PG8_STAGE(PG8_SB(0, 0), b2, voffB); PG8_STAGE(PG8_SB(0, 1), b2 + hstep, voffB); PG8_STAGE_A(PG8_SA(0, 0), a2, p2, 0);
            PG8_WAIT_V(8); PG8_WAIT_L(0); PG8_BAR; PG8_MMA(1, 0, At, B0); PG8_MMA(1, 1, At, B1); PG8_BAR; PG8_SCHED;
            PG8_LDB(B0, 1, 0); PG8_LDB(B1, 1, 1); PG8_SCHED; PG8_LDA(At, 1, 0); PG8_STAGE_A(PG8_SA(0, 1), a2, p2, 1);
            PG8_WAIT_V(8); PG8_WAIT_L(0); PG8_BAR; PG8_MMA(0, 0, At, B0); PG8_MMA(0, 1, At, B1); PG8_BAR; PG8_SCHED;
            PG8_LDA(At, 1, 1); PG8_STAGE(PG8_SB(1, 0), b3, voffB); PG8_STAGE(PG8_SB(1, 1), b3 + hstep, voffB); PG8_STAGE_A(PG8_SA(1, 0), a3, p2, 0);
            PG8_WAIT_V(8); PG8_WAIT_L(0); PG8_BAR; PG8_MMA(1, 0, At, B0); PG8_MMA(1, 1, At, B1); PG8_BAR; PG8_SCHED;
        }
        if (wr == 0) PG8_BAR;
        E(acc, cur, wr, wc, fr, fq);
        if (!has_next) break;
#pragma unroll
        for (int a = 0; a < 2; ++a)
#pragma unroll
            for (int b = 0; b < 2; ++b)
#pragma unroll
                for (int m = 0; m < 4; ++m)
#pragma unroll
                    for (int n = 0; n < 2; ++n) acc[a][b][m][n] = (f32x4){0.f, 0.f, 0.f, 0.f};
        cur = nxt; cA = nA; cB = nB; par = npar; ++ui;
        if (wr == 1) PG8_BAR;
    }
    PG8_WAIT_V(0);
    PG8_BAR;
#undef PG8_SA
#undef PG8_SB
#undef PG8_STAGE
#undef PG8_STAGE_A
#undef PG8_LDA
#undef PG8_LDB
#undef PG8_MMA
#undef PG8_WAIT_V
#undef PG8_WAIT_L
#undef PG8_BAR
#undef PG8_SCHED
#undef PG8_FILL
}
}

__device__ __forceinline__ bf16x8 frag_row(const LAS bf16_t* base, int ld, int r0, int k0, int lane) {
    return *(const LAS bf16x8*)(base + (r0 + (lane & 31)) * ld + k0 + 8 * (lane >> 5));
}
__device__ __forceinline__ bf16x8 frag_tr(const LAS bf16_t* base, int ld, int r0, int k0, int lane) {
    const int h = lane >> 5, blk = (lane >> 4) & 1, q = (lane & 15) >> 2, p = lane & 3;
    const LAS bf16_t* a0 = base + (k0 + 8 * h + q) * ld + r0 + 16 * blk + 4 * p;
    const s16x4 lo = __builtin_bit_cast(s16x4, __builtin_amdgcn_ds_read_tr16_b64_v4i16((LAS s16x4*)a0));
    const s16x4 hi = __builtin_bit_cast(s16x4, __builtin_amdgcn_ds_read_tr16_b64_v4i16((LAS s16x4*)(a0 + 4 * ld)));
    return (bf16x8){lo[0], lo[1], lo[2], lo[3], hi[0], hi[1], hi[2], hi[3]};
}
__device__ __forceinline__ int crow(int r, int lane) { return (r & 3) + 8 * (r >> 2) + 4 * (lane >> 5); }
#define MFMA32(a, b, c) __builtin_amdgcn_mfma_f32_32x32x16_bf16((a), (b), (c), 0, 0, 0)
constexpr f32x16 Z16 = {0.f, 0.f, 0.f, 0.f, 0.f, 0.f, 0.f, 0.f, 0.f, 0.f, 0.f, 0.f, 0.f, 0.f, 0.f, 0.f};


constexpr int CVT_BLOCK_ITEMS = 3 * 3072;
struct CvtJob { f32x4 v[8]; int item; };
__device__ __forceinline__ void cvt_issue(CvtJob& c, int item, int lane, const float* wg, const float* wu, const float* wd) {
    c.item = item;
    if (item < 0) return;
    const int kc = lane & 7, ng = lane >> 3; const int bi = item >> 3, sub = item & 7;
    const float* src; int ldn, k0, n0;
    if (bi < 6144) { const int up = bi >= 3072, r0 = bi - up * 3072, e = r0 / 192, r = r0 % 192; src = (up ? wu : wg) + (size_t)e * D_MODEL * FF; ldn = FF; k0 = 64 * (r / 6); n0 = 256 * (r % 6) + 32 * sub; }
    else { const int r0 = bi - 6144, e = r0 / 192, r = r0 % 192; src = wd + (size_t)e * FF * D_MODEL; ldn = D_MODEL; k0 = 64 * (r / 8); n0 = 256 * (r % 8) + 32 * sub; }
    const float* p = src + (size_t)(k0 + 8 * kc) * ldn + n0 + 4 * ng;
#pragma unroll
    for (int i = 0; i < 8; ++i) c.v[i] = *(const GAS f32x4*)(p + (size_t)i * ldn);
}
__device__ __forceinline__ void cvt_finish(const CvtJob& c, int lane, bf16_t* WGU, bf16_t* WDN) {
    const int item = c.item;
    if (item < 0) return;
    const int kc = lane & 7, ng = lane >> 3; const int bi = item >> 3, sub = item & 7;
    bf16_t* dst; int dstK, k0, n0, mode;
    if (bi < 6144) { const int up = bi >= 3072, r0 = bi - up * 3072, e = r0 / 192, r = r0 % 192; dst = WGU + (size_t)e * 2 * FF * D_MODEL; dstK = D_MODEL; k0 = 64 * (r / 6); n0 = 256 * (r % 6) + 32 * sub; mode = 1 + up; }
    else { const int r0 = bi - 6144, e = r0 / 192, r = r0 % 192; dst = WDN + (size_t)e * D_MODEL * FF; dstK = FF; k0 = 64 * (r / 8); n0 = 256 * (r % 8) + 32 * sub; mode = 0; }
    const int n = n0 + 4 * ng;
    const int row0 = mode == 0 ? n : (256 * (n >> 7) + 128 * (mode - 1) + (n & 127));
    bf16_t* o = dst + (size_t)row0 * dstK + k0 + 8 * kc;
#pragma unroll
    for (int j = 0; j < 4; ++j) { u32x4 w; w.x = pk2(c.v[0][j], c.v[1][j]); w.y = pk2(c.v[2][j], c.v[3][j]); w.z = pk2(c.v[4][j], c.v[5][j]); w.w = pk2(c.v[6][j], c.v[7][j]);
        *(GAS u32x4*)(o + (size_t)j * dstK) = w; }
}
struct CvtShadow { int base, left; };
__device__ __forceinline__ int cvt_next(CvtShadow& cs, unsigned* q, int lane) {
    if (cs.left == 0) { if (cs.base == -2) return -1; unsigned v = 0; if (lane == 0) v = atomicAdd(q, 1u); const int b = (int)__builtin_amdgcn_readfirstlane(v);
        if (b >= CVT_BLOCK_ITEMS) { cs.base = -2; return -1; } cs.base = b * 8; cs.left = 8; }
    const int it = cs.base + (8 - cs.left); --cs.left; return it;
}
constexpr int REC_W = 0, REC_UT = 16384, REC_QD = 32768, REC_KDT = 49152, REC_QK = 65536, REC_GT = 73728, REC_BYTES = 73984;
constexpr int NREC_X = BATCH * NH * 2 * 64, NREC = NREC_X + BATCH * NH * 2 * 4;
__device__ __forceinline__ size_t rec_index(bool isctx, int b, int h, int d, int c) { return isctx ? (size_t)(NREC_X + ((b * NH + h) * 2 + d) * 4 + c) : (size_t)(((b * NH + h) * 2 + d) * 64 + c); }
__device__ __forceinline__ float softplus_f(float v) { return v > 20.f ? v : log1pf(__expf(v)); }

struct GdnItem { bool isctx; int b, h, c, rowbase, vlo, vhi; };
__device__ __forceinline__ GdnItem gdn_decode(int item) {
    GdnItem I;
    if (item < BATCH * NH * 64) { I.isctx = false; I.b = item >> 9; I.h = (item >> 6) & 7; I.c = item & 63; I.rowbase = I.b * SEQ + I.c * 64; I.vlo = 0; I.vhi = 64; }
    else { const int j = item - BATCH * NH * 64; I.isctx = true; I.b = j >> 5; I.h = (j >> 2) & 7; I.c = j & 3; I.rowbase = MTOK + I.b * CTX + I.c * 64; I.vlo = -I.c * 64; I.vhi = CTX - I.c * 64; }
    return I;
}
struct GdnPre { u32x4 raw[7]; f32x4 cw; float ga, gb; };
__device__ __forceinline__ void gdn_prefetch(GdnPre& P, const GdnItem& I, int tid, int lane, int wave, const bf16_t* PQKV, const float* PAB, const float* convw) {
#pragma unroll
    for (int e = 0; e < 7; ++e) { const int idx = tid + 512 * e; u32x4 v = {0u, 0u, 0u, 0u};
        if (idx < 3 * 68 * 16) { const int ch = idx & 15, rr = (idx >> 4) % 68, t = (idx >> 4) / 68; const int rel = rr - 2;
            if (rel >= I.vlo && rel < I.vhi) v = *(const GAS u32x4*)(PQKV + (size_t)(I.rowbase + rel) * (3 * GDW) + t * GDW + I.h * HD + ch * 8); }
        P.raw[e] = v; }
    if (tid < 480) { const int t = tid / 160, j = (tid % 160) >> 5, c4 = tid & 31; P.cw = *(const GAS f32x4*)(convw + j * (3 * GDW) + t * GDW + I.h * HD + c4 * 4); }
    if (wave < 2) { const int d = wave; const int i = d ? 63 - lane : lane; const int m = I.rowbase + i; P.ga = PAB[(size_t)m * 32 + d * 8 + I.h]; P.gb = PAB[(size_t)m * 32 + 16 + d * 8 + I.h]; }
}

__device__ __forceinline__ void gdn_chunk_items(LAS unsigned char* L, int first, int stride, const bf16_t* PQKV, const float* PAB, const float* convw, const float* a_log, const float* dt_bias, unsigned char* GREC,
                                                unsigned* cvq, const float* wg, const float* wu, const float* wd, bf16_t* WGU, bf16_t* WDN) {
    const int tid_f_ = threadIdx.x, wave = __builtin_amdgcn_readfirstlane(tid_f_ >> 6);
    constexpr int LD = 136, LDT_ = 72, NITEMS = BATCH * NH * 64 + BATCH * NH * 4;
    LAS bf16_t* QN = (LAS bf16_t*)L; LAS bf16_t* KN = (LAS bf16_t*)(L + 17408); LAS bf16_t* VI = (LAS bf16_t*)(L + 34816);
    LAS bf16_t* RAW = (LAS bf16_t*)(L + 52224);
    LAS bf16_t* TB = (LAS bf16_t*)(L + 52224); LAS bf16_t* TBG = (LAS bf16_t*)(L + 70656);
    LAS float* MPD = (LAS float*)(L + 89088);
    LAS bf16_t* MB = (LAS bf16_t*)(L + 97280);
    LAS bf16_t* TI = (LAS bf16_t*)(L + 52224);
    LAS bf16_t* PI = (LAS bf16_t*)(L + 70656);
    LAS float* GC = (LAS float*)(L + 122880); LAS float* BETA = GC + 128; LAS float* EGC = GC + 256; LAS float* EKD = GC + 384; LAS float* GTOT = (LAS float*)(L + 115712);
    LAS float* CW = (LAS float*)(L + 124928);
    LAS bf16_t* QKB = (LAS bf16_t*)(L + 124928);
    if (first >= NITEMS) return;
    CvtShadow cs; cs.base = -1; cs.left = 0; CvtJob cj; cj.item = -1;
#ifndef CVT_SHADOW
#define CVT_SHADOW 0
#endif
#if CVT_SHADOW
#define CVT_HOOK_ISSUE() cvt_issue(cj, cvt_next(cs, cvq, lane), lane, wg, wu, wd)
#define CVT_HOOK_FINISH() cvt_finish(cj, lane, WGU, WDN)
#else
#define CVT_HOOK_ISSUE() do { } while (0)
#define CVT_HOOK_FINISH() do { } while (0)
#endif
    GdnPre P;
    { int t0_ = tid_f_; asm volatile("" : "+v"(t0_)); const GdnItem I0 = gdn_decode(first); gdn_prefetch(P, I0, t0_, t0_ & 63, wave, PQKV, PAB, convw); }
#pragma unroll 1
    for (int item = first; item < NITEMS; item += stride) {
        int tid_o_ = tid_f_; asm volatile("" : "+v"(tid_o_)); const int tid = tid_o_, lane = tid & 63;
        const GdnItem I = gdn_decode(item);
        const bool isctx = I.isctx; const int b = I.b, h = I.h, c = I.c;
#pragma unroll
        for (int e = 0; e < 7; ++e) { const int idx = tid + 512 * e; if (idx < 3 * 68 * 16) { const int ch = idx & 15, rr = (idx >> 4) % 68, t = (idx >> 4) / 68; *(LAS u32x4*)(RAW + (t * 68 + rr) * LD + ch * 8) = P.raw[e]; } }
        if (tid < 480) { const int t = tid / 160, j = (tid % 160) >> 5, c4 = tid & 31; *(LAS f32x4*)(CW + (t * 5 + j) * 128 + c4 * 4) = P.cw; }
        if (wave < 2) { const int d = wave; const int i = d ? 63 - lane : lane;
            const float g = -__expf(a_log[d * 8 + h]) * softplus_f(P.ga + dt_bias[d * 8 + h]);
            float s = g;
#pragma unroll
            for (int o = 1; o < 64; o <<= 1) { const float t = __shfl_up(s, o); if (lane >= o) s += t; }
            const float gt_ = __shfl(s, 63);
            GC[d * 64 + i] = s; EGC[d * 64 + i] = __expf(s); EKD[d * 64 + i] = __expf(gt_ - s); BETA[d * 64 + i] = __builtin_amdgcn_rcpf(1.f + __expf(-P.gb));
            if (lane == 63) GTOT[d] = s; }
        LBAR();
        { const int nxt = item + stride; if (nxt < NITEMS) { const GdnItem In = gdn_decode(nxt); gdn_prefetch(P, In, tid, lane, wave, PQKV, PAB, convw); } }
#ifndef REPG
#define REPG 0
#endif
#define GS(k) for (int gq_ = 0; gq_ <= ((REPG >> (k)) & 1); ++gq_)
        GS(1) {
        CVT_HOOK_ISSUE();
        { int tt = tid; asm volatile("" : "+v"(tt)); const int cgp = tt & 31, tg = tt >> 5;
#pragma unroll
            for (int t = 0; t < 3; ++t) {
                f32x4 w[5];
#pragma unroll
                for (int j = 0; j < 5; ++j) w[j] = *(const LAS f32x4*)(CW + (t * 5 + j) * 128 + 4 * cgp);
                f32x4 x[8];
#pragma unroll
                for (int rr = 0; rr < 8; ++rr) { const u32x2 q = *(const LAS u32x2*)(RAW + (t * 68 + 4 * tg + rr) * LD + 4 * cgp); x[rr] = (f32x4){bf2f(q.x & 0xffffu), bf2f(q.x >> 16), bf2f(q.y & 0xffffu), bf2f(q.y >> 16)}; }
                f32x4 y[4]; float ss[4];
#pragma unroll
                for (int k = 0; k < 4; ++k) { f32x4 acc = w[0] * x[k];
#pragma unroll
                    for (int j = 1; j < 5; ++j) acc += w[j] * x[k + j];
                    acc.x = silu_f(acc.x); acc.y = silu_f(acc.y); acc.z = silu_f(acc.z); acc.w = silu_f(acc.w);
                    y[k] = acc; ss[k] = (acc.x * acc.x + acc.y * acc.y) + (acc.z * acc.z + acc.w * acc.w); }
                if (t < 2) {
#pragma unroll
                    for (int k = 0; k < 4; ++k) { float v = ss[k]; v += dpp_xor1(v); v += dpp_xor2(v); v += __shfl_xor(v, 4); v += __shfl_xor(v, 8); v += __shfl_xor(v, 16);
                        float sc = __builtin_amdgcn_rsqf(v + EPS); if (t == 0) sc *= 0.08838834764831845f; y[k] = y[k] * sc; } }
                LAS bf16_t* dst = (t == 0 ? QN : (t == 1 ? KN : VI)) + (4 * tg) * LD + 4 * cgp;
#pragma unroll
                for (int k = 0; k < 4; ++k) { u32x2 o; o.x = pk2(y[k].x, y[k].y); o.y = pk2(y[k].z, y[k].w); *(LAS u32x2*)(dst + k * LD) = o; }
            }
        }
        CVT_HOOK_FINISH();
        LBAR();
        }
        GS(2) {
        { const int which = wave >> 2, ti = (wave >> 1) & 1, tj = wave & 1; f32x16 acc = Z16;
            { bf16x8 fa[8], fb[8];
#pragma unroll
                for (int ks = 0; ks < 8; ++ks) { fa[ks] = frag_row(which ? QN : KN, LD, 32 * ti, 16 * ks, lane); fb[ks] = frag_row(KN, LD, 32 * tj, 16 * ks, lane); }
                __builtin_amdgcn_sched_barrier(0);
#pragma unroll
                for (int ks = 0; ks < 8; ++ks) acc = MFMA32(fa[ks], fb[ks], acc); }
            const int j = 32 * tj + (lane & 31); const float g0j = GC[j], g1j = GC[64 + j];
#pragma unroll
            for (int g4 = 0; g4 < 4; ++g4) { const int i0 = 32 * ti + 8 * g4 + 4 * (lane >> 5);
                const f32x4 g0i = *(const LAS f32x4*)(GC + i0), g1i = *(const LAS f32x4*)(GC + 64 + i0), b0i = *(const LAS f32x4*)(BETA + i0), b1i = *(const LAS f32x4*)(BETA + 64 + i0);
#pragma unroll
                for (int e = 0; e < 4; ++e) { const int i = i0 + e; const float a_ = acc[4 * g4 + e];
                    const bool lo = j < i, hi = j > i;
                    const float ex = __expf(lo ? (g0i[e] - g0j) : (hi ? (g1i[e] - g1j) : 0.f));
                    if (which == 0) { const float v = a_ * ex * (lo ? b0i[e] : b1i[e]); const float v0 = lo ? v : 0.f, v1 = hi ? v : 0.f; const int il = 63 - i, jl = 63 - j;
                        MB[(0 * 64 + i) * LDT_ + j] = (bf16_t)f2bf(v0); MB[(1 * 64 + il) * LDT_ + jl] = (bf16_t)f2bf(v1);
                        if ((i >> 4) == (j >> 4)) { MPD[((0 * 4 + (i >> 4)) * 16 + (i & 15)) * 16 + (j & 3) * 4 + ((j & 15) >> 2)] = v0; MPD[((1 * 4 + (il >> 4)) * 16 + (il & 15)) * 16 + (jl & 3) * 4 + ((jl & 15) >> 2)] = v1; } }
                    else { const float v = a_ * ex; QKB[(0 * 64 + i) * LDT_ + j] = (bf16_t)f2bf(hi ? 0.f : v); QKB[(1 * 64 + i) * LDT_ + j] = (bf16_t)f2bf(lo ? 0.f : v); } } }
        }
        LBAR();
        }
        GS(3) {
        CVT_HOOK_ISSUE();
        { const int d = wave >> 2, a_ = wave & 3; const int c = lane >> 2, r = lane & 3; float T[4] = {0.f, 0.f, 0.f, 0.f};
            LAS bf16_t* TId = TI + d * 64 * LDT_;
            { LAS unsigned* z = (LAS unsigned*)(TId + 16 * a_ * LDT_);
#pragma unroll
                for (int e = 0; e < 9; ++e) z[lane + 64 * e] = 0u; }
            const LAS float* mp = MPD + ((d * 4 + a_) * 16) * 16 + r * 4;
            f32x4 md[16];
#pragma unroll
            for (int rr = 0; rr < 16; ++rr) md[rr] = *(const LAS f32x4*)(mp + rr * 16);
#pragma unroll
            for (int rr = 0; rr < 16; ++rr) { float acc = (md[rr].x * T[0] + md[rr].y * T[1]) + (md[rr].z * T[2] + md[rr].w * T[3]);
                acc += dpp_xor1(acc); acc += dpp_xor2(acc);
                const float t = (rr == c ? 1.f : 0.f) - acc;
                if (r == (rr & 3)) T[rr >> 2] = t; }
            LDS_WAIT();
#pragma unroll
            for (int q = 0; q < 4; ++q) TId[(16 * a_ + 4 * q + r) * LDT_ + 16 * a_ + c] = (bf16_t)f2bf(T[q]);
        }
        LBAR();
        { const int d = wave >> 2, hsel = wave & 3; LAS bf16_t* TId = TI + d * 64 * LDT_; LAS bf16_t* PId = PI + d * 64 * LDT_; const LAS bf16_t* MBd = MB + d * 64 * LDT_;
            if (hsel < 2) { const int o = 32 * hsel;
                f32x16 p = Z16;
#pragma unroll
                for (int ks = 0; ks < 2; ++ks) p = MFMA32(frag_row(MBd, LDT_, o, o + 16 * ks, lane), frag_tr(TId, LDT_, o, o + 16 * ks, lane), p);
#pragma unroll
                for (int rg = 0; rg < 16; ++rg) PId[(o + crow(rg, lane)) * LDT_ + o + (lane & 31)] = (bf16_t)f2bf(p[rg]);
                LDS_WAIT();
                f32x16 q = Z16;
#pragma unroll
                for (int ks = 0; ks < 2; ++ks) q = MFMA32(frag_row(TId, LDT_, o, o + 16 * ks, lane), frag_tr(PId, LDT_, o, o + 16 * ks, lane), q);
                if ((lane & 31) < 16) {
#pragma unroll
                    for (int rg = 8; rg < 16; ++rg) TId[(o + crow(rg, lane)) * LDT_ + o + (lane & 31)] = (bf16_t)f2bf(-q[rg]); } }
        }
        LBAR();
        { const int d = wave >> 2, hsel = wave & 3; LAS bf16_t* TId = TI + d * 64 * LDT_; LAS bf16_t* PId = PI + d * 64 * LDT_; const LAS bf16_t* MBd = MB + d * 64 * LDT_;
            if (hsel == 0) {
                f32x16 p = Z16;
#pragma unroll
                for (int ks = 0; ks < 2; ++ks) p = MFMA32(frag_row(MBd, LDT_, 32, 16 * ks, lane), frag_tr(TId, LDT_, 0, 16 * ks, lane), p);
#pragma unroll
                for (int rg = 0; rg < 16; ++rg) PId[(32 + crow(rg, lane)) * LDT_ + (lane & 31)] = (bf16_t)f2bf(p[rg]);
                LDS_WAIT();
                f32x16 q = Z16;
#pragma unroll
                for (int ks = 0; ks < 2; ++ks) q = MFMA32(frag_row(TId, LDT_, 32, 32 + 16 * ks, lane), frag_tr(PId, LDT_, 0, 32 + 16 * ks, lane), q);
#pragma unroll
                for (int rg = 0; rg < 16; ++rg) TId[(32 + crow(rg, lane)) * LDT_ + (lane & 31)] = (bf16_t)f2bf(-q[rg]); }
        }
        LBAR();
        { int tt = tid; asm volatile("" : "+v"(tt)); const int d = tt >> 8, t2 = tt & 255;
            if (d == 0) {
#pragma unroll
                for (int e = 0; e < 16; ++e) { const int idx = t2 + 256 * e, i = idx >> 6, j = idx & 63; const float t = bf2f(TI[i * LDT_ + j]); const float bj = BETA[j];
                    TB[i * LDT_ + j] = (bf16_t)f2bf(t * bj); TBG[i * LDT_ + j] = (bf16_t)f2bf(t * bj * EGC[j]); } }
            else {
#pragma unroll
                for (int e = 0; e < 8; ++e) { const int idx = t2 + 256 * e, p = idx >> 6, q = idx & 63, p2 = 63 - p, q2 = 63 - q;
                    const float ta = bf2f(TI[(64 + p) * LDT_ + q]), tb = bf2f(TI[(64 + p2) * LDT_ + q2]); const float b1 = BETA[64 + q], b2 = BETA[64 + q2];
                    TB[(64 + p) * LDT_ + q] = (bf16_t)f2bf(tb * b1); TB[(64 + p2) * LDT_ + q2] = (bf16_t)f2bf(ta * b2);
                    TBG[(64 + p) * LDT_ + q] = (bf16_t)f2bf(tb * b1 * EGC[64 + q]); TBG[(64 + p2) * LDT_ + q2] = (bf16_t)f2bf(ta * b2 * EGC[64 + q2]); } }
        }
        CVT_HOOK_FINISH();
        LBAR();
        }
        GS(4) {
        CVT_HOOK_ISSUE();
        { const int d = wave >> 2, wq = wave & 3; unsigned char* rec = GREC + rec_index(isctx, b, h, d, c) * REC_BYTES;
            bf16_t* uT = (bf16_t*)(rec + REC_UT); bf16_t* wout = (bf16_t*)(rec + REC_W);
#pragma unroll
            for (int it = 0; it < 2; ++it) { f32x16 au = Z16, aw = Z16;
                { bf16x8 f1[4], f2[4], f3[4], f4[4];
#pragma unroll
                    for (int ks = 0; ks < 4; ++ks) { f1[ks] = frag_row(TB + d * 64 * LDT_, LDT_, 32 * it, 16 * ks, lane); f2[ks] = frag_tr(VI, LD, 32 * wq, 16 * ks, lane);
                        f3[ks] = frag_tr(KN, LD, 32 * wq, 16 * ks, lane); f4[ks] = frag_row(TBG + d * 64 * LDT_, LDT_, 32 * it, 16 * ks, lane); }
                    __builtin_amdgcn_sched_barrier(0);
#pragma unroll
                    for (int ks = 0; ks < 4; ++ks) { au = MFMA32(f1[ks], f2[ks], au); aw = MFMA32(f3[ks], f4[ks], aw); } }
#pragma unroll
                for (int g4 = 0; g4 < 4; ++g4) { u32x2 pu, pw; pu.x = pk2(au[4 * g4], au[4 * g4 + 1]); pu.y = pk2(au[4 * g4 + 2], au[4 * g4 + 3]); pw.x = pk2(aw[4 * g4], aw[4 * g4 + 1]); pw.y = pk2(aw[4 * g4 + 2], aw[4 * g4 + 3]);
                    *(GAS u32x2*)(uT + (32 * wq + (lane & 31)) * 64 + 32 * it + 8 * g4 + 4 * (lane >> 5)) = pu;
                    *(GAS u32x2*)(wout + (32 * it + (lane & 31)) * 128 + 32 * wq + 8 * g4 + 4 * (lane >> 5)) = pw; } }
        }
        { int tt = tid; asm volatile("" : "+v"(tt)); const int d = tt >> 8, t2 = tt & 255; unsigned char* rec = GREC + rec_index(isctx, b, h, d, c) * REC_BYTES; const float gtot = GTOT[d];
#pragma unroll
            for (int e = 0; e < 4; ++e) { const int idx = t2 + 256 * e, i = idx >> 4, ch = idx & 15; const float sc = EGC[d * 64 + i];
                const u32x4 v = *(const LAS u32x4*)(QN + i * LD + ch * 8); const unsigned rw[4] = {v.x, v.y, v.z, v.w}; u32x4 o; unsigned ow[4];
#pragma unroll
                for (int q = 0; q < 4; ++q) ow[q] = pk2(bf2f(rw[q] & 0xffffu) * sc, bf2f(rw[q] >> 16) * sc);
                o.x = ow[0]; o.y = ow[1]; o.z = ow[2]; o.w = ow[3];
                *(GAS u32x4*)(rec + REC_QD + (i * 128 + ch * 8) * 2) = o; }
#pragma unroll
            for (int e = 0; e < 4; ++e) { const int idx = t2 + 256 * e, k = idx >> 3, ci = idx & 7; float o[8];
#pragma unroll
                for (int q = 0; q < 8; ++q) { const int i = 8 * ci + q; o[q] = bf2f(KN[i * LD + k]) * EKD[d * 64 + i]; }
                u32x4 w; w.x = pk2(o[0], o[1]); w.y = pk2(o[2], o[3]); w.z = pk2(o[4], o[5]); w.w = pk2(o[6], o[7]);
                *(GAS u32x4*)(rec + REC_KDT + (k * 64 + 8 * ci) * 2) = w; }
#pragma unroll
            for (int e = 0; e < 2; ++e) { const int idx = t2 + 256 * e, i = idx >> 3, cj = idx & 7;
                *(GAS u32x4*)(rec + REC_QK + (i * 64 + 8 * cj) * 2) = *(const LAS u32x4*)(QKB + (d * 64 + i) * LDT_ + 8 * cj); }
            if (t2 == 0) *(float*)(rec + REC_GT) = __expf(gtot);
        }
        CVT_HOOK_FINISH();
        LBAR();
        }
    }
    while (cs.left > 0) { cvt_issue(cj, cvt_next(cs, cvq, tid_f_ & 63), tid_f_ & 63, wg, wu, wd); cvt_finish(cj, tid_f_ & 63, WGU, WDN); }
#undef CVT_HOOK_ISSUE
#undef CVT_HOOK_FINISH
}

__device__ __forceinline__ void gdn_scan_unit(LAS unsigned char* L, int unit, const unsigned char* GREC, bf16_t* OF, bf16_t* OB) {
    int tid_o_ = threadIdx.x; asm volatile("" : "+v"(tid_o_)); const int tid = tid_o_, lane = tid & 63, wave = __builtin_amdgcn_readfirstlane(tid >> 6);
    constexpr int LD = 136, LDS_ = 72;
    LAS bf16_t* ST = (LAS bf16_t*)L;
    LAS bf16_t* Wl = (LAS bf16_t*)(L + 34816);
    LAS bf16_t* QDl = (LAS bf16_t*)(L + 52224);
    LAS bf16_t* KDTl = (LAS bf16_t*)(L + 69632);
    LAS bf16_t* QKl = (LAS bf16_t*)(L + 88064);
    LAS bf16_t* VNT = (LAS bf16_t*)(L + 97280);
    const int b = unit >> 4, h = (unit >> 1) & 7, d = unit & 1;
    bf16_t* O = d ? OB : OF;
    for (int i = tid; i < 128 * LD / 8; i += NTHREADS) *(LAS u32x4*)(ST + i * 8) = (u32x4){0u, 0u, 0u, 0u};
    f32x16 S0 = Z16, S1 = Z16;
    const int kt = wave >> 1, vt0 = 2 * (wave & 1);
    struct ScanOps { u32x4 rg[7]; u32x2 u[4]; float gt; };
    auto rec_of = [&](int s) -> const unsigned char* { const bool isctx = s < 4; const int cs = isctx ? s : s - 4; const int c = isctx ? (d ? 3 - cs : cs) : (d ? 63 - cs : cs);
        return GREC + rec_index(isctx, b, h, d, c) * REC_BYTES; };
    auto load_ops = [&](ScanOps& o, int s) { const unsigned char* rec = rec_of(s); const bool withq = s >= 4;
#pragma unroll
        for (int e = 0; e < 2; ++e) { const int idx = tid + 512 * e; o.rg[e] = __builtin_nontemporal_load((const GAS u32x4*)(rec + REC_W + idx * 16)); o.rg[4 + e] = __builtin_nontemporal_load((const GAS u32x4*)(rec + REC_KDT + idx * 16)); }
        if (withq) {
#pragma unroll
            for (int e = 0; e < 2; ++e) { const int idx = tid + 512 * e; o.rg[2 + e] = __builtin_nontemporal_load((const GAS u32x4*)(rec + REC_QD + idx * 16)); }
            o.rg[6] = __builtin_nontemporal_load((const GAS u32x4*)(rec + REC_QK + tid * 16)); }
        { const int it = wave >> 2, vt = wave & 3; const bf16_t* uT = (const bf16_t*)(rec + REC_UT) + (32 * vt + (lane & 31)) * 64 + 32 * it + 4 * (lane >> 5);
#pragma unroll
            for (int g4 = 0; g4 < 4; ++g4) o.u[g4] = *(const GAS u32x2*)(uT + 8 * g4); }
        o.gt = *(const float*)(rec + REC_GT);
    };
    auto step = [&](ScanOps& o, int s) {
        const bool isctx = s < 4;
#pragma unroll
        for (int e = 0; e < 2; ++e) { const int idx = tid + 512 * e; *(LAS u32x4*)(Wl + (idx >> 4) * LD + (idx & 15) * 8) = o.rg[e]; *(LAS u32x4*)(KDTl + (idx >> 3) * LDS_ + (idx & 7) * 8) = o.rg[4 + e]; }
        if (!isctx) {
#pragma unroll
            for (int e = 0; e < 2; ++e) { const int idx = tid + 512 * e; *(LAS u32x4*)(QDl + (idx >> 4) * LD + (idx & 15) * 8) = o.rg[2 + e]; }
            *(LAS u32x4*)(QKl + (tid >> 3) * LDS_ + (tid & 7) * 8) = o.rg[6]; }
        const float gt = o.gt; u32x2 uc[4];
#pragma unroll
        for (int g4 = 0; g4 < 4; ++g4) uc[g4] = o.u[g4];
        LBAR();
        if (s + 2 < 68) load_ops(o, s + 2);
        const int it = wave >> 2, vt = wave & 3;
        { bf16x8 fw[8], fs[8];
#pragma unroll
            for (int ks = 0; ks < 8; ++ks) { fw[ks] = frag_row(Wl, LD, 32 * it, 16 * ks, lane); fs[ks] = frag_row(ST, LD, 32 * vt, 16 * ks, lane); }
            __builtin_amdgcn_sched_barrier(0);
            f32x16 acc = Z16;
#pragma unroll
            for (int ks = 0; ks < 8; ++ks) acc = MFMA32(fw[ks], fs[ks], acc);
#pragma unroll
            for (int g4 = 0; g4 < 4; ++g4) { const u32x2 uu = uc[g4];
                const float v0 = bf2f(uu.x & 0xffffu) - acc[4 * g4], v1 = bf2f(uu.x >> 16) - acc[4 * g4 + 1], v2 = bf2f(uu.y & 0xffffu) - acc[4 * g4 + 2], v3 = bf2f(uu.y >> 16) - acc[4 * g4 + 3];
                u32x2 p; p.x = pk2(v0, v1); p.y = pk2(v2, v3);
                *(LAS u32x2*)(VNT + (32 * vt + (lane & 31)) * LDS_ + 32 * it + 8 * g4 + 4 * (lane >> 5)) = p; } }
        LBAR();
        bf16x8 fk[4], fv0[4], fv1[4];
#pragma unroll
        for (int ks = 0; ks < 4; ++ks) { fk[ks] = frag_row(KDTl, LDS_, 32 * kt, 16 * ks, lane); fv0[ks] = frag_row(VNT, LDS_, 32 * vt0, 16 * ks, lane); fv1[ks] = frag_row(VNT, LDS_, 32 * (vt0 + 1), 16 * ks, lane); }
        __builtin_amdgcn_sched_barrier(0);
        { S0 = S0 * gt; S1 = S1 * gt;
#pragma unroll
            for (int ks = 0; ks < 4; ++ks) { S0 = MFMA32(fk[ks], fv0[ks], S0); S1 = MFMA32(fk[ks], fv1[ks], S1); } }
        if (!isctx) { f32x16 acc = Z16;
            { bf16x8 fq[8], fs[8];
#pragma unroll
                for (int ks = 0; ks < 8; ++ks) { fs[ks] = frag_row(ST, LD, 32 * vt, 16 * ks, lane); fq[ks] = frag_row(QDl, LD, 32 * it, 16 * ks, lane); }
                __builtin_amdgcn_sched_barrier(0);
#pragma unroll
                for (int ks = 0; ks < 8; ++ks) acc = MFMA32(fs[ks], fq[ks], acc); }
            { bf16x8 fvn[4], fqk[4];
#pragma unroll
                for (int ks = 0; ks < 4; ++ks) { fvn[ks] = frag_row(VNT, LDS_, 32 * vt, 16 * ks, lane); fqk[ks] = frag_row(QKl, LDS_, 32 * it, 16 * ks, lane); }
                __builtin_amdgcn_sched_barrier(0);
#pragma unroll
                for (int ks = 0; ks < 4; ++ks) acc = MFMA32(fvn[ks], fqk[ks], acc); }
            const int cs = s - 4, c = d ? 63 - cs : cs;
            bf16_t* op = O + (size_t)(b * SEQ + c * 64 + 32 * it + (lane & 31)) * GDW + h * HD + 32 * vt + 4 * (lane >> 5);
#pragma unroll
            for (int g4 = 0; g4 < 4; ++g4) { u32x2 p; p.x = pk2(acc[4 * g4], acc[4 * g4 + 1]); p.y = pk2(acc[4 * g4 + 2], acc[4 * g4 + 3]); *(GAS u32x2*)(op + 8 * g4) = p; } }
        LBAR();
#pragma unroll
        for (int g4 = 0; g4 < 4; ++g4) { u32x2 p0, p1; p0.x = pk2(S0[4 * g4], S0[4 * g4 + 1]); p0.y = pk2(S0[4 * g4 + 2], S0[4 * g4 + 3]); p1.x = pk2(S1[4 * g4], S1[4 * g4 + 1]); p1.y = pk2(S1[4 * g4 + 2], S1[4 * g4 + 3]);
            *(LAS u32x2*)(ST + (32 * vt0 + (lane & 31)) * LD + 32 * kt + 8 * g4 + 4 * (lane >> 5)) = p0;
            *(LAS u32x2*)(ST + (32 * (vt0 + 1) + (lane & 31)) * LD + 32 * kt + 8 * g4 + 4 * (lane >> 5)) = p1; }
    };
    ScanOps A, B;
    load_ops(A, 0); load_ops(B, 1);
#pragma unroll 1
    for (int s = 0; s < 68; s += 2) { step(A, s); step(B, s + 1); }
    LBAR();
}

struct Args { const float* in[19]; float* out; unsigned char* ws; int ph_lo, ph_hi; };
enum { I_X = 0, I_C, I_CTX, I_CCTX, I_WMOD, I_BMOD, I_N1G, I_N2G, I_WIN, I_CONVW, I_ALOG, I_DTB, I_GNW, I_WOUT, I_WROUTER, I_WGATE, I_WUP, I_WDOWN, I_NORMF };

struct XposeItem { const float* src; int ldn, ncols, k0, n0; bf16_t* dst; int dstK; int mode; };
__device__ __forceinline__ int xpose_row(const XposeItem& it, int n) { return it.mode == 0 ? n : (256 * (n >> 7) + 128 * (it.mode - 1) + (n & 127)); }
__device__ __forceinline__ void xpose_load(const XposeItem& it, f32x4 (&r)[8], int tid) {
    const int n = it.n0 + 4 * (tid & 63);
#pragma unroll
    for (int j = 0; j < 8; ++j) { const int k = it.k0 + (tid >> 6) + 8 * j;
        if (n + 3 < it.ncols) r[j] = __builtin_nontemporal_load((const GAS f32x4*)(it.src + (size_t)k * it.ldn + n));
        else { f32x4 v = {0.f, 0.f, 0.f, 0.f}; const float* p = it.src + (size_t)k * it.ldn; if (n < it.ncols) v.x = p[n]; if (n + 1 < it.ncols) v.y = p[n + 1]; if (n + 2 < it.ncols) v.z = p[n + 2]; r[j] = v; } }
}
__device__ __forceinline__ void xpose_store_lds(LAS float* T, const f32x4 (&r)[8], int tid) {
#pragma unroll
    for (int j = 0; j < 8; ++j) { const int kr = (tid >> 6) + 8 * j; *(LAS f32x4*)(T + kr * 260 + ((4 * (tid & 63)) ^ (4 * ((kr >> 3) & 7)))) = r[j]; }
}
__device__ __forceinline__ void xpose_emit(const XposeItem& it, const LAS float* T, int tid) {
    const int kc = tid & 7;
#pragma unroll
    for (int j = 0; j < 4; ++j) { const int nl = (tid >> 3) + 64 * j, n = it.n0 + nl;
        const LAS float* s = T + (8 * kc) * 260 + (nl ^ (4 * kc));
        u32x4 o; o.x = pk2(s[0], s[260]); o.y = pk2(s[2 * 260], s[3 * 260]); o.z = pk2(s[4 * 260], s[5 * 260]); o.w = pk2(s[6 * 260], s[7 * 260]);
        if (n < it.ncols) __builtin_nontemporal_store(o, (GAS u32x4*)(it.dst + (size_t)xpose_row(it, n) * it.dstK + it.k0 + 8 * kc)); }
}


__device__ __forceinline__ void moe_convert(LAS unsigned char* L, volatile LAS unsigned* MISC, unsigned* q, const float* wg, const float* wu, const float* wd, bf16_t* WGU, bf16_t* WDN, int maxpulls) {
    int tid_o_ = threadIdx.x; asm volatile("" : "+v"(tid_o_)); const int tid = tid_o_;
    __syncthreads();
    LAS float* T = (LAS float*)L;
    constexpr int NIT = 3 * 3072;
    auto mk = [&](int it) { XposeItem x; if (it < 6144) { const int up = it >= 3072, r0 = it - up * 3072, e = r0 / 192, r = r0 % 192; x.src = (up ? wu : wg) + (size_t)e * D_MODEL * FF; x.ldn = FF; x.ncols = FF; x.k0 = 64 * (r / 6); x.n0 = 256 * (r % 6);
            x.dst = WGU + (size_t)e * 2 * FF * D_MODEL; x.dstK = D_MODEL; x.mode = 1 + up; }
        else { const int r0 = it - 6144, e = r0 / 192, r = r0 % 192; x.src = wd + (size_t)e * FF * D_MODEL; x.ldn = D_MODEL; x.ncols = D_MODEL; x.k0 = 64 * (r / 8); x.n0 = 256 * (r % 8);
            x.dst = WDN + (size_t)e * D_MODEL * FF; x.dstK = FF; x.mode = 0; } return x; };
    f32x4 r[8];
    int pulls = 0;
    if (tid == 0) MISC[18] = maxpulls > 0 ? atomicAdd(q, 1u) : (unsigned)NIT;
    ++pulls;
    __syncthreads();
    int it = (int)MISC[18];
    if (it < NIT) { XposeItem x = mk(it); xpose_load(x, r, tid); }
    for (int qn = 0; it < NIT; ++qn) {
        XposeItem x = mk(it);
        xpose_store_lds(T, r, tid);
        if (tid == 0) MISC[19 + (qn & 1)] = pulls < maxpulls ? atomicAdd(q, 1u) : (unsigned)NIT;
        ++pulls;
        __syncthreads();
        const int nx = (int)MISC[19 + (qn & 1)];
        if (nx < NIT) { XposeItem y = mk(nx); xpose_load(y, r, tid); }
        xpose_emit(x, T, tid);
        __syncthreads();
        it = nx;
    }
}
struct SchedIn {
    const char* A; const char* Actx; const char* B; int G, c;
    __device__ __forceinline__ bool next(int i, pg8::Unit& u) const {
        const int L = i * G + c; constexpr int NX = 64 * 21, NC = 4 * 13;
        if (L >= NX + NC) return false;
        int pm, pn;
        if (L < NX) { int wgid = L; { const int q = NX / 8, xcd = wgid % 8, off = wgid / 8; wgid = xcd * q + off; }
            const int nig = 8 * 21, gid = wgid / nig, fm = gid * 8; pm = fm + ((wgid % nig) % 8); pn = (wgid % nig) / 8; }
        else { const int r = L - NX; pm = 64 + r / 13; const int j = r % 13; pn = j < 12 ? 4 + j : 20; }
        u.pm = pm; u.pn = pn; u.aux = 0; u.gidx = nullptr;
        u.a = pm < 64 ? A + (size_t)pm * 256 * D_MODEL * 2 : Actx + (size_t)(pm - 64) * 256 * D_MODEL * 2; u.b = B + (size_t)pn * 256 * D_MODEL * 2; return true;
    }
};

struct EpiIn {
    static constexpr bool PERM = true;
    bf16_t* pf; bf16_t* pqkv; bf16_t* pz; float* pab;
    __device__ __forceinline__ void operator()(const f32x4 (&acc)[2][2][4][2], const pg8::Unit& u, int wr, int wc, int fr, int fq) const {
        const int row0 = u.pm * 256 + wr * 64 + fr; const int pn = u.pn;
        if (pn == 20) {
            if (wc == 0) {
#pragma unroll
                for (int ai = 0; ai < 2; ++ai)
#pragma unroll
                    for (int m = 0; m < 4; ++m) { float* rp = pab + (size_t)(row0 + ai * 128 + m * 16) * 32 + 8 * fq;
                        *(GAS f32x4*)rp = acc[ai][0][m][0]; *(GAS f32x4*)(rp + 4) = acc[ai][0][m][1]; }
            }
            return;
        }
        bf16_t* base; int ld, c0;
        if (pn < 4) { base = pf; ld = FW; c0 = pn * 256; } else if (pn < 16) { base = pqkv; ld = 3 * GDW; c0 = (pn - 4) * 256; } else { base = pz; ld = GDW; c0 = (pn - 16) * 256; }
        const int col0 = c0 + wc * 32 + 8 * fq;
#pragma unroll
        for (int ai = 0; ai < 2; ++ai)
#pragma unroll
            for (int m = 0; m < 4; ++m) { bf16_t* rowp = base + (size_t)(row0 + ai * 128 + m * 16) * ld + col0;
#pragma unroll
                for (int bj = 0; bj < 2; ++bj) { const f32x4 v0 = acc[ai][bj][m][0], v1 = acc[ai][bj][m][1];
                    u32x4 w; w.x = pk2(v0[0], v0[1]); w.y = pk2(v0[2], v0[3]); w.z = pk2(v1[0], v1[1]); w.w = pk2(v1[2], v1[3]);
                    *(GAS u32x4*)(rowp + bj * 128) = w; } }
    }
};

struct SchedOut {
    const char* A; const char* B; int G, c;
    __device__ __forceinline__ bool next(int i, pg8::Unit& u) const {
        const int Lq = i * G + c; constexpr int NU = 64 * 8;
        if (Lq >= NU) return false;
        int wgid = Lq; { const int q = NU / 8, xcd = wgid % 8, off = wgid / 8; wgid = xcd * q + off; }
        const int nig = 8 * 8, gid = wgid / nig, fm = gid * 8; const int pm = fm + ((wgid % nig) % 8), pn = (wgid % nig) / 8;
        u.pm = pm; u.pn = pn; u.aux = 0; u.gidx = nullptr;
        u.a = A + (size_t)pm * 256 * D_MODEL * 2; u.b = B + (size_t)pn * 256 * D_MODEL * 2; return true;
    }
};

struct EpiOut {
    static constexpr bool PERM = true;
    const bf16_t* x; const float* mod; bf16_t* x2;
    __device__ __forceinline__ void operator()(const f32x4 (&acc)[2][2][4][2], const pg8::Unit& u, int wr, int wc, int fr, int fq) const {
        const int row0 = u.pm * 256 + wr * 64 + fr, col0 = u.pn * 256 + wc * 32 + 8 * fq;
        const float* gt = mod + (u.pm >> 4) * 12288 + 2 * 2048;
        f32x4 gv[2][2];
#pragma unroll
        for (int bj = 0; bj < 2; ++bj)
#pragma unroll
            for (int n = 0; n < 2; ++n) gv[bj][n] = *(const GAS f32x4*)(gt + col0 + bj * 128 + n * 4);
#pragma unroll
        for (int ai = 0; ai < 2; ++ai)
#pragma unroll
            for (int m = 0; m < 4; ++m) { const size_t off = (size_t)(row0 + ai * 128 + m * 16) * D_MODEL + col0;
#pragma unroll
                for (int bj = 0; bj < 2; ++bj) { const u32x4 xq = *(const GAS u32x4*)(x + off + bj * 128);
                    const f32x4 x0 = {bf2f(xq.x & 0xffffu), bf2f(xq.x >> 16), bf2f(xq.y & 0xffffu), bf2f(xq.y >> 16)}, x1 = {bf2f(xq.z & 0xffffu), bf2f(xq.z >> 16), bf2f(xq.w & 0xffffu), bf2f(xq.w >> 16)};
                    const f32x4 y0 = x0 + gv[bj][0] * acc[ai][bj][m][0], y1 = x1 + gv[bj][1] * acc[ai][bj][m][1];
                    u32x4 w; w.x = pk2(y0[0], y0[1]); w.y = pk2(y0[2], y0[3]); w.z = pk2(y1[0], y1[1]); w.w = pk2(y1[2], y1[3]);
                    *(GAS u32x4*)(x2 + off + bj * 128) = w; } }
    }
};


struct SchedGU {
    const char* HX2; const char* W; const int* IDX; int G, c;
    __device__ __forceinline__ bool next(int i, pg8::Unit& u) const {
        const int L = i * G + c; if (L >= 1536) return false;
        int wt, rt;
        if (G == 256) { const int xcd = c & 7, j = c >> 3; wt = (i * 8 + xcd) * 4 + (j >> 3); rt = j & 7; } else { wt = L >> 3; rt = L & 7; }
        const int e = wt / 12, pn = wt % 12, b = rt >> 1, mt = rt & 1;
        u.pm = (b * NE + e) * 2 + mt; u.pn = pn; u.aux = 0;
        u.a = HX2 + (size_t)b * SEQ * D_MODEL * 2; u.gidx = IDX + (b * NE + e) * CAP + mt * 256;
        u.b = W + ((size_t)e * 2 * FF + (size_t)pn * 256) * D_MODEL * 2; return true;
    }
};
struct EpiGU {
    static constexpr bool PERM = true;
    bf16_t* hid;
    __device__ __forceinline__ void operator()(const f32x4 (&acc)[2][2][4][2], const pg8::Unit& u, int wr, int wc, int fr, int fq) const {
        const int row0 = u.pm * 256 + wr * 64 + fr, col0 = u.pn * 128 + wc * 32 + 8 * fq;
#pragma unroll
        for (int ai = 0; ai < 2; ++ai)
#pragma unroll
            for (int m = 0; m < 4; ++m) { const f32x4 g0 = acc[ai][0][m][0], g1 = acc[ai][0][m][1], u0 = acc[ai][1][m][0], u1 = acc[ai][1][m][1];
                u32x4 w; w.x = pk2(silu_f(g0[0]) * u0[0], silu_f(g0[1]) * u0[1]); w.y = pk2(silu_f(g0[2]) * u0[2], silu_f(g0[3]) * u0[3]);
                w.z = pk2(silu_f(g1[0]) * u1[0], silu_f(g1[1]) * u1[1]); w.w = pk2(silu_f(g1[2]) * u1[2], silu_f(g1[3]) * u1[3]);
                *(GAS u32x4*)(hid + (size_t)(row0 + ai * 128 + m * 16) * FF + col0) = w; }
    }
};
struct SchedDN {
    const char* HID; const char* W; int G, c;
    __device__ __forceinline__ bool next(int i, pg8::Unit& u) const {
        const int L = i * G + c; if (L >= 1024) return false;
        int wt, rt;
        if (G == 256) { const int xcd = c & 7, j = c >> 3; wt = (i * 8 + xcd) * 4 + (j >> 3); rt = j & 7; } else { wt = L >> 3; rt = L & 7; }
        const int e = wt >> 3, pn = wt & 7, b = rt >> 1, mt = rt & 1;
        u.pm = (b * NE + e) * 2 + mt; u.pn = pn; u.aux = 0; u.gidx = nullptr;
        u.a = HID + (size_t)u.pm * 256 * FF * 2; u.b = W + ((size_t)e * D_MODEL + (size_t)pn * 256) * FF * 2; return true;
    }
};
struct EpiDN {
    static constexpr bool PERM = true;
    bf16_t* yb; const float* val;
    __device__ __forceinline__ void operator()(const f32x4 (&acc)[2][2][4][2], const pg8::Unit& u, int wr, int wc, int fr, int fq) const {
        const int row0 = u.pm * 256 + wr * 64 + fr, col0 = u.pn * 256 + wc * 32 + 8 * fq;
#pragma unroll
        for (int ai = 0; ai < 2; ++ai)
#pragma unroll
            for (int m = 0; m < 4; ++m) { const int row = row0 + ai * 128 + m * 16; const float vv = val[row]; bf16_t* rowp = yb + (size_t)row * D_MODEL + col0;
#pragma unroll
                for (int bj = 0; bj < 2; ++bj) { const f32x4 v0 = acc[ai][bj][m][0] * vv, v1 = acc[ai][bj][m][1] * vv;
                    u32x4 w; w.x = pk2(v0[0], v0[1]); w.y = pk2(v0[2], v0[3]); w.z = pk2(v1[0], v1[1]); w.w = pk2(v1[2], v1[3]);
                    *(GAS u32x4*)(rowp + bj * 128) = w; } }
    }
};

__device__ __forceinline__ unsigned block_excl_scan(unsigned v, LAS unsigned* scr, int tid, int lane, int wave, unsigned& total) {
    unsigned s = v;
#pragma unroll
    for (int o = 1; o < 64; o <<= 1) { const unsigned t = __shfl_up(s, o); if (lane >= o) s += t; }
    if (lane == 63) scr[wave] = s;
    __syncthreads();
    unsigned base = 0, tot = 0;
#pragma unroll
    for (int w = 0; w < NWAVES; ++w) { const unsigned x = scr[w]; if (w < wave) base += x; tot += x; }
    __syncthreads();
    total = tot; return base + s - v;
}
__device__ __forceinline__ void topk_unit(LAS unsigned char* L, int unit, const float* AFF, int* IDX, float* VAL, int* SLOT) {
    int tid_o_ = threadIdx.x; asm volatile("" : "+v"(tid_o_)); const int tid = tid_o_, lane = tid & 63, wave = __builtin_amdgcn_readfirstlane(tid >> 6);
    LAS unsigned* HIST = (LAS unsigned*)L; LAS unsigned* SH = HIST + 256; LAS unsigned* SCR = SH + 8;
    const int b = unit >> 4, e = unit & 15;
    unsigned key[8];
    { const u32x4 k0 = *(const GAS u32x4*)(AFF + (size_t)unit * SEQ + tid * 8), k1 = *(const GAS u32x4*)(AFF + (size_t)unit * SEQ + tid * 8 + 4);
        key[0] = k0.x; key[1] = k0.y; key[2] = k0.z; key[3] = k0.w; key[4] = k1.x; key[5] = k1.y; key[6] = k1.z; key[7] = k1.w; }
    unsigned prefix = 0;
#pragma unroll 1
    for (int bit = 31; bit >= 0; --bit) { const unsigned cand = prefix | (1u << bit); unsigned c = 0;
#pragma unroll
        for (int q = 0; q < 8; ++q) c += (unsigned)__popcll(__ballot(key[q] >= cand));
        if (lane == 0) HIST[(bit & 1) * 8 + wave] = c;
        __syncthreads();
        unsigned tot = 0;
#pragma unroll
        for (int w = 0; w < NWAVES; ++w) tot += HIST[(bit & 1) * 8 + w];
        if (tot >= (unsigned)CAP) prefix = cand; }
    unsigned gtc = 0;
#pragma unroll
    for (int q = 0; q < 8; ++q) gtc += (key[q] > prefix) ? 1u : 0u;
    unsigned gtot_; (void)block_excl_scan(gtc, SCR, tid, lane, wave, gtot_);
    const unsigned need = (unsigned)CAP - gtot_;
    const unsigned T = prefix;
    unsigned eq = 0;
#pragma unroll
    for (int q = 0; q < 8; ++q) eq += (key[q] == T) ? 1u : 0u;
    unsigned tot; unsigned eqbase = block_excl_scan(eq, SCR, tid, lane, wave, tot);
    unsigned selmask = 0, cnt = 0;
#pragma unroll
    for (int q = 0; q < 8; ++q) { bool sel = key[q] > T; if (key[q] == T) { sel = eqbase < need; ++eqbase; } if (sel) { selmask |= 1u << q; ++cnt; } }
    unsigned slot = block_excl_scan(cnt, SCR, tid, lane, wave, tot);
#pragma unroll
    for (int q = 0; q < 8; ++q) { const int t = tid * 8 + q; int sl = -1;
        if (selmask & (1u << q)) { sl = (int)slot; ++slot; if (sl < CAP) { IDX[unit * CAP + sl] = t; VAL[unit * CAP + sl] = __uint_as_float(key[q]); } else sl = -1; }
        SLOT[((size_t)b * SEQ + t) * NE + e] = sl; }
    __syncthreads();
}
__global__ void __launch_bounds__(NTHREADS, 2) fwd_kernel(Args args) {
    extern __shared__ __attribute__((aligned(16))) unsigned char lds_raw[];
    LAS unsigned char* L = (LAS unsigned char*)lds_raw;
    volatile LAS unsigned* MISC = (volatile LAS unsigned*)(L + MISC_OFF);
    LAS unsigned* TAB = (LAS unsigned*)(L + TAB_OFF);
    const int tid = threadIdx.x, lane = tid & 63, wave = __builtin_amdgcn_readfirstlane(tid >> 6);
    const int G = gridDim.x, bid = blockIdx.x;
    if (tid < 64) MISC[tid] = 0u;
    __syncthreads();
    unsigned char* ws = args.ws;
    unsigned* ctl = (unsigned*)(ws + WS_CTL);
    XcdBarrier bar = xcd_barrier_post(ctl + CW_BAR, MISC + 8);
    const int gw = bid * NWAVES + wave, NGW = G * NWAVES;
    const int lo = args.ph_lo, hi = args.ph_hi;
#define IN(k) (lo <= (k) && (k) < hi)
#ifndef REPMASK
#define REPMASK 0
#endif
#define PH(k) for (int rp_ = 0; rp_ <= ((REPMASK >> (k)) & 1); ++rp_) if (IN(k))
#define RPB do { if (rp_) xcd_barrier(bar); } while (0)
#define OPQ_IDS int tid_o_ = threadIdx.x; asm volatile("" : "+v"(tid_o_)); const int tid = tid_o_, lane = tid & 63; (void)tid; (void)lane
#ifndef REPSUB
#define REPSUB 0
#endif
#define RS(k) for (int rs_ = 0; rs_ <= ((REPSUB >> (k)) & 1); ++rs_)
#ifdef TPROBE_A
    unsigned long long* TSB = (unsigned long long*)(ws + WS_CTL + 512 * 1024);
#define STAMP(k) do { if (bid == 0 && tid == 0) TSB[k] = __builtin_amdgcn_s_memrealtime(); } while (0)
#else
#define STAMP(k) do { } while (0)
#endif
#define SEAM(k) do { if (IN(k) && IN((k) + 1)) xcd_barrier(bar); STAMP((k) + 1); } while (0)
    STAMP(0);

    float* MOD = (float*)(ws + WS_MOD);
    float* TW = (float*)(ws + WS_TW);
    bf16_t* DA = (bf16_t*)(ws + WS_DA); bf16_t* DB = (bf16_t*)(ws + WS_DB); bf16_t* DC = (bf16_t*)(ws + WS_DC);
    bf16_t* WIN = (bf16_t*)(ws + WS_WIN); bf16_t* WOUT = (bf16_t*)(ws + WS_WOUT);
    bf16_t* PF = (bf16_t*)(ws + WS_PF); bf16_t* PQKV = (bf16_t*)(ws + WS_PQKV); bf16_t* PZ = (bf16_t*)(ws + WS_PZ); float* PAB = (float*)(ws + WS_PAB);
    bf16_t* A2 = (bf16_t*)(ws + WS_A2);
    bf16_t* OF = (bf16_t*)(ws + WS_A2 + (size_t)MTOK * D_MODEL * 2); bf16_t* OB = OF + (size_t)MTOK * GDW;
    bf16_t* HX = (bf16_t*)args.out;
    bf16_t* XB = (bf16_t*)args.out + (size_t)MTOK * D_MODEL;
    bf16_t* YB = (bf16_t*)args.out;
    bf16_t* X2B = (bf16_t*)(ws + WS_A2 + (size_t)MTOK * D_MODEL * 2);

    PH(0) { RPB; OPQ_IDS;
        if (bid < 192) {
            LAS float* SC = (LAS float*)L;
            LAS float* RED = (LAS float*)(L + 5 * 2048 * 4);
            for (int i = tid; i < 5 * 2048; i += NTHREADS) { const int r = i >> 11, k = i & 2047; const float v = r < 4 ? args.in[I_C][r * 2048 + k] : args.in[I_CCTX][k]; SC[i] = silu_f(v); }
            __syncthreads();
            for (int s = bid; s < 192; s += G) {
                const int cg = lane & 15, ksub = lane >> 4;
                const float* wp = args.in[I_WMOD] + (size_t)(wave * 256 + ksub) * 12288 + s * 64 + cg * 4;
                f32x4 a0 = {0.f, 0.f, 0.f, 0.f}, a1 = a0, a2 = a0, a3 = a0, a4 = a0;
                for (int k = 0; k < 256; k += 32) {
                    f32x4 wv[8];
#pragma unroll
                    for (int j = 0; j < 8; ++j) wv[j] = __builtin_nontemporal_load((const GAS f32x4*)(wp + (size_t)(k + 4 * j) * 12288));
#pragma unroll
                    for (int j = 0; j < 8; ++j) { const int kk = wave * 256 + k + 4 * j + ksub;
                        a0 += wv[j] * SC[kk]; a1 += wv[j] * SC[2048 + kk]; a2 += wv[j] * SC[4096 + kk]; a3 += wv[j] * SC[6144 + kk]; a4 += wv[j] * SC[8192 + kk]; }
                }
                LAS float* rp = RED + ((wave * 4 + ksub) * 5) * 64 + cg * 4;
                *(LAS f32x4*)(rp) = a0; *(LAS f32x4*)(rp + 64) = a1; *(LAS f32x4*)(rp + 128) = a2; *(LAS f32x4*)(rp + 192) = a3; *(LAS f32x4*)(rp + 256) = a4;
                __syncthreads();
                if (tid < 320) { const int r = tid >> 6, c = tid & 63; float v = 0.f;
#pragma unroll
                    for (int w = 0; w < 32; ++w) v += RED[(w * 5 + r) * 64 + c];
                    MOD[r * 12288 + s * 64 + c] = v + args.in[I_BMOD][s * 64 + c]; }
                __syncthreads();
            }
        }
        if (bid == G - 1) {
            for (int i = tid; i < 4096; i += NTHREADS) { float s, c; sincosf(6.283185307179586f * (float)i / 4096.f, &s, &c); TW[2 * i] = c; TW[2 * i + 1] = s; }
            for (int i = tid; i < 128 * 64; i += NTHREADS) { const int r = i >> 6, n1 = i & 63, a = r & 63; const int m = (a * n1) & 63; float s, c; sincosf(6.283185307179586f * (float)m / 64.f, &s, &c);
                DA[i] = (bf16_t)f2bf(r < 64 ? c : -s); }
        }
        if (bid == G - 2) {
            for (int i = tid; i < 128 * 128; i += NTHREADS) { const int r = i >> 7, rho = i & 127, k2 = r & 63, n2 = rho >> 1, ri = rho & 1; const int m = (k2 * n2) & 63; float s, c; sincosf(6.283185307179586f * (float)m / 64.f, &s, &c);
                const float v = r < 64 ? (ri == 0 ? c : s) : (ri == 0 ? -s : c); DB[i] = (bf16_t)f2bf(v); }
        }
        if (bid == G - 3) {
            const float scale = 0.0013810679320049757f;
            for (int i = tid; i < 128 * 256; i += NTHREADS) { const int cp = i >> 8, kap = i & 255, ri = kap >> 7, c = kap & 127; const int m = (c * cp) & 127; float s, co; sincosf(6.283185307179586f * (float)m / 128.f, &s, &co);
                DC[i] = (bf16_t)f2bf((ri == 0 ? co : s) * scale); }
        }
        for (size_t i = (size_t)bid * NTHREADS + tid; i < (size_t)(INC_PAD - INC) * D_MODEL / 8; i += (size_t)G * NTHREADS) *(GAS u32x4*)(WIN + (size_t)INC * D_MODEL + i * 8) = (u32x4){0u, 0u, 0u, 0u};
        {
            __syncthreads();
            LAS float* T = (LAS float*)L;
            constexpr int N_IN = 32 * 21, N_OUT = 32 * 8, NIT = N_IN + N_OUT;
            auto mk = [&](int it) { XposeItem x; if (it < N_IN) { x.src = args.in[I_WIN]; x.ldn = INC; x.ncols = INC; x.k0 = 64 * (it / 21); x.n0 = 256 * (it % 21); x.dst = WIN; x.dstK = D_MODEL; x.mode = 0; }
                else { const int r = it - N_IN; x.src = args.in[I_WOUT]; x.ldn = D_MODEL; x.ncols = D_MODEL; x.k0 = 64 * (r / 8); x.n0 = 256 * (r % 8); x.dst = WOUT; x.dstK = D_MODEL; x.mode = 0; } return x; };
            f32x4 r[8];
            if (tid == 0) MISC[18] = atomicAdd(ctl + CW_Q0, 1u);
            __syncthreads();
            int it = (int)MISC[18];
            if (it < NIT) { XposeItem x = mk(it); xpose_load(x, r, tid); }
            for (int qn = 0; it < NIT; ++qn) {
                XposeItem x = mk(it);
                xpose_store_lds(T, r, tid);
                if (tid == 0) MISC[19 + (qn & 1)] = atomicAdd(ctl + CW_Q0, 1u);
                __syncthreads();
                const int nx = (int)MISC[19 + (qn & 1)];
                if (nx < NIT) { XposeItem y = mk(nx); xpose_load(y, r, tid); }
                xpose_emit(x, T, tid);
                __syncthreads();
                it = nx;
            }
        }
    }
    SEAM(0);

    PH(1) { RPB; OPQ_IDS;
        const float* g1 = args.in[I_N1G];
        f32x4 ca[8], cb[8]; int curmr = -1;
        const int PW = (MTOK / 2 + NGW - 1) / NGW;
        for (int k = 0; k < PW; ++k) {
            const int p = gw + k * NGW;
            if (p >= MTOK / 2) continue;
            const int m0 = 2 * p; const int mr = m0 < MTOK ? (m0 >> 12) : 4;
            if (mr != curmr) { curmr = mr; const float* sh = MOD + mr * 12288; const float* sc = sh + 2048;
#pragma unroll
                for (int j = 0; j < 8; ++j) { const f32x4 gg = *((const GAS f32x4*)g1 + lane + 64 * j), s1 = *((const GAS f32x4*)sc + lane + 64 * j); ca[j] = gg * (s1 + 1.f); cb[j] = *((const GAS f32x4*)sh + lane + 64 * j); } }
            const float* src = m0 < MTOK ? args.in[I_X] + (size_t)m0 * D_MODEL : args.in[I_CTX] + (size_t)(m0 - MTOK) * D_MODEL;
            f32x4 v0[8], v1[8]; float s0 = 0.f, s1_ = 0.f;
#pragma unroll
            for (int j = 0; j < 8; ++j) { v0[j] = __builtin_nontemporal_load((const GAS f32x4*)src + lane + 64 * j); v1[j] = __builtin_nontemporal_load((const GAS f32x4*)(src + D_MODEL) + lane + 64 * j); }
#pragma unroll
            for (int j = 0; j < 8; ++j) { s0 += (v0[j].x * v0[j].x + v0[j].y * v0[j].y) + (v0[j].z * v0[j].z + v0[j].w * v0[j].w); s1_ += (v1[j].x * v1[j].x + v1[j].y * v1[j].y) + (v1[j].z * v1[j].z + v1[j].w * v1[j].w); }
#pragma unroll
            for (int o = 1; o < 64; o <<= 1) { s0 += __shfl_xor(s0, o); s1_ += __shfl_xor(s1_, o); }
            const float r0 = __builtin_amdgcn_rsqf(s0 * (1.f / D_MODEL) + EPS), r1 = __builtin_amdgcn_rsqf(s1_ * (1.f / D_MODEL) + EPS);
            GAS u32x2* o0 = (GAS u32x2*)(HX + (size_t)m0 * D_MODEL) + lane; GAS u32x2* o1 = o0 + D_MODEL / 4;
            GAS u32x2* x0 = (GAS u32x2*)(XB + (size_t)m0 * D_MODEL) + lane; GAS u32x2* x1 = x0 + D_MODEL / 4;
#pragma unroll
            for (int j = 0; j < 8; ++j) { const f32x4 y0 = v0[j] * r0 * ca[j] + cb[j], y1 = v1[j] * r1 * ca[j] + cb[j];
                u32x2 w; w.x = pk2(y0.x, y0.y); w.y = pk2(y0.z, y0.w); o0[64 * j] = w; w.x = pk2(y1.x, y1.y); w.y = pk2(y1.z, y1.w); o1[64 * j] = w;
                w.x = pk2(v0[j].x, v0[j].y); w.y = pk2(v0[j].z, v0[j].w); x0[64 * j] = w; w.x = pk2(v1[j].x, v1[j].y); w.y = pk2(v1[j].z, v1[j].w); x1[64 * j] = w; }
        }
        for (int r = gw >> 1; (gw & 1) == 0 && r < MCTX; r += NGW / 2) {
            const float* sh = MOD + 4 * 12288; const float* sc = sh + 2048; const float* src = args.in[I_CTX] + (size_t)r * D_MODEL;
            f32x4 v0[8]; float s0 = 0.f;
#pragma unroll
            for (int j = 0; j < 8; ++j) { v0[j] = *((const GAS f32x4*)src + lane + 64 * j); s0 += (v0[j].x * v0[j].x + v0[j].y * v0[j].y) + (v0[j].z * v0[j].z + v0[j].w * v0[j].w); }
            const float r0 = __builtin_amdgcn_rsqf(wave_sum(s0) * (1.f / D_MODEL) + EPS);
            GAS u32x2* o0 = (GAS u32x2*)((bf16_t*)(ws + WS_HXC) + (size_t)r * D_MODEL) + lane;
#pragma unroll
            for (int j = 0; j < 8; ++j) { const f32x4 gg = *((const GAS f32x4*)g1 + lane + 64 * j), s1 = *((const GAS f32x4*)sc + lane + 64 * j), h1 = *((const GAS f32x4*)sh + lane + 64 * j);
                const f32x4 y0 = v0[j] * r0 * gg * (s1 + 1.f) + h1; u32x2 w; w.x = pk2(y0.x, y0.y); w.y = pk2(y0.z, y0.w); o0[64 * j] = w; }
        }
    }
    SEAM(1);

    PH(2) { RPB; OPQ_IDS;
        SchedIn S{(const char*)HX, (const char*)(ws + WS_HXC), (const char*)WIN, G, bid};
        EpiIn E{PF, PQKV, PZ, PAB};
        pg8::gemm_phase<EpiIn, SchedIn, false>(L, TAB, D_MODEL, S, E);
        { constexpr int NU = 64 * 21 + 4 * 13; const int mine = (NU - bid + G - 1) / G, most = (NU + G - 1) / G;
            if (mine < most) moe_convert(L, MISC, ctl + CW_Q2, args.in[I_WGATE], args.in[I_WUP], args.in[I_WDOWN], (bf16_t*)(ws + WS_WGU), (bf16_t*)(ws + WS_WDN), 11 * (most - mine)); }
    }
    SEAM(2);

    PH(3) { RPB; OPQ_IDS;
        RS(0) gdn_chunk_items(L, bid, G, PQKV, PAB, args.in[I_CONVW], args.in[I_ALOG], args.in[I_DTB], ws + WS_G, ctl + CW_Q2, args.in[I_WGATE], args.in[I_WUP], args.in[I_WDOWN], (bf16_t*)(ws + WS_WGU), (bf16_t*)(ws + WS_WDN));
        __syncthreads();
        constexpr int LDF = 136, LDA_ = 72, LDO = 136;
        LAS bf16_t* DAl = (LAS bf16_t*)L;
        LAS bf16_t* Fi = (LAS bf16_t*)(L + 128 * LDA_ * 2);
        LAS bf16_t* Oi = (LAS bf16_t*)(L + 128 * LDA_ * 2 + 64 * LDF * 2);
        for (int i = tid; i < 128 * 64; i += NTHREADS) DAl[(i >> 6) * LDA_ + (i & 63)] = DA[i];
        LBAR();
        RS(1) for (int it = bid; it < BATCH * 64 * 8; it += G) {
            const int g = it & 7, n2 = (it >> 3) & 63, b = it >> 9;
#pragma unroll
            for (int j = 0; j < 2; ++j) { const int idx = tid + 512 * j, row = idx >> 4, ch = idx & 15;
                const u32x4 v = *(const GAS u32x4*)(PF + (size_t)(b * SEQ + 64 * row + n2) * FW + g * 128 + ch * 8);
                *(LAS u32x4*)(Fi + row * LDF + ch * 8) = v; }
            LBAR();
            const int ct = wave & 3, kt = wave >> 2;
            f32x16 are = Z16, aim = Z16;
            { bf16x8 fb_[4], fr_[4], fi_[4];
#pragma unroll
                for (int ks = 0; ks < 4; ++ks) { fb_[ks] = frag_tr(Fi, LDF, 32 * ct, 16 * ks, lane); fr_[ks] = frag_row(DAl, LDA_, 32 * kt, 16 * ks, lane); fi_[ks] = frag_row(DAl, LDA_, 64 + 32 * kt, 16 * ks, lane); }
                __builtin_amdgcn_sched_barrier(0);
#pragma unroll
                for (int ks = 0; ks < 4; ++ks) { are = MFMA32(fr_[ks], fb_[ks], are); aim = MFMA32(fi_[ks], fb_[ks], aim); } }
#pragma unroll
            for (int r = 0; r < 16; ++r) { const int k1 = 32 * kt + crow(r, lane); const int m = (n2 * k1) & 4095; const float c = TW[2 * m], s = TW[2 * m + 1];
                const float re = are[r] * c + aim[r] * s, im = aim[r] * c - are[r] * s;
                Oi[k1 * LDO + 32 * ct + (lane & 31)] = (bf16_t)f2bf(re); Oi[(64 + k1) * LDO + 32 * ct + (lane & 31)] = (bf16_t)f2bf(im); }
            LBAR();
#pragma unroll
            for (int j = 0; j < 4; ++j) { const int idx = tid + 512 * j, row = idx >> 4, ch = idx & 15, ri = row >> 6, k1 = row & 63;
                const u32x4 v = *(const LAS u32x4*)(Oi + row * LDO + ch * 8);
                *(GAS u32x4*)(YB + ((size_t)((b * 64 + k1) * 64 + n2) * 2 + ri) * FW + g * 128 + ch * 8) = v; }
        }
    }
    if (IN(3)) { constexpr int NI = BATCH * NH * 64 + BATCH * NH * 4; const int mine = (NI - bid + G - 1) / G, most = (NI + G - 1) / G;
        if (mine < most) moe_convert(L, MISC, ctl + CW_Q2, args.in[I_WGATE], args.in[I_WUP], args.in[I_WDOWN], (bf16_t*)(ws + WS_WGU), (bf16_t*)(ws + WS_WDN), 4 * (most - mine)); }
    SEAM(3);

    PH(4) { RPB; OPQ_IDS;
    if (bid < 64) {
        RS(2) for (int u = bid; u < 64; u += G) gdn_scan_unit(L, u, ws + WS_G, OF, OB);
    }
    if (bid >= 64) {
        constexpr int LDB_ = 136, LDT = 136, LDZ = 264, LDO2 = 136;
        LAS bf16_t* DBl = (LAS bf16_t*)L;
        LAS bf16_t* DCl = (LAS bf16_t*)(L + 34816);
        LAS bf16_t* W0 = (LAS bf16_t*)(L + 34816 + 65536);
        for (int i = tid; i < 128 * 128; i += NTHREADS) DBl[(i >> 7) * LDB_ + (i & 127)] = DB[i];
        for (int i = tid; i < 128 * 32; i += NTHREADS) { const int row = i >> 5, ch = i & 31; *(LAS u32x4*)(DCl + row * 256 + ((ch ^ (row & 15)) * 8)) = *(const GAS u32x4*)(DC + row * 256 + ch * 8); }
        LBAR();
        for (int qn = 0;; ++qn) {
            if (tid == 0) MISC[16 + (qn & 1)] = atomicAdd(ctl + CW_Q1, 1u);
            LBAR();
            const int it = (int)MISC[16 + (qn & 1)];
            if (it >= BATCH * 64 * 8) break;
            const int g = it & 7, k1 = (it >> 3) & 63, b = it >> 9;
#pragma unroll
            for (int j = 0; j < 4; ++j) { const int idx = tid + 512 * j, row = idx >> 4, ch = idx & 15;
                const u32x4 v = *(const GAS u32x4*)(YB + ((size_t)(b * 64 + k1) * 128 + row) * FW + g * 128 + ch * 8);
                *(LAS u32x4*)(W0 + row * LDT + ch * 8) = v; }
            LBAR();
            const int ct = wave & 3, kt = wave >> 2;
            f32x16 zre = Z16, zim = Z16;
#pragma unroll
            for (int kh = 0; kh < 2; ++kh) { bf16x8 fb_[4], fr_[4], fi_[4];
#pragma unroll
                for (int k4 = 0; k4 < 4; ++k4) { const int ks = 4 * kh + k4; fb_[k4] = frag_tr(W0, LDT, 32 * ct, 16 * ks, lane); fr_[k4] = frag_row(DBl, LDB_, 32 * kt, 16 * ks, lane); fi_[k4] = frag_row(DBl, LDB_, 64 + 32 * kt, 16 * ks, lane); }
                __builtin_amdgcn_sched_barrier(0);
#pragma unroll
                for (int k4 = 0; k4 < 4; ++k4) { zre = MFMA32(fr_[k4], fb_[k4], zre); zim = MFMA32(fi_[k4], fb_[k4], zim); }
                __builtin_amdgcn_sched_barrier(0); }
            LBAR();
#pragma unroll
            for (int r = 0; r < 16; ++r) { const int k2 = 32 * kt + crow(r, lane); const int c = 32 * ct + (lane & 31);
                W0[k2 * LDZ + c] = (bf16_t)f2bf(zre[r]); W0[k2 * LDZ + 128 + c] = (bf16_t)f2bf(zim[r]); }
            LBAR();
            f32x16 yo = Z16;
            { const int mt = wave >> 2, nt2 = wave & 3; const int rowc = 32 * nt2 + (lane & 31);
#pragma unroll
                for (int kq = 0; kq < 2; ++kq) { bf16x8 fa_[8], fb_[8];
#pragma unroll
                    for (int k8 = 0; k8 < 8; ++k8) { const int ks = 8 * kq + k8, chunk = 2 * ks + (lane >> 5);
                        fb_[k8] = *(const LAS bf16x8*)(DCl + rowc * 256 + ((chunk ^ (rowc & 15)) * 8)); fa_[k8] = frag_row(W0, LDZ, 32 * mt, 16 * ks, lane); }
                    __builtin_amdgcn_sched_barrier(0);
#pragma unroll
                    for (int k8 = 0; k8 < 8; ++k8) yo = MFMA32(fa_[k8], fb_[k8], yo);
                    __builtin_amdgcn_sched_barrier(0); } }
            LBAR();
            { const int mt = wave >> 2, nt2 = wave & 3;
#pragma unroll
                for (int r = 0; r < 16; ++r) W0[(32 * mt + crow(r, lane)) * LDO2 + 32 * nt2 + (lane & 31)] = (bf16_t)f2bf(yo[r]); }
            LBAR();
#pragma unroll
            for (int j = 0; j < 2; ++j) { const int idx = tid + 512 * j, k2 = idx >> 4, ch = idx & 15;
                *(GAS u32x4*)(A2 + (size_t)(b * SEQ + k1 + 64 * k2) * D_MODEL + g * 128 + ch * 8) = *(const LAS u32x4*)(W0 + k2 * LDO2 + ch * 8); }
            LBAR();
        }
    }
    moe_convert(L, MISC, ctl + CW_Q2, args.in[I_WGATE], args.in[I_WUP], args.in[I_WDOWN], (bf16_t*)(ws + WS_WGU), (bf16_t*)(ws + WS_WDN), 1 << 30);
    }
    SEAM(4);

    PH(5) { RPB; OPQ_IDS;
        const float* gnw = args.in[I_GNW];
        f32x4 gn0 = *(const GAS f32x4*)(gnw + ((lane * 8) & 127)), gn1 = *(const GAS f32x4*)(gnw + ((lane * 8) & 127) + 4);
        auto ld2 = [&](u32x4 (&a)[2][2], u32x4 (&bq)[2][2], u32x4 (&zz)[2][2], int m) {
#pragma unroll
            for (int t = 0; t < 2; ++t)
#pragma unroll
                for (int half = 0; half < 2; ++half) { const size_t off = (size_t)(m + t) * GDW + half * 512 + lane * 8;
                    a[t][half] = *(const GAS u32x4*)(OF + off); bq[t][half] = *(const GAS u32x4*)(OB + off); zz[t][half] = *(const GAS u32x4*)(PZ + off); } };
        auto do2 = [&](const u32x4 (&a)[2][2], const u32x4 (&bq)[2][2], const u32x4 (&zz)[2][2], int m) {
#pragma unroll
            for (int t = 0; t < 2; ++t)
#pragma unroll
                for (int half = 0; half < 2; ++half) {
                    const unsigned aw[4] = {a[t][half].x, a[t][half].y, a[t][half].z, a[t][half].w}, bw[4] = {bq[t][half].x, bq[t][half].y, bq[t][half].z, bq[t][half].w}, zw[4] = {zz[t][half].x, zz[t][half].y, zz[t][half].z, zz[t][half].w};
                    float o[8]; float ss = 0.f;
#pragma unroll
                    for (int q = 0; q < 4; ++q) { o[2 * q] = bf2f(aw[q] & 0xffffu) + bf2f(bw[q] & 0xffffu); o[2 * q + 1] = bf2f(aw[q] >> 16) + bf2f(bw[q] >> 16); ss += o[2 * q] * o[2 * q] + o[2 * q + 1] * o[2 * q + 1]; }
                    ss += dpp_xor1(ss); ss += dpp_xor2(ss); ss += __shfl_xor(ss, 4); ss += __shfl_xor(ss, 8);
                    const float rstd = __builtin_amdgcn_rsqf(ss * (1.f / HD) + EPS);
                    const float gp[8] = {gn0.x, gn0.y, gn0.z, gn0.w, gn1.x, gn1.y, gn1.z, gn1.w};
                    float y[8];
#pragma unroll
                    for (int q = 0; q < 4; ++q) { const float z0 = bf2f(zw[q] & 0xffffu), z1 = bf2f(zw[q] >> 16); y[2 * q] = o[2 * q] * rstd * gp[2 * q] * silu_f(z0); y[2 * q + 1] = o[2 * q + 1] * rstd * gp[2 * q + 1] * silu_f(z1); }
                    u32x4 w; w.x = pk2(y[0], y[1]); w.y = pk2(y[2], y[3]); w.z = pk2(y[4], y[5]); w.w = pk2(y[6], y[7]);
                    *(GAS u32x4*)(A2 + (size_t)(m + t) * D_MODEL + 1024 + half * 512 + lane * 8) = w; } };
        { u32x4 a0[2][2], b0[2][2], z0[2][2], a1[2][2], b1[2][2], z1[2][2];
            const int st = 2 * NGW; int m = 2 * gw;
            if (m < MTOK) ld2(a0, b0, z0, m);
            for (; m < MTOK; m += 2 * st) {
                if (m + st < MTOK) ld2(a1, b1, z1, m + st);
                do2(a0, b0, z0, m);
                if (m + 2 * st < MTOK) ld2(a0, b0, z0, m + 2 * st);
                if (m + st < MTOK) do2(a1, b1, z1, m + st);
            }
        }
    }
    SEAM(5);

    PH(6) { RPB; OPQ_IDS;
        SchedOut S{(const char*)A2, (const char*)WOUT, G, bid};
        EpiOut E{XB, MOD, X2B};
        pg8::gemm_phase<EpiOut, SchedOut, false>(L, TAB, D_MODEL, S, E);
    }
    SEAM(6);

    PH(7) { RPB; OPQ_IDS;
        LAS float* WR = (LAS float*)L;
        for (int i = tid; i < D_MODEL * NE; i += NTHREADS) { const int e = i & 15, k = i >> 4; WR[e * 2048 + ((k >> 2) & 1) * 1024 + (k >> 3) * 4 + (k & 3)] = args.in[I_WROUTER][i]; }
        __syncthreads();
        const float* g2 = args.in[I_N2G];
        bf16_t* HX2 = (bf16_t*)(ws + WS_HX2); float* AFF = (float*)(ws + WS_AFF);
        u32x4 pq0[4], pq1[4];
        if (2 * gw < MTOK) {
#pragma unroll
            for (int jc = 0; jc < 4; ++jc) { pq0[jc] = *((const GAS u32x4*)(X2B + (size_t)(2 * gw) * D_MODEL) + lane + 64 * jc); pq1[jc] = *((const GAS u32x4*)(X2B + (size_t)(2 * gw + 1) * D_MODEL) + lane + 64 * jc); } }
        for (int m0 = 2 * gw; m0 < MTOK; m0 += 2 * NGW) {
            const int b = m0 >> 12;
            const float* sh = MOD + b * 12288 + 3 * 2048; const float* sc = sh + 2048;
            f32x4 v[2][8]; float s0 = 0.f, s1 = 0.f;
            u32x4 cq0[4], cq1[4];
#pragma unroll
            for (int jc = 0; jc < 4; ++jc) { cq0[jc] = pq0[jc]; cq1[jc] = pq1[jc]; }
            { const int mn = m0 + 2 * NGW; if (mn < MTOK) {
#pragma unroll
                for (int jc = 0; jc < 4; ++jc) { pq0[jc] = *((const GAS u32x4*)(X2B + (size_t)mn * D_MODEL) + lane + 64 * jc); pq1[jc] = *((const GAS u32x4*)(X2B + (size_t)(mn + 1) * D_MODEL) + lane + 64 * jc); } } }
#pragma unroll
            for (int jc = 0; jc < 4; ++jc) { const u32x4 q0 = cq0[jc], q1 = cq1[jc];
                v[0][2 * jc] = (f32x4){bf2f(q0.x & 0xffffu), bf2f(q0.x >> 16), bf2f(q0.y & 0xffffu), bf2f(q0.y >> 16)}; v[0][2 * jc + 1] = (f32x4){bf2f(q0.z & 0xffffu), bf2f(q0.z >> 16), bf2f(q0.w & 0xffffu), bf2f(q0.w >> 16)};
                v[1][2 * jc] = (f32x4){bf2f(q1.x & 0xffffu), bf2f(q1.x >> 16), bf2f(q1.y & 0xffffu), bf2f(q1.y >> 16)}; v[1][2 * jc + 1] = (f32x4){bf2f(q1.z & 0xffffu), bf2f(q1.z >> 16), bf2f(q1.w & 0xffffu), bf2f(q1.w >> 16)}; }
#pragma unroll
            for (int j = 0; j < 8; ++j) { s0 += (v[0][j].x * v[0][j].x + v[0][j].y * v[0][j].y) + (v[0][j].z * v[0][j].z + v[0][j].w * v[0][j].w); s1 += (v[1][j].x * v[1][j].x + v[1][j].y * v[1][j].y) + (v[1][j].z * v[1][j].z + v[1][j].w * v[1][j].w); }
#pragma unroll
            for (int o = 1; o < 64; o <<= 1) { s0 += __shfl_xor(s0, o); s1 += __shfl_xor(s1, o); }
            const float r0 = __builtin_amdgcn_rsqf(s0 * (1.f / D_MODEL) + EPS), r1 = __builtin_amdgcn_rsqf(s1 * (1.f / D_MODEL) + EPS);
#pragma unroll
            for (int jc = 0; jc < 4; ++jc) { const int c0 = 8 * (lane + 64 * jc); u32x4 w0, w1;
#pragma unroll
                for (int hh = 0; hh < 2; ++hh) { const f32x4 gg = *(const GAS f32x4*)(g2 + c0 + 4 * hh), sc1 = *(const GAS f32x4*)(sc + c0 + 4 * hh) + 1.f, h1 = *(const GAS f32x4*)(sh + c0 + 4 * hh);
                    const f32x4 y0 = v[0][2 * jc + hh] * r0 * gg * sc1 + h1, y1 = v[1][2 * jc + hh] * r1 * gg * sc1 + h1; v[0][2 * jc + hh] = y0; v[1][2 * jc + hh] = y1;
                    if (hh == 0) { w0.x = pk2(y0.x, y0.y); w0.y = pk2(y0.z, y0.w); w1.x = pk2(y1.x, y1.y); w1.y = pk2(y1.z, y1.w); } else { w0.z = pk2(y0.x, y0.y); w0.w = pk2(y0.z, y0.w); w1.z = pk2(y1.x, y1.y); w1.w = pk2(y1.z, y1.w); } }
                *((GAS u32x4*)(HX2 + (size_t)m0 * D_MODEL) + lane + 64 * jc) = w0; *((GAS u32x4*)(HX2 + (size_t)(m0 + 1) * D_MODEL) + lane + 64 * jc) = w1; }
            float a0[16], a1[16];
#pragma unroll
            for (int eg = 0; eg < 4; ++eg) {
#pragma unroll
                for (int q = 0; q < 4; ++q) { const int e = 4 * eg + q; float c0 = 0.f, c1 = 0.f;
#pragma unroll
                    for (int j = 0; j < 8; ++j) { const f32x4 w4 = *(const LAS f32x4*)(WR + e * 2048 + (j & 1) * 1024 + 4 * (lane + 64 * (j >> 1)));
                        c0 += (v[0][j].x * w4.x + v[0][j].y * w4.y) + (v[0][j].z * w4.z + v[0][j].w * w4.w); c1 += (v[1][j].x * w4.x + v[1][j].y * w4.y) + (v[1][j].z * w4.z + v[1][j].w * w4.w); }
                    a0[e] = c0; a1[e] = c1; }
                asm volatile("" ::: "memory"); }
#pragma unroll
            for (int st = 0; st < 4; ++st) { const int msk = 1 << st, n2 = 8 >> st; const bool up = (lane & msk) != 0;
#pragma unroll
                for (int q = 0; q < 8; ++q) if (q < n2) { const float k0 = up ? a0[q + n2] : a0[q], d0 = up ? a0[q] : a0[q + n2], k1 = up ? a1[q + n2] : a1[q], d1 = up ? a1[q] : a1[q + n2];
                    a0[q] = k0 + __shfl_xor(d0, msk); a1[q] = k1 + __shfl_xor(d1, msk); } }
            float l0 = a0[0], l1 = a1[0]; l0 += __shfl_xor(l0, 16); l1 += __shfl_xor(l1, 16); l0 += __shfl_xor(l0, 32); l1 += __shfl_xor(l1, 32);
            float mx0 = l0, mx1 = l1;
#pragma unroll
            for (int o = 1; o < 16; o <<= 1) { mx0 = fmaxf(mx0, __shfl_xor(mx0, o)); mx1 = fmaxf(mx1, __shfl_xor(mx1, o)); }
            const float e0 = expf(l0 - mx0), e1 = expf(l1 - mx1); float dn0 = e0, dn1 = e1;
#pragma unroll
            for (int o = 1; o < 16; o <<= 1) { dn0 += __shfl_xor(dn0, o); dn1 += __shfl_xor(dn1, o); }
            const int eidx = ((lane & 1) << 3) | ((lane & 2) << 1) | ((lane & 4) >> 1) | ((lane & 8) >> 3);
            if (lane < 16) { float* ap = AFF + ((size_t)b * NE + eidx) * SEQ + (m0 & 4095); f32x2 pr = {e0 / dn0, e1 / dn1}; *(GAS f32x2*)ap = pr; }
        }
    }
    SEAM(7);

    PH(8) { RPB; OPQ_IDS;
        for (int u = bid; u < BATCH * NE; u += G) topk_unit(L, u, (const float*)(ws + WS_AFF), (int*)(ws + WS_IDX), (float*)(ws + WS_VAL), (int*)(ws + WS_SLOT));
    }
    SEAM(8);

    PH(9) { RPB; OPQ_IDS;
        SchedGU S{(const char*)(ws + WS_HX2), (const char*)(ws + WS_WGU), (const int*)(ws + WS_IDX), G, bid};
        EpiGU E{(bf16_t*)(ws + WS_HID)};
        pg8::gemm_phase<EpiGU, SchedGU, true>(L, TAB, D_MODEL, S, E);
    }
    SEAM(9);

    PH(10) { RPB; OPQ_IDS;
        SchedDN S{(const char*)(ws + WS_HID), (const char*)(ws + WS_WDN), G, bid};
        EpiDN E{(bf16_t*)(ws + WS_YB), (const float*)(ws + WS_VAL)};
        pg8::gemm_phase<EpiDN, SchedDN, false>(L, TAB, FF, S, E);
    }
    SEAM(10);

    PH(11) { RPB; OPQ_IDS;
        const float* nf = args.in[I_NORMF]; const bf16_t* YB = (const bf16_t*)(ws + WS_YB); const int* SLOT = (const int*)(ws + WS_SLOT);
        f32x4 cg[8], cn[8]; int curb = -1;
        const int RW = (MTOK + NGW - 1) / NGW;
        for (int k = 0; k < RW; ++k) {
            const int m = gw + k * NGW; if (m >= MTOK) break;
            const int b = m >> 12;
            if (b != curb) { curb = b; const float* gt = MOD + b * 12288 + 5 * 2048;
#pragma unroll
                for (int jc = 0; jc < 4; ++jc) { const int c0 = 8 * (lane + 64 * jc); cg[2 * jc] = *(const GAS f32x4*)(gt + c0); cg[2 * jc + 1] = *(const GAS f32x4*)(gt + c0 + 4); cn[2 * jc] = *(const GAS f32x4*)(nf + c0); cn[2 * jc + 1] = *(const GAS f32x4*)(nf + c0 + 4); } }
            f32x4 v[8], y[8];
            u32x4 xq[4];
#pragma unroll
            for (int jc = 0; jc < 4; ++jc) xq[jc] = *((const GAS u32x4*)(X2B + (size_t)m * D_MODEL) + lane + 64 * jc);
            const int myslot = SLOT[(size_t)m * NE + (lane & 15)];
#pragma unroll
            for (int j = 0; j < 8; ++j) y[j] = (f32x4){0.f, 0.f, 0.f, 0.f};
            unsigned emask = (unsigned)(__ballot(myslot >= 0) & 0xffffull);
#pragma unroll 1
            while (emask) {
                int es[4], sl[4];
#pragma unroll
                for (int q = 0; q < 4; ++q) { if (emask) { es[q] = __builtin_ctz(emask); emask &= emask - 1; sl[q] = __builtin_amdgcn_readlane(myslot, es[q]); } else { es[q] = 0; sl[q] = -1; } }
                u32x4 w[4][4];
#pragma unroll
                for (int q = 0; q < 4; ++q) if (sl[q] >= 0) { const GAS u32x4* yr = (const GAS u32x4*)(YB + ((size_t)(b * NE + es[q]) * CAP + sl[q]) * D_MODEL) + lane;
#pragma unroll
                    for (int jc = 0; jc < 4; ++jc) w[q][jc] = yr[64 * jc]; }
#pragma unroll
                for (int q = 0; q < 4; ++q) if (sl[q] >= 0) {
#pragma unroll
                    for (int jc = 0; jc < 4; ++jc) { y[2 * jc].x += bf2f(w[q][jc].x & 0xffffu); y[2 * jc].y += bf2f(w[q][jc].x >> 16); y[2 * jc].z += bf2f(w[q][jc].y & 0xffffu); y[2 * jc].w += bf2f(w[q][jc].y >> 16);
                        y[2 * jc + 1].x += bf2f(w[q][jc].z & 0xffffu); y[2 * jc + 1].y += bf2f(w[q][jc].z >> 16); y[2 * jc + 1].z += bf2f(w[q][jc].w & 0xffffu); y[2 * jc + 1].w += bf2f(w[q][jc].w >> 16); } }
            }
            float s = 0.f;
#pragma unroll
            for (int jc = 0; jc < 4; ++jc) { v[2 * jc] = (f32x4){bf2f(xq[jc].x & 0xffffu), bf2f(xq[jc].x >> 16), bf2f(xq[jc].y & 0xffffu), bf2f(xq[jc].y >> 16)}; v[2 * jc + 1] = (f32x4){bf2f(xq[jc].z & 0xffffu), bf2f(xq[jc].z >> 16), bf2f(xq[jc].w & 0xffffu), bf2f(xq[jc].w >> 16)}; }
#pragma unroll
            for (int j = 0; j < 8; ++j) { v[j] = v[j] + cg[j] * y[j]; s += (v[j].x * v[j].x + v[j].y * v[j].y) + (v[j].z * v[j].z + v[j].w * v[j].w); }
            const float rstd = __builtin_amdgcn_rsqf(wave_sum(s) * (1.f / D_MODEL) + EPS);
            float* orow = args.out + (size_t)m * D_MODEL;
#pragma unroll
            for (int jc = 0; jc < 4; ++jc) { const int c0 = 8 * (lane + 64 * jc); __builtin_nontemporal_store(v[2 * jc] * rstd * cn[2 * jc], (GAS f32x4*)(orow + c0)); __builtin_nontemporal_store(v[2 * jc + 1] * rstd * cn[2 * jc + 1], (GAS f32x4*)(orow + c0 + 4)); }
        }
    }
#ifdef TPROBE_A
    __syncthreads();
    if (bid == 0 && tid == 0) { asm volatile("s_waitcnt vmcnt(0)" ::: "memory"); const unsigned long long te = __builtin_amdgcn_s_memrealtime(); TSB[12] = te;
        const float ta = (float)(TSB[TPROBE_A + 1] - TSB[TPROBE_A]) * 0.1f, tb = (float)(TSB[TPROBE_B + 1] - TSB[TPROBE_B]) * 0.1f;
        args.out[0] = ta; for (int i = 1; i <= 100; ++i) args.out[i] = tb; }
#endif
#undef IN
#undef SEAM
}

constexpr int NPHASES = 12;

extern "C" void kernel_launch(void* const* d_in, const int* in_sizes, int n_in, void* d_out, int out_size, void* d_ws, size_t ws_size, hipStream_t stream) {
    static int grid = 0;
    if (grid == 0) {
        if (n_in != 19 || out_size != MTOK * D_MODEL || ws_size < WS_END) { fprintf(stderr, "kernel_launch: unexpected shapes (n_in %d out %d ws %zu)\n", n_in, out_size, ws_size); grid = -1; return; }
        int dev = 0, cus = 0, per_cu = 0;
        if (hipGetDevice(&dev) != hipSuccess || hipDeviceGetAttribute(&cus, hipDeviceAttributeMultiprocessorCount, dev) != hipSuccess) { grid = -1; return; }
        if (hipFuncSetAttribute((const void*)fwd_kernel, hipFuncAttributeMaxDynamicSharedMemorySize, LDS_BYTES) != hipSuccess) { grid = -1; return; }
        if (hipOccupancyMaxActiveBlocksPerMultiprocessor(&per_cu, (const void*)fwd_kernel, NTHREADS, LDS_BYTES) != hipSuccess || per_cu < 1) { fprintf(stderr, "occupancy query: %d\n", per_cu); grid = -1; return; }
        grid = cus;
    }
    if (grid < 0) return;
    if (hipMemsetAsync((char*)d_ws + WS_CTL, 0, CTL_ZERO_BYTES, stream) != hipSuccess) return;
    Args a{};
    for (int i = 0; i < 19; ++i) a.in[i] = (const float*)d_in[i];
    a.out = (float*)d_out; a.ws = (unsigned char*)d_ws; a.ph_lo = 0; a.ph_hi = NPHASES;
    hipLaunchKernelGGL(fwd_kernel, dim3(grid), dim3(NTHREADS), LDS_BYTES, stream, a);
}
```

```cpp
#include <hip/hip_runtime.h>
#include <cstdio>
#include <cstdint>

#define GAS __attribute__((address_space(1)))
#define LAS __attribute__((address_space(3)))
typedef unsigned short bf16_t;
typedef short bf16x8 __attribute__((ext_vector_type(8)));
typedef short s16x4 __attribute__((ext_vector_type(4)));
typedef float f32x2 __attribute__((ext_vector_type(2)));
typedef float f32x4 __attribute__((ext_vector_type(4)));
typedef float f32x16 __attribute__((ext_vector_type(16)));
typedef unsigned u32x2 __attribute__((ext_vector_type(2)));
typedef unsigned u32x4 __attribute__((ext_vector_type(4)));
typedef __bf16 bf16x2_t __attribute__((ext_vector_type(2)));

constexpr int NWAVES = 8, NTHREADS = 512;
constexpr int D_MODEL = 2048, BATCH = 4, SEQ = 4096, MTOK = BATCH * SEQ, CTX = 256, MCTX = BATCH * CTX, MALL = MTOK + MCTX;
constexpr int FW = 1024, GDW = 1024, NH = 8, HD = 128, INC = 5152, INC_PAD = 5376;
constexpr int NE = 16, CAP = 512, FF = 1536;
constexpr float EPS = 1e-6f;

constexpr size_t MiB = 1u << 20;
constexpr size_t WS_CTL = 0, CTL_ZERO_BYTES = 1 * MiB;
constexpr size_t WS_MOD = 1 * MiB;
constexpr size_t WS_TW = WS_MOD + 256 * 1024;
constexpr size_t WS_DA = WS_TW + 32 * 1024;
constexpr size_t WS_DB = WS_DA + 16 * 1024;
constexpr size_t WS_DC = WS_DB + 32 * 1024;
constexpr size_t WS_WIN = 2 * MiB;
constexpr size_t WS_WOUT = WS_WIN + (size_t)INC_PAD * D_MODEL * 2;
constexpr size_t WS_WGU = WS_WOUT + (size_t)D_MODEL * D_MODEL * 2;
constexpr size_t WS_WDN = WS_WGU + (size_t)NE * 2 * FF * D_MODEL * 2;
constexpr size_t WS_PF = WS_WDN + (size_t)NE * D_MODEL * FF * 2;
constexpr size_t WS_PQKV = WS_PF + (size_t)MTOK * FW * 2;
constexpr size_t WS_PZ = WS_PQKV + (size_t)MALL * 3 * GDW * 2;
constexpr size_t WS_PAB = WS_PZ + (size_t)MTOK * GDW * 2;
constexpr size_t WS_G = WS_PAB + (size_t)MALL * 32 * 4;
constexpr size_t WS_HX2 = WS_G;
constexpr size_t WS_HID = WS_HX2 + (size_t)MTOK * D_MODEL * 2;
constexpr size_t WS_YB = WS_HID + (size_t)BATCH * NE * CAP * FF * 2;
constexpr size_t WS_AFF = WS_YB + (size_t)BATCH * NE * CAP * D_MODEL * 2;
constexpr size_t WS_IDX = WS_AFF + (size_t)BATCH * NE * SEQ * 4;
constexpr size_t WS_VAL = WS_IDX + (size_t)BATCH * NE * CAP * 4;
constexpr size_t WS_SLOT = WS_VAL + (size_t)BATCH * NE * CAP * 4;
constexpr size_t WS_A2 = WS_PF;
constexpr size_t WS_HXC = WS_G + (size_t)(BATCH * NH * 2 * 68) * 73984;
constexpr size_t WS_END = 800 * MiB;
static_assert(WS_HXC + (size_t)MCTX * D_MODEL * 2 <= WS_END, "ws map: HX context rows");
static_assert(WS_SLOT + (size_t)MTOK * NE * 4 <= WS_END, "ws map");


constexpr int RING_BYTES = 131072;
constexpr int TAB_OFF = RING_BYTES;
constexpr int MISC_OFF = TAB_OFF + 16384;
constexpr int LDS_BYTES = MISC_OFF + 256;

constexpr int CW_BAR = 4096;
constexpr int CW_Q0 = 8128, CW_Q1 = 8192, CW_Q2 = 8256;

__device__ __forceinline__ unsigned f2bf(float f) { unsigned u = __builtin_bit_cast(unsigned, f); return (u + 0x7fffu + ((u >> 16) & 1u)) >> 16; }
__device__ __forceinline__ float bf2f(unsigned h) { return __builtin_bit_cast(float, h << 16); }
__device__ __forceinline__ unsigned pk2(float lo, float hi) { f32x2 v = {lo, hi}; bf16x2_t b = __builtin_convertvector(v, bf16x2_t); return __builtin_bit_cast(unsigned, b); }
__device__ __forceinline__ float wave_sum(float v) {
#pragma unroll
    for (int o = 1; o < 64; o <<= 1) v += __shfl_xor(v, o);
    return v;
}
__device__ __forceinline__ float dpp_xor1(float v) { return __builtin_bit_cast(float, __builtin_amdgcn_mov_dpp(__builtin_bit_cast(int, v), 0xB1, 0xf, 0xf, true)); }
__device__ __forceinline__ float dpp_xor2(float v) { return __builtin_bit_cast(float, __builtin_amdgcn_mov_dpp(__builtin_bit_cast(int, v), 0x4E, 0xf, 0xf, true)); }
__device__ __forceinline__ float silu_f(float v) { return v * __builtin_amdgcn_rcpf(1.f + __expf(-v)); }
#define LDS_WAIT() asm volatile("s_waitcnt lgkmcnt(0)" ::: "memory")
#define LBAR() do { asm volatile("s_waitcnt lgkmcnt(0)" ::: "memory"); __builtin_amdgcn_s_barrier(); asm volatile("" ::: "memory"); } while (0)

#define XB_TMO      128
#define XB_XCNT(j)  (256  + 64 * (j))
#define XB_XSUB(j)  (1280 + 64 * (j))
#define XB_XGEN(j)  (2304 + 64 * (j))
#define XB_TOP      3328
#define XB_TOPGEN   3392
#define XCD_BAR_WORDS 3456
#define XB_SPIN_CAP (1u << 18)
__device__ __forceinline__ unsigned xb_ld(unsigned* p)              { return __hip_atomic_load(p, __ATOMIC_RELAXED, __HIP_MEMORY_SCOPE_AGENT); }
__device__ __forceinline__ unsigned xb_add(unsigned* p, unsigned v) { return __hip_atomic_fetch_add(p, v, __ATOMIC_RELAXED, __HIP_MEMORY_SCOPE_AGENT); }
__device__ __forceinline__ unsigned xb_xcc_id() { return (unsigned)__builtin_amdgcn_s_getreg((3 << 11) | 20) & 0xFu; }
#define XB_SPIN(cond, bar) do { unsigned _sp = 0; while (cond) { __builtin_amdgcn_s_sleep(1); \
    if ((++_sp & 255u) == 0u) { if (xb_ld(&(bar)[XB_TMO])) break; if (_sp > XB_SPIN_CAP) { atomicAdd(&(bar)[XB_TMO], 1u); break; } } } } while (0)
struct XcdBarrier { unsigned* bar; unsigned x; volatile LAS unsigned* st; };
__device__ __forceinline__ XcdBarrier xcd_barrier_post(unsigned* bar, volatile LAS unsigned* st) {
    XcdBarrier b; b.bar = bar; b.x = xb_xcc_id(); b.st = st;
    if (threadIdx.x == 0) (void)xb_add(&bar[XB_XCNT(b.x)], 1u);
    return b;
}
__device__ __forceinline__ void xcd_barrier_complete(unsigned* bar, unsigned x, unsigned& nloc, unsigned& nx) {
    const unsigned G = gridDim.x * gridDim.y * gridDim.z;
    unsigned sum, cnt, mine, sp = 0u;
    for (;;) {
        sum = 0u; cnt = 0u; mine = 0u;
#pragma unroll
        for (unsigned j = 0; j < 16; ++j) { const unsigned c = xb_ld(&bar[XB_XCNT(j)]); sum += c; cnt += (c > 0u) ? 1u : 0u; mine = (j == x) ? c : mine; }
        if (sum == G) break;
        __builtin_amdgcn_s_sleep(1);
        if ((++sp & 255u) == 0u) { if (xb_ld(&bar[XB_TMO])) break; if (sp > XB_SPIN_CAP) { atomicAdd(&bar[XB_TMO], 1u); break; } }
    }
    nloc = mine > 0u ? mine : 1u; nx = cnt > 0u ? cnt : 1u;
}
__device__ __forceinline__ void xcd_barrier(const XcdBarrier& b) {
    asm volatile("s_waitcnt vmcnt(0)" ::: "memory");
    __syncthreads();
    if (threadIdx.x == 0) {
        unsigned* bar = b.bar;
        __builtin_amdgcn_s_waitcnt(0);
        unsigned nloc = b.st[0], nx = b.st[1];
        if (nloc == 0u) { xcd_barrier_complete(bar, b.x, nloc, nx); b.st[0] = nloc; b.st[1] = nx; }
        const unsigned old = xb_add(&bar[XB_XSUB(b.x)], 1u);
        const unsigned gen = old / nloc;
        if (old + 1u == (gen + 1u) * nloc) {
            __builtin_amdgcn_fence(__ATOMIC_RELEASE, "agent");
            asm volatile("s_waitcnt vmcnt(0)" ::: "memory");
            const unsigned og = xb_add(&bar[XB_TOP], 1u);
            const unsigned tg = og / nx;
            if (og + 1u == (tg + 1u) * nx) xb_add(&bar[XB_TOPGEN], 1u);
            else XB_SPIN(xb_ld(&bar[XB_TOPGEN]) == tg, bar);
            __builtin_amdgcn_fence(__ATOMIC_ACQUIRE, "agent");
            xb_add(&bar[XB_XGEN(b.x)], 1u);
            asm volatile("s_waitcnt vmcnt(0)" ::: "memory");
        } else {
            XB_SPIN(xb_ld(&bar[XB_XGEN(b.x)]) == gen, bar);
            __builtin_amdgcn_fence(__ATOMIC_ACQUIRE, "agent");
            asm volatile("s_waitcnt vmcnt(0)" ::: "memory");
        }
    }
    __syncthreads();
}

namespace pg8 {
constexpr int BM = 256, BK = 64, HALF = 128, HTB = HALF * BK * 2, STAGE_BYTES = 8 * HTB, NXCD = 8, WGM = 8;
__host__ __device__ __forceinline__ int lds_byte(int r, int c) { const int st = (r >> 4) * 2 + (c >> 5), rr = r & 15, cc = c & 31, ob = rr * 64 + cc * 2; return st * 1024 + (ob ^ (((ob >> 9) & 1) << 5)); }
__host__ __device__ __forceinline__ void stage_rc(int b, int& R, int& C) { const int st = b / 1024, sb = b % 1024, swz = sb ^ (((sb >> 9) & 1) << 5); R = (st >> 1) * 16 + swz / 64; C = (st & 1) * 32 + (swz % 64) / 2; }
__host__ __device__ __forceinline__ int perm32(int rho) { const int n = rho >> 4, i = rho & 15; return 8 * (i >> 2) + 4 * n + (i & 3); }

struct Unit { const char* a; const char* b; const int* gidx; int pm, pn, aux; };

template <class Epi, class Sched, bool GATHER>
__device__ __forceinline__ void gemm_phase(LAS unsigned char* lds, LAS unsigned* tab, const int K, const Sched& S, const Epi& E) {
    int tid_ = threadIdx.x; asm volatile("" : "+v"(tid_));
    const int tid = tid_, wid = __builtin_amdgcn_readfirstlane(tid >> 6), lane = tid & 63, wr = wid >> 2, wc = wid & 3, fr = lane & 15, fq = lane >> 4;
    const int nt = K / BK;
    unsigned voffA[2], voffB[2];
#pragma unroll
    for (int i = 0; i < 2; ++i) { int R, C; stage_rc(tid * 16 + i * 8192, R, C); const int Rb = Epi::PERM ? ((R & ~31) + perm32(R & 31)) : R;
        voffA[i] = (unsigned)(R * K + C) * 2u; voffB[i] = (unsigned)(Rb * K + C) * 2u; }
    const size_t kstep = (size_t)(BK * 2);
    const size_t hstep = (size_t)HALF * K * 2;
    const unsigned ldsw = (unsigned)wid * 1024u;
    const int aoff = lds_byte(wr * 64 + fr, fq * 8), boff = lds_byte(wc * 32 + fr, fq * 8);
#define PG8_SA(b, h) (((b) * 2 + (h)) * HTB)
#define PG8_SB(b, h) ((4 + (b) * 2 + (h)) * HTB)
#define PG8_STAGE(bufoff, gbase, voff) do { _Pragma("unroll") for (int _i = 0; _i < 2; ++_i) \
        __builtin_amdgcn_global_load_lds((const unsigned*)((const char*)(gbase) + (voff)[_i]), (LAS unsigned*)(lds + (bufoff) + ldsw + _i * 8192), 16, 0, 0); } while (0)
#define PG8_STAGE_A(bufoff, gbase, par, h) do { if constexpr (GATHER) { _Pragma("unroll") for (int _i = 0; _i < 2; ++_i) { const unsigned _o = tab[(((par) * 2 + (h)) * 2 + _i) * 512 + tid]; \
            __builtin_amdgcn_global_load_lds((const unsigned*)((const char*)(gbase) + _o), (LAS unsigned*)(lds + (bufoff) + ldsw + _i * 8192), 16, 0, 0); } } \
        else { PG8_STAGE(bufoff, (gbase) + (h) * hstep, voffA); } } while (0)
#define PG8_LDA(dst, b, h) do { _Pragma("unroll") for (int m = 0; m < 4; ++m) _Pragma("unroll") for (int k = 0; k < 2; ++k) dst[m][k] = *(const LAS bf16x8*)(lds + PG8_SA(b, h) + aoff + m * 2048 + k * 1024); } while (0)
#define PG8_LDB(dst, b, h) do { _Pragma("unroll") for (int n = 0; n < 2; ++n) _Pragma("unroll") for (int k = 0; k < 2; ++k) dst[n][k] = *(const LAS bf16x8*)(lds + PG8_SB(b, h) + boff + n * 2048 + k * 1024); } while (0)
#define PG8_MMA(ai, bj, At, Bt) do { __builtin_amdgcn_s_setprio(1); _Pragma("unroll") for (int m = 0; m < 4; ++m) _Pragma("unroll") for (int n = 0; n < 2; ++n) _Pragma("unroll") for (int k = 0; k < 2; ++k) \
        acc[ai][bj][m][n] = __builtin_amdgcn_mfma_f32_16x16x32_bf16(Bt[n][k], At[m][k], acc[ai][bj][m][n], 0, 0, 0); __builtin_amdgcn_s_setprio(0); } while (0)
#define PG8_WAIT_V(n) asm volatile("s_waitcnt vmcnt(" #n ")" ::: "memory")
#define PG8_WAIT_L(n) asm volatile("s_waitcnt lgkmcnt(" #n ")" ::: "memory")
#define PG8_BAR __builtin_amdgcn_s_barrier()
#define PG8_SCHED __builtin_amdgcn_sched_barrier(0)
#define PG8_FILL(par, u) do { if constexpr (GATHER) { _Pragma("unroll") for (int _h = 0; _h < 2; ++_h) _Pragma("unroll") for (int _i = 0; _i < 2; ++_i) { int R_, C_; stage_rc(tid * 16 + _i * 8192, R_, C_); \
        const int row_ = (u).gidx[_h * HALF + R_]; tab[(((par) * 2 + _h) * 2 + _i) * 512 + tid] = (unsigned)(row_ * K + C_) * 2u; } } } while (0)
    Unit cur, nxt; int ui = 0; int par = 0;
    if (!S.next(0, cur)) return;
    f32x4 acc[2][2][4][2];
#pragma unroll
    for (int a = 0; a < 2; ++a)
#pragma unroll
        for (int b = 0; b < 2; ++b)
#pragma unroll
            for (int m = 0; m < 4; ++m)
#pragma unroll
                for (int n = 0; n < 2; ++n) acc[a][b][m][n] = (f32x4){0.f, 0.f, 0.f, 0.f};
    bf16x8 At[4][2], B0[2][2], B1[2][2];
    const char* cA = cur.a; const char* cB = cur.b;
    PG8_FILL(0, cur);
    PG8_STAGE(PG8_SB(0, 0), cB, voffB); PG8_STAGE(PG8_SB(0, 1), cB + hstep, voffB); PG8_STAGE_A(PG8_SA(0, 0), cA, 0, 0); PG8_STAGE_A(PG8_SA(0, 1), cA, 0, 1);
    if (wr == 1) PG8_BAR;
    PG8_WAIT_V(2); PG8_BAR;
    PG8_STAGE(PG8_SB(1, 0), cB + kstep, voffB); PG8_STAGE_A(PG8_SA(1, 0), cA + kstep, 0, 0); PG8_STAGE(PG8_SB(1, 1), cB + hstep + kstep, voffB);
    PG8_WAIT_V(6); PG8_BAR;
    for (;;) {
        const bool has_next = S.next(ui + 1, nxt);
        const char* nA = has_next ? nxt.a : cA; const char* nB = has_next ? nxt.b : cB;
        const int npar = has_next ? (par ^ 1) : par;
        for (int t = 0; t < nt; t += 2) {
            const bool last = (t == nt - 2);
            const char* a1 = cA + (size_t)(t + 1) * kstep;
            const char* a2 = last ? nA : cA + (size_t)(t + 2) * kstep; const char* b2 = last ? nB : cB + (size_t)(t + 2) * kstep;
            const char* a3 = a2 + kstep; const char* b3 = b2 + kstep;
            const int p2 = last ? npar : par;
            if (last && has_next) PG8_FILL(npar, nxt);
            PG8_LDB(B0, 0, 0); PG8_LDB(B1, 0, 1); PG8_SCHED; PG8_LDA(At, 0, 0); PG8_STAGE_A(PG8_SA(1, 1), a1, par, 1);
            PG8_WAIT_V(8); PG8_WAIT_L(0); PG8_BAR; PG8_MMA(0, 0, At, B0); PG8_MMA(0, 1, At, B1); PG8_BAR; PG8_SCHED;
            PG8_LDA(At, 0, 1); PG8_STAGE(PG8_SB(0, 0), b2, voffB); PG8_STAGE(PG8_SB(0, 1), b2 + hstep, voffB); PG8_STAGE_A(PG8_SA(0, 0), a2, p2, 0);
            PG8_WAIT_V(8); PG8_WAIT_L(0); PG8_BAR; PG8_MMA(1, 0, At, B0); PG8_MMA(1, 1, At, B1); PG8_BAR; PG8_SCHED;
            PG8_LDB(B0, 1, 0); PG8_LDB(B1, 1, 1); PG8_SCHED; PG8_LDA(At, 1, 0); PG8_STAGE_A(PG8_SA(0, 1), a2, p2, 1);
            PG8_WAIT_V(8); PG8_WAIT_L(0); PG8_BAR; PG8_MMA(0, 0, At, B0); PG8_MMA(0, 1, At, B1); PG8_BAR; PG8_SCHED;
            PG8_LDA(At, 1, 1); PG8_STAGE(PG8_SB(1, 0), b3, voffB); PG8_STAGE(PG8_SB(1, 1), b3 + hstep, voffB); PG8_STAGE_A(PG8_SA(1, 0), a3, p2, 0);
            PG8_WAIT_V(8); PG8_WAIT_L(0); PG8_BAR; PG8_MMA(1, 0, At, B0); PG8_MMA(1, 1, At, B1); PG8_BAR; PG8_SCHED;
        }
        if (wr == 0) PG8_BAR;
        E(acc, cur, wr, wc, fr, fq);
        if (!has_next) break;
#pragma unroll
        for (int a = 0; a < 2; ++a)
#pragma unroll
            for (int b = 0; b < 2; ++b)
#pragma unroll
                for (int m = 0; m < 4; ++m)
#pragma unroll
                    for (int n = 0; n < 2; ++n) acc[a][b][m][n] = (f32x4){0.f, 0.f, 0.f, 0.f};
        cur = nxt; cA = nA; cB = nB; par = npar; ++ui;
        if (wr == 1) PG8_BAR;
    }
    PG8_WAIT_V(0);
    PG8_BAR;
#undef PG8_SA
#undef PG8_SB
#undef PG8_STAGE
#undef PG8_STAGE_A
#undef PG8_LDA
#undef PG8_LDB
#undef PG8_MMA
#undef PG8_WAIT_V
#undef PG8_WAIT_L
#undef PG8_BAR
#undef PG8_SCHED
#undef PG8_FILL
}
}

__device__ __forceinline__ bf16x8 frag_row(const LAS bf16_t* base, int ld, int r0, int k0, int lane) {
    return *(const LAS bf16x8*)(base + (r0 + (lane & 31)) * ld + k0 + 8 * (lane >> 5));
}
__device__ __forceinline__ bf16x8 frag_tr(const LAS bf16_t* base, int ld, int r0, int k0, int lane) {
    const int h = lane >> 5, blk = (lane >> 4) & 1, q = (lane & 15) >> 2, p = lane & 3;
    const LAS bf16_t* a0 = base + (k0 + 8 * h + q) * ld + r0 + 16 * blk + 4 * p;
    const s16x4 lo = __builtin_bit_cast(s16x4, __builtin_amdgcn_ds_read_tr16_b64_v4i16((LAS s16x4*)a0));
    const s16x4 hi = __builtin_bit_cast(s16x4, __builtin_amdgcn_ds_read_tr16_b64_v4i16((LAS s16x4*)(a0 + 4 * ld)));
    return (bf16x8){lo[0], lo[1], lo[2], lo[3], hi[0], hi[1], hi[2], hi[3]};
}
__device__ __forceinline__ int crow(int r, int lane) { return (r & 3) + 8 * (r >> 2) + 4 * (lane >> 5); }
#define MFMA32(a, b, c) __builtin_amdgcn_mfma_f32_32x32x16_bf16((a), (b), (c), 0, 0, 0)
constexpr f32x16 Z16 = {0.f, 0.f, 0.f, 0.f, 0.f, 0.f, 0.f, 0.f, 0.f, 0.f, 0.f, 0.f, 0.f, 0.f, 0.f, 0.f};


constexpr int CVT_BLOCK_ITEMS = 3 * 3072;
struct CvtJob { f32x4 v[8]; int item; };
__device__ __forceinline__ void cvt_issue(CvtJob& c, int item, int lane, const float* wg, const float* wu, const float* wd) {
    c.item = item;
    if (item < 0) return;
    const int kc = lane & 7, ng = lane >> 3; const int bi = item >> 3, sub = item & 7;
    const float* src; int ldn, k0, n0;
    if (bi < 6144) { const int up = bi >= 3072, r0 = bi - up * 3072, e = r0 / 192, r = r0 % 192; src = (up ? wu : wg) + (size_t)e * D_MODEL * FF; ldn = FF; k0 = 64 * (r / 6); n0 = 256 * (r % 6) + 32 * sub; }
    else { const int r0 = bi - 6144, e = r0 / 192, r = r0 % 192; src = wd + (size_t)e * FF * D_MODEL; ldn = D_MODEL; k0 = 64 * (r / 8); n0 = 256 * (r % 8) + 32 * sub; }
    const float* p = src + (size_t)(k0 + 8 * kc) * ldn + n0 + 4 * ng;
#pragma unroll
    for (int i = 0; i < 8; ++i) c.v[i] = *(const GAS f32x4*)(p + (size_t)i * ldn);
}
__device__ __forceinline__ void cvt_finish(const CvtJob& c, int lane, bf16_t* WGU, bf16_t* WDN) {
    const int item = c.item;
    if (item < 0) return;
    const int kc = lane & 7, ng = lane >> 3; const int bi = item >> 3, sub = item & 7;
    bf16_t* dst; int dstK, k0, n0, mode;
    if (bi < 6144) { const int up = bi >= 3072, r0 = bi - up * 3072, e = r0 / 192, r = r0 % 192; dst = WGU + (size_t)e * 2 * FF * D_MODEL; dstK = D_MODEL; k0 = 64 * (r / 6); n0 = 256 * (r % 6) + 32 * sub; mode = 1 + up; }
    else { const int r0 = bi - 6144, e = r0 / 192, r = r0 % 192; dst = WDN + (size_t)e * D_MODEL * FF; dstK = FF; k0 = 64 * (r / 8); n0 = 256 * (r % 8) + 32 * sub; mode = 0; }
    const int n = n0 + 4 * ng;
    const int row0 = mode == 0 ? n : (256 * (n >> 7) + 128 * (mode - 1) + (n & 127));
    bf16_t* o = dst + (size_t)row0 * dstK + k0 + 8 * kc;
#pragma unroll
    for (int j = 0; j < 4; ++j) { u32x4 w; w.x = pk2(c.v[0][j], c.v[1][j]); w.y = pk2(c.v[2][j], c.v[3][j]); w.z = pk2(c.v[4][j], c.v[5][j]); w.w = pk2(c.v[6][j], c.v[7][j]);
        *(GAS u32x4*)(o + (size_t)j * dstK) = w; }
}
struct CvtShadow { int base, left; };
__device__ __forceinline__ int cvt_next(CvtShadow& cs, unsigned* q, int lane) {
    if (cs.left == 0) { if (cs.base == -2) return -1; unsigned v = 0; if (lane == 0) v = atomicAdd(q, 1u); const int b = (int)__builtin_amdgcn_readfirstlane(v);
        if (b >= CVT_BLOCK_ITEMS) { cs.base = -2; return -1; } cs.base = b * 8; cs.left = 8; }
    const int it = cs.base + (8 - cs.left); --cs.left; return it;
}
constexpr int REC_W = 0, REC_UT = 16384, REC_QD = 32768, REC_KDT = 49152, REC_QK = 65536, REC_GT = 73728, REC_BYTES = 73984;
constexpr int NREC_X = BATCH * NH * 2 * 64, NREC = NREC_X + BATCH * NH * 2 * 4;
__device__ __forceinline__ size_t rec_index(bool isctx, int b, int h, int d, int c) { return isctx ? (size_t)(NREC_X + ((b * NH + h) * 2 + d) * 4 + c) : (size_t)(((b * NH + h) * 2 + d) * 64 + c); }
__device__ __forceinline__ float softplus_f(float v) { return v > 20.f ? v : log1pf(__expf(v)); }

struct GdnItem { bool isctx; int b, h, c, rowbase, vlo, vhi; };
__device__ __forceinline__ GdnItem gdn_decode(int item) {
    GdnItem I;
    if (item < BATCH * NH * 64) { I.isctx = false; I.b = item >> 9; I.h = (item >> 6) & 7; I.c = item & 63; I.rowbase = I.b * SEQ + I.c * 64; I.vlo = 0; I.vhi = 64; }
    else { const int j = item - BATCH * NH * 64; I.isctx = true; I.b = j >> 5; I.h = (j >> 2) & 7; I.c = j & 3; I.rowbase = MTOK + I.b * CTX + I.c * 64; I.vlo = -I.c * 64; I.vhi = CTX - I.c * 64; }
    return I;
}
struct GdnPre { u32x4 raw[7]; f32x4 cw; float ga, gb; };
__device__ __forceinline__ void gdn_prefetch(GdnPre& P, const GdnItem& I, int tid, int lane, int wave, const bf16_t* PQKV, const float* PAB, const float* convw) {
#pragma unroll
    for (int e = 0; e < 7; ++e) { const int idx = tid + 512 * e; u32x4 v = {0u, 0u, 0u, 0u};
        if (idx < 3 * 68 * 16) { const int ch = idx & 15, rr = (idx >> 4) % 68, t = (idx >> 4) / 68; const int rel = rr - 2;
            if (rel >= I.vlo && rel < I.vhi) v = *(const GAS u32x4*)(PQKV + (size_t)(I.rowbase + rel) * (3 * GDW) + t * GDW + I.h * HD + ch * 8); }
        P.raw[e] = v; }
    if (tid < 480) { const int t = tid / 160, j = (tid % 160) >> 5, c4 = tid & 31; P.cw = *(const GAS f32x4*)(convw + j * (3 * GDW) + t * GDW + I.h * HD + c4 * 4); }
    if (wave < 2) { const int d = wave; const int i = d ? 63 - lane : lane; const int m = I.rowbase + i; P.ga = PAB[(size_t)m * 32 + d * 8 + I.h]; P.gb = PAB[(size_t)m * 32 + 16 + d * 8 + I.h]; }
}

__device__ __forceinline__ void gdn_chunk_items(LAS unsigned char* L, int first, int stride, const bf16_t* PQKV, const float* PAB, const float* convw, const float* a_log, const float* dt_bias, unsigned char* GREC,
                                                unsigned* cvq, const float* wg, const float* wu, const float* wd, bf16_t* WGU, bf16_t* WDN) {
    const int tid_f_ = threadIdx.x, wave = __builtin_amdgcn_readfirstlane(tid_f_ >> 6);
    constexpr int LD = 136, LDT_ = 72, NITEMS = BATCH * NH * 64 + BATCH * NH * 4;
    LAS bf16_t* QN = (LAS bf16_t*)L; LAS bf16_t* KN = (LAS bf16_t*)(L + 17408); LAS bf16_t* VI = (LAS bf16_t*)(L + 34816);
    LAS bf16_t* RAW = (LAS bf16_t*)(L + 52224);
    LAS bf16_t* TB = (LAS bf16_t*)(L + 52224); LAS bf16_t* TBG = (LAS bf16_t*)(L + 70656);
    LAS float* MPD = (LAS float*)(L + 89088);
    LAS bf16_t* MB = (LAS bf16_t*)(L + 97280);
    LAS bf16_t* TI = (LAS bf16_t*)(L + 52224);
    LAS bf16_t* PI = (LAS bf16_t*)(L + 70656);
    LAS float* GC = (LAS float*)(L + 122880); LAS float* BETA = GC + 128; LAS float* EGC = GC + 256; LAS float* EKD = GC + 384; LAS float* GTOT = (LAS float*)(L + 115712);
    LAS float* CW = (LAS float*)(L + 124928);
    LAS bf16_t* QKB = (LAS bf16_t*)(L + 124928);
    if (first >= NITEMS) return;
    CvtShadow cs; cs.base = -1; cs.left = 0; CvtJob cj; cj.item = -1;
#ifndef CVT_SHADOW
#define CVT_SHADOW 0
#endif
#if CVT_SHADOW
#define CVT_HOOK_ISSUE() cvt_issue(cj, cvt_next(cs, cvq, lane), lane, wg, wu, wd)
#define CVT_HOOK_FINISH() cvt_finish(cj, lane, WGU, WDN)
#else
#define CVT_HOOK_ISSUE() do { } while (0)
#define CVT_HOOK_FINISH() do { } while (0)
#endif
    GdnPre P;
    { int t0_ = tid_f_; asm volatile("" : "+v"(t0_)); const GdnItem I0 = gdn_decode(first); gdn_prefetch(P, I0, t0_, t0_ & 63, wave, PQKV, PAB, convw); }
#pragma unroll 1
    for (int item = first; item < NITEMS; item += stride) {
        int tid_o_ = tid_f_; asm volatile("" : "+v"(tid_o_)); const int tid = tid_o_, lane = tid & 63;
        const GdnItem I = gdn_decode(item);
        const bool isctx = I.isctx; const int b = I.b, h = I.h, c = I.c;
#pragma unroll
        for (int e = 0; e < 7; ++e) { const int idx = tid + 512 * e; if (idx < 3 * 68 * 16) { const int ch = idx & 15, rr = (idx >> 4) % 68, t = (idx >> 4) / 68; *(LAS u32x4*)(RAW + (t * 68 + rr) * LD + ch * 8) = P.raw[e]; } }
        if (tid < 480) { const int t = tid / 160, j = (tid % 160) >> 5, c4 = tid & 31; *(LAS f32x4*)(CW + (t * 5 + j) * 128 + c4 * 4) = P.cw; }
        if (wave < 2) { const int d = wave; const int i = d ? 63 - lane : lane;
            const float g = -__expf(a_log[d * 8 + h]) * softplus_f(P.ga + dt_bias[d * 8 + h]);
            float s = g;
#pragma unroll
            for (int o = 1; o < 64; o <<= 1) { const float t = __shfl_up(s, o); if (lane >= o) s += t; }
            const float gt_ = __shfl(s, 63);
            GC[d * 64 + i] = s; EGC[d * 64 + i] = __expf(s); EKD[d * 64 + i] = __expf(gt_ - s); BETA[d * 64 + i] = __builtin_amdgcn_rcpf(1.f + __expf(-P.gb));
            if (lane == 63) GTOT[d] = s; }
        LBAR();
        { const int nxt = item + stride; if (nxt < NITEMS) { const GdnItem In = gdn_decode(nxt); gdn_prefetch(P, In, tid, lane, wave, PQKV, PAB, convw); } }
#ifndef REPG
#define REPG 0
#endif
#define GS(k) for (int gq_ = 0; gq_ <= ((REPG >> (k)) & 1); ++gq_)
        GS(1) {
        CVT_HOOK_ISSUE();
        { int tt = tid; asm volatile("" : "+v"(tt)); const int cgp = tt & 31, tg = tt >> 5;
#pragma unroll
            for (int t = 0; t < 3; ++t) {
                f32x4 w[5];
#pragma unroll
                for (int j = 0; j < 5; ++j) w[j] = *(const LAS f32x4*)(CW + (t * 5 + j) * 128 + 4 * cgp);
                f32x4 x[8];
#pragma unroll
                for (int rr = 0; rr < 8; ++rr) { const u32x2 q = *(const LAS u32x2*)(RAW + (t * 68 + 4 * tg + rr) * LD + 4 * cgp); x[rr] = (f32x4){bf2f(q.x & 0xffffu), bf2f(q.x >> 16), bf2f(q.y & 0xffffu), bf2f(q.y >> 16)}; }
                f32x4 y[4]; float ss[4];
#pragma unroll
                for (int k = 0; k < 4; ++k) { f32x4 acc = w[0] * x[k];
#pragma unroll
                    for (int j = 1; j < 5; ++j) acc += w[j] * x[k + j];
                    acc.x = silu_f(acc.x); acc.y = silu_f(acc.y); acc.z = silu_f(acc.z); acc.w = silu_f(acc.w);
                    y[k] = acc; ss[k] = (acc.x * acc.x + acc.y * acc.y) + (acc.z * acc.z + acc.w * acc.w); }
                if (t < 2) {
#pragma unroll
                    for (int k = 0; k < 4; ++k) { float v = ss[k]; v += dpp_xor1(v); v += dpp_xor2(v); v += __shfl_xor(v, 4); v += __shfl_xor(v, 8); v += __shfl_xor(v, 16);
                        float sc = __builtin_amdgcn_rsqf(v + EPS); if (t == 0) sc *= 0.08838834764831845f; y[k] = y[k] * sc; } }
                LAS bf16_t* dst = (t == 0 ? QN : (t == 1 ? KN : VI)) + (4 * tg) * LD + 4 * cgp;
#pragma unroll
                for (int k = 0; k < 4; ++k) { u32x2 o; o.x = pk2(y[k].x, y[k].y); o.y = pk2(y[k].z, y[k].w); *(LAS u32x2*)(dst + k * LD) = o; }
            }
        }
        CVT_HOOK_FINISH();
        LBAR();
        }
        GS(2) {
        { const int which = wave >> 2, ti = (wave >> 1) & 1, tj = wave & 1; f32x16 acc = Z16;
            { bf16x8 fa[8], fb[8];
#pragma unroll
                for (int ks = 0; ks < 8; ++ks) { fa[ks] = frag_row(which ? QN : KN, LD, 32 * ti, 16 * ks, lane); fb[ks] = frag_row(KN, LD, 32 * tj, 16 * ks, lane); }
                __builtin_amdgcn_sched_barrier(0);
#pragma unroll
                for (int ks = 0; ks < 8; ++ks) acc = MFMA32(fa[ks], fb[ks], acc); }
            const int j = 32 * tj + (lane & 31); const float g0j = GC[j], g1j = GC[64 + j];
#pragma unroll
            for (int g4 = 0; g4 < 4; ++g4) { const int i0 = 32 * ti + 8 * g4 + 4 * (lane >> 5);
                const f32x4 g0i = *(const LAS f32x4*)(GC + i0), g1i = *(const LAS f32x4*)(GC + 64 + i0), b0i = *(const LAS f32x4*)(BETA + i0), b1i = *(const LAS f32x4*)(BETA + 64 + i0);
#pragma unroll
                for (int e = 0; e < 4; ++e) { const int i = i0 + e; const float a_ = acc[4 * g4 + e];
                    const bool lo = j < i, hi = j > i;
                    const float ex = __expf(lo ? (g0i[e] - g0j) : (hi ? (g1i[e] - g1j) : 0.f));
                    if (which == 0) { const float v = a_ * ex * (lo ? b0i[e] : b1i[e]); const float v0 = lo ? v : 0.f, v1 = hi ? v : 0.f; const int il = 63 - i, jl = 63 - j;
                        MB[(0 * 64 + i) * LDT_ + j] = (bf16_t)f2bf(v0); MB[(1 * 64 + il) * LDT_ + jl] = (bf16_t)f2bf(v1);
                        if ((i >> 4) == (j >> 4)) { MPD[((0 * 4 + (i >> 4)) * 16 + (i & 15)) * 16 + (j & 3) * 4 + ((j & 15) >> 2)] = v0; MPD[((1 * 4 + (il >> 4)) * 16 + (il & 15)) * 16 + (jl & 3) * 4 + ((jl & 15) >> 2)] = v1; } }
                    else { const float v = a_ * ex; QKB[(0 * 64 + i) * LDT_ + j] = (bf16_t)f2bf(hi ? 0.f : v); QKB[(1 * 64 + i) * LDT_ + j] = (bf16_t)f2bf(lo ? 0.f : v); } } }
        }
        LBAR();
        }
        GS(3) {
        CVT_HOOK_ISSUE();
        { const int d = wave >> 2, a_ = wave & 3; const int c = lane >> 2, r = lane & 3; float T[4] = {0.f, 0.f, 0.f, 0.f};
            LAS bf16_t* TId = TI + d * 64 * LDT_;
            { LAS unsigned* z = (LAS unsigned*)(TId + 16 * a_ * LDT_);
#pragma unroll
                for (int e = 0; e < 9; ++e) z[lane + 64 * e] = 0u; }
            const LAS float* mp = MPD + ((d * 4 + a_) * 16) * 16 + r * 4;
            f32x4 md[16];
#pragma unroll
            for (int rr = 0; rr < 16; ++rr) md[rr] = *(const LAS f32x4*)(mp + rr * 16);
#pragma unroll
            for (int rr = 0; rr < 16; ++rr) { float acc = (md[rr].x * T[0] + md[rr].y * T[1]) + (md[rr].z * T[2] + md[rr].w * T[3]);
                acc += dpp_xor1(acc); acc += dpp_xor2(acc);
                const float t = (rr == c ? 1.f : 0.f) - acc;
                if (r == (rr & 3)) T[rr >> 2] = t; }
            LDS_WAIT();
#pragma unroll
            for (int q = 0; q < 4; ++q) TId[(16 * a_ + 4 * q + r) * LDT_ + 16 * a_ + c] = (bf16_t)f2bf(T[q]);
        }
        LBAR();
        { const int d = wave >> 2, hsel = wave & 3; LAS bf16_t* TId = TI + d * 64 * LDT_; LAS bf16_t* PId = PI + d * 64 * LDT_; const LAS bf16_t* MBd = MB + d * 64 * LDT_;
            if (hsel < 2) { const int o = 32 * hsel;
                f32x16 p = Z16;
#pragma unroll
                for (int ks = 0; ks < 2; ++ks) p = MFMA32(frag_row(MBd, LDT_, o, o + 16 * ks, lane), frag_tr(TId, LDT_, o, o + 16 * ks, lane), p);
#pragma unroll
                for (int rg = 0; rg < 16; ++rg) PId[(o + crow(rg, lane)) * LDT_ + o + (lane & 31)] = (bf16_t)f2bf(p[rg]);
                LDS_WAIT();
                f32x16 q = Z16;
#pragma unroll
                for (int ks = 0; ks < 2; ++ks) q = MFMA32(frag_row(TId, LDT_, o, o + 16 * ks, lane), frag_tr(PId, LDT_, o, o + 16 * ks, lane), q);
                if ((lane & 31) < 16) {
#pragma unroll
                    for (int rg = 8; rg < 16; ++rg) TId[(o + crow(rg, lane)) * LDT_ + o + (lane & 31)] = (bf16_t)f2bf(-q[rg]); } }
        }
        LBAR();
        { const int d = wave >> 2, hsel = wave & 3; LAS bf16_t* TId = TI + d * 64 * LDT_; LAS bf16_t* PId = PI + d * 64 * LDT_; const LAS bf16_t* MBd = MB + d * 64 * LDT_;
            if (hsel == 0) {
                f32x16 p = Z16;
#pragma unroll
                for (int ks = 0; ks < 2; ++ks) p = MFMA32(frag_row(MBd, LDT_, 32, 16 * ks, lane), frag_tr(TId, LDT_, 0, 16 * ks, lane), p);
#pragma unroll
                for (int rg = 0; rg < 16; ++rg) PId[(32 + crow(rg, lane)) * LDT_ + (lane & 31)] = (bf16_t)f2bf(p[rg]);
                LDS_WAIT();
                f32x16 q = Z16;
#pragma unroll
                for (int ks = 0; ks < 2; ++ks) q = MFMA32(frag_row(TId, LDT_, 32, 32 + 16 * ks, lane), frag_tr(PId, LDT_, 0, 32 + 16 * ks, lane), q);
#pragma unroll
                for (int rg = 0; rg < 16; ++rg) TId[(32 + crow(rg, lane)) * LDT_ + (lane & 31)] = (bf16_t)f2bf(-q[rg]); }
        }
        LBAR();
        { int tt = tid; asm volatile("" : "+v"(tt)); const int d = tt >> 8, t2 = tt & 255;
            if (d == 0) {
#pragma unroll
                for (int e = 0; e < 16; ++e) { const int idx = t2 + 256 * e, i = idx >> 6, j = idx & 63; const float t = bf2f(TI[i * LDT_ + j]); const float bj = BETA[j];
                    TB[i * LDT_ + j] = (bf16_t)f2bf(t * bj); TBG[i * LDT_ + j] = (bf16_t)f2bf(t * bj * EGC[j]); } }
            else {
#pragma unroll
                for (int e = 0; e < 8; ++e) { const int idx = t2 + 256 * e, p = idx >> 6, q = idx & 63, p2 = 63 - p, q2 = 63 - q;
                    const float ta = bf2f(TI[(64 + p) * LDT_ + q]), tb = bf2f(TI[(64 + p2) * LDT_ + q2]); const float b1 = BETA[64 + q], b2 = BETA[64 + q2];
                    TB[(64 + p) * LDT_ + q] = (bf16_t)f2bf(tb * b1); TB[(64 + p2) * LDT_ + q2] = (bf16_t)f2bf(ta * b2);
                    TBG[(64 + p) * LDT_ + q] = (bf16_t)f2bf(tb * b1 * EGC[64 + q]); TBG[(64 + p2) * LDT_ + q2] = (bf16_t)f2bf(ta * b2 * EGC[64 + q2]); } }
        }
        CVT_HOOK_FINISH();
        LBAR();
        }
        GS(4) {
        CVT_HOOK_ISSUE();
        { const int d = wave >> 2, wq = wave & 3; unsigned char* rec = GREC + rec_index(isctx, b, h, d, c) * REC_BYTES;
            bf16_t* uT = (bf16_t*)(rec + REC_UT); bf16_t* wout = (bf16_t*)(rec + REC_W);
#pragma unroll
            for (int it = 0; it < 2; ++it) { f32x16 au = Z16, aw = Z16;
                { bf16x8 f1[4], f2[4], f3[4], f4[4];
#pragma unroll
                    for (int ks = 0; ks < 4; ++ks) { f1[ks] = frag_row(TB + d * 64 * LDT_, LDT_, 32 * it, 16 * ks, lane); f2[ks] = frag_tr(VI, LD, 32 * wq, 16 * ks, lane);
                        f3[ks] = frag_tr(KN, LD, 32 * wq, 16 * ks, lane); f4[ks] = frag_row(TBG + d * 64 * LDT_, LDT_, 32 * it, 16 * ks, lane); }
                    __builtin_amdgcn_sched_barrier(0);
#pragma unroll
                    for (int ks = 0; ks < 4; ++ks) { au = MFMA32(f1[ks], f2[ks], au); aw = MFMA32(f3[ks], f4[ks], aw); } }
#pragma unroll
                for (int g4 = 0; g4 < 4; ++g4) { u32x2 pu, pw; pu.x = pk2(au[4 * g4], au[4 * g4 + 1]); pu.y = pk2(au[4 * g4 + 2], au[4 * g4 + 3]); pw.x = pk2(aw[4 * g4], aw[4 * g4 + 1]); pw.y = pk2(aw[4 * g4 + 2], aw[4 * g4 + 3]);
                    *(GAS u32x2*)(uT + (32 * wq + (lane & 31)) * 64 + 32 * it + 8 * g4 + 4 * (lane >> 5)) = pu;
                    *(GAS u32x2*)(wout + (32 * it + (lane & 31)) * 128 + 32 * wq + 8 * g4 + 4 * (lane >> 5)) = pw; } }
        }
        { int tt = tid; asm volatile("" : "+v"(tt)); const int d = tt >> 8, t2 = tt & 255; unsigned char* rec = GREC + rec_index(isctx, b, h, d, c) * REC_BYTES; const float gtot = GTOT[d];
#pragma unroll
            for (int e = 0; e < 4; ++e) { const int idx = t2 + 256 * e, i = idx >> 4, ch = idx & 15; const float sc = EGC[d * 64 + i];
                const u32x4 v = *(const LAS u32x4*)(QN + i * LD + ch * 8); const unsigned rw[4] = {v.x, v.y, v.z, v.w}; u32x4 o; unsigned ow[4];
#pragma unroll
                for (int q = 0; q < 4; ++q) ow[q] = pk2(bf2f(rw[q] & 0xffffu) * sc, bf2f(rw[q] >> 16) * sc);
                o.x = ow[0]; o.y = ow[1]; o.z = ow[2]; o.w = ow[3];
                *(GAS u32x4*)(rec + REC_QD + (i * 128 + ch * 8) * 2) = o; }
#pragma unroll
            for (int e = 0; e < 4; ++e) { const int idx = t2 + 256 * e, k = idx >> 3, ci = idx & 7; float o[8];
#pragma unroll
                for (int q = 0; q < 8; ++q) { const int i = 8 * ci + q; o[q] = bf2f(KN[i * LD + k]) * EKD[d * 64 + i]; }
                u32x4 w; w.x = pk2(o[0], o[1]); w.y = pk2(o[2], o[3]); w.z = pk2(o[4], o[5]); w.w = pk2(o[6], o[7]);
                *(GAS u32x4*)(rec + REC_KDT + (k * 64 + 8 * ci) * 2) = w; }
#pragma unroll
            for (int e = 0; e < 2; ++e) { const int idx = t2 + 256 * e, i = idx >> 3, cj = idx & 7;
                *(GAS u32x4*)(rec + REC_QK + (i * 64 + 8 * cj) * 2) = *(const LAS u32x4*)(QKB + (d * 64 + i) * LDT_ + 8 * cj); }
            if (t2 == 0) *(float*)(rec + REC_GT) = __expf(gtot);
        }
        CVT_HOOK_FINISH();
        LBAR();
        }
    }
    while (cs.left > 0) { cvt_issue(cj, cvt_next(cs, cvq, tid_f_ & 63), tid_f_ & 63, wg, wu, wd); cvt_finish(cj, tid_f_ & 63, WGU, WDN); }
#undef CVT_HOOK_ISSUE
#undef CVT_HOOK_FINISH
}

__device__ __forceinline__ void gdn_scan_half(LAS unsigned char* L, int unit, int vh, const unsigned char* GREC, bf16_t* OF, bf16_t* OB) {
    int tid_o_ = threadIdx.x; asm volatile("" : "+v"(tid_o_)); const int tid = tid_o_, lane = tid & 63, wave = __builtin_amdgcn_readfirstlane(tid >> 6);
    constexpr int LD = 136, LDS_ = 72;
    LAS bf16_t* ST = (LAS bf16_t*)L;
    LAS bf16_t* Wl = (LAS bf16_t*)(L + 17408);
    LAS bf16_t* QDl = (LAS bf16_t*)(L + 34816);
    LAS bf16_t* KDTl = (LAS bf16_t*)(L + 52224);
    LAS bf16_t* QKl = (LAS bf16_t*)(L + 70656);
    LAS bf16_t* VNT = (LAS bf16_t*)(L + 79872);
    const int b = unit >> 4, h = (unit >> 1) & 7, d = unit & 1, vb = 64 * vh;
    bf16_t* O = d ? OB : OF;
    for (int i = tid; i < 64 * LD / 8; i += NTHREADS) *(LAS u32x4*)(ST + i * 8) = (u32x4){0u, 0u, 0u, 0u};
    f32x16 S0 = Z16;
    const int kt = wave >> 1, vtl = wave & 1;
    const int w4 = wave & 3, it4 = (w4 >> 1) & 1, vt4 = w4 & 1;
    struct ScanOps { u32x4 rg[7]; u32x2 u[4]; float gt; };
    auto rec_of = [&](int s) -> const unsigned char* { const bool isctx = s < 4; const int cs = isctx ? s : s - 4; const int c = isctx ? (d ? 3 - cs : cs) : (d ? 63 - cs : cs);
        return GREC + rec_index(isctx, b, h, d, c) * REC_BYTES; };
    auto load_ops = [&](ScanOps& o, int s) { const unsigned char* rec = rec_of(s); const bool withq = s >= 4;
#pragma unroll
        for (int e = 0; e < 2; ++e) { const int idx = tid + 512 * e; o.rg[e] = __builtin_nontemporal_load((const GAS u32x4*)(rec + REC_W + idx * 16)); o.rg[4 + e] = __builtin_nontemporal_load((const GAS u32x4*)(rec + REC_KDT + idx * 16)); }
        if (withq) {
#pragma unroll
            for (int e = 0; e < 2; ++e) { const int idx = tid + 512 * e; o.rg[2 + e] = __builtin_nontemporal_load((const GAS u32x4*)(rec + REC_QD + idx * 16)); }
            o.rg[6] = __builtin_nontemporal_load((const GAS u32x4*)(rec + REC_QK + tid * 16)); }
        if (wave < 4) { const bf16_t* uT = (const bf16_t*)(rec + REC_UT) + (vb + 32 * vt4 + (lane & 31)) * 64 + 32 * it4 + 4 * (lane >> 5);
#pragma unroll
            for (int g4 = 0; g4 < 4; ++g4) o.u[g4] = *(const GAS u32x2*)(uT + 8 * g4); }
        o.gt = *(const float*)(rec + REC_GT);
    };
    auto step = [&](ScanOps& o, int s) {
        const bool isctx = s < 4;
#pragma unroll
        for (int e = 0; e < 2; ++e) { const int idx = tid + 512 * e; *(LAS u32x4*)(Wl + (idx >> 4) * LD + (idx & 15) * 8) = o.rg[e]; *(LAS u32x4*)(KDTl + (idx >> 3) * LDS_ + (idx & 7) * 8) = o.rg[4 + e]; }
        if (!isctx) {
#pragma unroll
            for (int e = 0; e < 2; ++e) { const int idx = tid + 512 * e; *(LAS u32x4*)(QDl + (idx >> 4) * LD + (idx & 15) * 8) = o.rg[2 + e]; }
            *(LAS u32x4*)(QKl + (tid >> 3) * LDS_ + (tid & 7) * 8) = o.rg[6]; }
        const float gt = o.gt; u32x2 uc[4];
#pragma unroll
        for (int g4 = 0; g4 < 4; ++g4) uc[g4] = o.u[g4];
        LBAR();
        if (s + 2 < 68) load_ops(o, s + 2);
        if (wave < 4) { bf16x8 fw[8], fs[8];
#pragma unroll
            for (int ks = 0; ks < 8; ++ks) { fw[ks] = frag_row(Wl, LD, 32 * it4, 16 * ks, lane); fs[ks] = frag_row(ST, LD, 32 * vt4, 16 * ks, lane); }
            __builtin_amdgcn_sched_barrier(0);
            f32x16 acc = Z16;
#pragma unroll
            for (int ks = 0; ks < 8; ++ks) acc = MFMA32(fw[ks], fs[ks], acc);
#pragma unroll
            for (int g4 = 0; g4 < 4; ++g4) { const u32x2 uu = uc[g4];
                const float v0 = bf2f(uu.x & 0xffffu) - acc[4 * g4], v1 = bf2f(uu.x >> 16) - acc[4 * g4 + 1], v2 = bf2f(uu.y & 0xffffu) - acc[4 * g4 + 2], v3 = bf2f(uu.y >> 16) - acc[4 * g4 + 3];
                u32x2 p; p.x = pk2(v0, v1); p.y = pk2(v2, v3);
                *(LAS u32x2*)(VNT + (32 * vt4 + (lane & 31)) * LDS_ + 32 * it4 + 8 * g4 + 4 * (lane >> 5)) = p; } }
        LBAR();
        { bf16x8 fk[4], fv0[4];
#pragma unroll
            for (int ks = 0; ks < 4; ++ks) { fk[ks] = frag_row(KDTl, LDS_, 32 * kt, 16 * ks, lane); fv0[ks] = frag_row(VNT, LDS_, 32 * vtl, 16 * ks, lane); }
            __builtin_amdgcn_sched_barrier(0);
            S0 = S0 * gt;
#pragma unroll
            for (int ks = 0; ks < 4; ++ks) S0 = MFMA32(fk[ks], fv0[ks], S0); }
        if (!isctx && wave >= 4) { f32x16 acc = Z16;
            { bf16x8 fq[8], fs[8];
#pragma unroll
                for (int ks = 0; ks < 8; ++ks) { fs[ks] = frag_row(ST, LD, 32 * vt4, 16 * ks, lane); fq[ks] = frag_row(QDl, LD, 32 * it4, 16 * ks, lane); }
                __builtin_amdgcn_sched_barrier(0);
#pragma unroll
                for (int ks = 0; ks < 8; ++ks) acc = MFMA32(fs[ks], fq[ks], acc); }
            { bf16x8 fvn[4], fqk[4];
#pragma unroll
                for (int ks = 0; ks < 4; ++ks) { fvn[ks] = frag_row(VNT, LDS_, 32 * vt4, 16 * ks, lane); fqk[ks] = frag_row(QKl, LDS_, 32 * it4, 16 * ks, lane); }
                __builtin_amdgcn_sched_barrier(0);
#pragma unroll
                for (int ks = 0; ks < 4; ++ks) acc = MFMA32(fvn[ks], fqk[ks], acc); }
            const int cs = s - 4, c = d ? 63 - cs : cs;
            bf16_t* op = O + (size_t)(b * SEQ + c * 64 + 32 * it4 + (lane & 31)) * GDW + h * HD + vb + 32 * vt4 + 4 * (lane >> 5);
#pragma unroll
            for (int g4 = 0; g4 < 4; ++g4) { u32x2 p; p.x = pk2(acc[4 * g4], acc[4 * g4 + 1]); p.y = pk2(acc[4 * g4 + 2], acc[4 * g4 + 3]); *(GAS u32x2*)(op + 8 * g4) = p; } }
        LBAR();
#pragma unroll
        for (int g4 = 0; g4 < 4; ++g4) { u32x2 p0; p0.x = pk2(S0[4 * g4], S0[4 * g4 + 1]); p0.y = pk2(S0[4 * g4 + 2], S0[4 * g4 + 3]);
            *(LAS u32x2*)(ST + (32 * vtl + (lane & 31)) * LD + 32 * kt + 8 * g4 + 4 * (lane >> 5)) = p0; }
    };
    ScanOps A, B;
    load_ops(A, 0); load_ops(B, 1);
#pragma unroll 1
    for (int s = 0; s < 68; s += 2) { step(A, s); step(B, s + 1); }
    LBAR();
}

struct Args { const float* in[19]; float* out; unsigned char* ws; int ph_lo, ph_hi; };
enum { I_X = 0, I_C, I_CTX, I_CCTX, I_WMOD, I_BMOD, I_N1G, I_N2G, I_WIN, I_CONVW, I_ALOG, I_DTB, I_GNW, I_WOUT, I_WROUTER, I_WGATE, I_WUP, I_WDOWN, I_NORMF };

struct XposeItem { const float* src; int ldn, ncols, k0, n0; bf16_t* dst; int dstK; int mode; };
__device__ __forceinline__ int xpose_row(const XposeItem& it, int n) { return it.mode == 0 ? n : (256 * (n >> 7) + 128 * (it.mode - 1) + (n & 127)); }
__device__ __forceinline__ void xpose_load(const XposeItem& it, f32x4 (&r)[8], int tid) {
    const int n = it.n0 + 4 * (tid & 63);
#pragma unroll
    for (int j = 0; j < 8; ++j) { const int k = it.k0 + (tid >> 6) + 8 * j;
        if (n + 3 < it.ncols) r[j] = __builtin_nontemporal_load((const GAS f32x4*)(it.src + (size_t)k * it.ldn + n));
        else { f32x4 v = {0.f, 0.f, 0.f, 0.f}; const float* p = it.src + (size_t)k * it.ldn; if (n < it.ncols) v.x = p[n]; if (n + 1 < it.ncols) v.y = p[n + 1]; if (n + 2 < it.ncols) v.z = p[n + 2]; r[j] = v; } }
}
__device__ __forceinline__ void xpose_store_lds(LAS float* T, const f32x4 (&r)[8], int tid) {
#pragma unroll
    for (int j = 0; j < 8; ++j) { const int kr = (tid >> 6) + 8 * j; *(LAS f32x4*)(T + kr * 260 + ((4 * (tid & 63)) ^ (4 * ((kr >> 3) & 7)))) = r[j]; }
}
__device__ __forceinline__ void xpose_emit(const XposeItem& it, const LAS float* T, int tid) {
    const int kc = tid & 7;
#pragma unroll
    for (int j = 0; j < 4; ++j) { const int nl = (tid >> 3) + 64 * j, n = it.n0 + nl;
        const LAS float* s = T + (8 * kc) * 260 + (nl ^ (4 * kc));
        u32x4 o; o.x = pk2(s[0], s[260]); o.y = pk2(s[2 * 260], s[3 * 260]); o.z = pk2(s[4 * 260], s[5 * 260]); o.w = pk2(s[6 * 260], s[7 * 260]);
        if (n < it.ncols) __builtin_nontemporal_store(o, (GAS u32x4*)(it.dst + (size_t)xpose_row(it, n) * it.dstK + it.k0 + 8 * kc)); }
}


__device__ __forceinline__ void moe_convert(LAS unsigned char* L, volatile LAS unsigned* MISC, unsigned* q, const float* wg, const float* wu, const float* wd, bf16_t* WGU, bf16_t* WDN, int maxpulls) {
    int tid_o_ = threadIdx.x; asm volatile("" : "+v"(tid_o_)); const int tid = tid_o_;
    __syncthreads();
    LAS float* T = (LAS float*)L;
    constexpr int NIT = 3 * 3072;
    auto mk = [&](int it) { XposeItem x; if (it < 6144) { const int up = it >= 3072, r0 = it - up * 3072, e = r0 / 192, r = r0 % 192; x.src = (up ? wu : wg) + (size_t)e * D_MODEL * FF; x.ldn = FF; x.ncols = FF; x.k0 = 64 * (r / 6); x.n0 = 256 * (r % 6);
            x.dst = WGU + (size_t)e * 2 * FF * D_MODEL; x.dstK = D_MODEL; x.mode = 1 + up; }
        else { const int r0 = it - 6144, e = r0 / 192, r = r0 % 192; x.src = wd + (size_t)e * FF * D_MODEL; x.ldn = D_MODEL; x.ncols = D_MODEL; x.k0 = 64 * (r / 8); x.n0 = 256 * (r % 8);
            x.dst = WDN + (size_t)e * D_MODEL * FF; x.dstK = FF; x.mode = 0; } return x; };
    f32x4 r[8];
    int pulls = 0;
    if (tid == 0) MISC[18] = maxpulls > 0 ? atomicAdd(q, 1u) : (unsigned)NIT;
    ++pulls;
    __syncthreads();
    int it = (int)MISC[18];
    if (it < NIT) { XposeItem x = mk(it); xpose_load(x, r, tid); }
    for (int qn = 0; it < NIT; ++qn) {
        XposeItem x = mk(it);
        xpose_store_lds(T, r, tid);
        if (tid == 0) MISC[19 + (qn & 1)] = pulls < maxpulls ? atomicAdd(q, 1u) : (unsigned)NIT;
        ++pulls;
        __syncthreads();
        const int nx = (int)MISC[19 + (qn & 1)];
        if (nx < NIT) { XposeItem y = mk(nx); xpose_load(y, r, tid); }
        xpose_emit(x, T, tid);
        __syncthreads();
        it = nx;
    }
}
struct SchedIn {
    const char* A; const char* Actx; const char* B; int G, c;
    __device__ __forceinline__ bool next(int i, pg8::Unit& u) const {
        const int L = i * G + c; constexpr int NX = 64 * 21, NC = 4 * 13;
        if (L >= NX + NC) return false;
        int pm, pn;
        if (L < NX) { int wgid = L; { const int q = NX / 8, xcd = wgid % 8, off = wgid / 8; wgid = xcd * q + off; }
            const int nig = 8 * 21, gid = wgid / nig, fm = gid * 8; pm = fm + ((wgid % nig) % 8); pn = (wgid % nig) / 8; }
        else { const int r = L - NX; pm = 64 + r / 13; const int j = r % 13; pn = j < 12 ? 4 + j : 20; }
        u.pm = pm; u.pn = pn; u.aux = 0; u.gidx = nullptr;
        u.a = pm < 64 ? A + (size_t)pm * 256 * D_MODEL * 2 : Actx + (size_t)(pm - 64) * 256 * D_MODEL * 2; u.b = B + (size_t)pn * 256 * D_MODEL * 2; return true;
    }
};

struct EpiIn {
    static constexpr bool PERM = true;
    bf16_t* pf; bf16_t* pqkv; bf16_t* pz; float* pab;
    __device__ __forceinline__ void operator()(const f32x4 (&acc)[2][2][4][2], const pg8::Unit& u, int wr, int wc, int fr, int fq) const {
        const int row0 = u.pm * 256 + wr * 64 + fr; const int pn = u.pn;
        if (pn == 20) {
            if (wc == 0) {
#pragma unroll
                for (int ai = 0; ai < 2; ++ai)
#pragma unroll
                    for (int m = 0; m < 4; ++m) { float* rp = pab + (size_t)(row0 + ai * 128 + m * 16) * 32 + 8 * fq;
                        *(GAS f32x4*)rp = acc[ai][0][m][0]; *(GAS f32x4*)(rp + 4) = acc[ai][0][m][1]; }
            }
            return;
        }
        bf16_t* base; int ld, c0;
        if (pn < 4) { base = pf; ld = FW; c0 = pn * 256; } else if (pn < 16) { base = pqkv; ld = 3 * GDW; c0 = (pn - 4) * 256; } else { base = pz; ld = GDW; c0 = (pn - 16) * 256; }
        const int col0 = c0 + wc * 32 + 8 * fq;
#pragma unroll
        for (int ai = 0; ai < 2; ++ai)
#pragma unroll
            for (int m = 0; m < 4; ++m) { bf16_t* rowp = base + (size_t)(row0 + ai * 128 + m * 16) * ld + col0;
#pragma unroll
                for (int bj = 0; bj < 2; ++bj) { const f32x4 v0 = acc[ai][bj][m][0], v1 = acc[ai][bj][m][1];
                    u32x4 w; w.x = pk2(v0[0], v0[1]); w.y = pk2(v0[2], v0[3]); w.z = pk2(v1[0], v1[1]); w.w = pk2(v1[2], v1[3]);
                    *(GAS u32x4*)(rowp + bj * 128) = w; } }
    }
};

struct SchedOut {
    const char* A; const char* B; int G, c;
    __device__ __forceinline__ bool next(int i, pg8::Unit& u) const {
        const int Lq = i * G + c; constexpr int NU = 64 * 8;
        if (Lq >= NU) return false;
        int wgid = Lq; { const int q = NU / 8, xcd = wgid % 8, off = wgid / 8; wgid = xcd * q + off; }
        const int nig = 8 * 8, gid = wgid / nig, fm = gid * 8; const int pm = fm + ((wgid % nig) % 8), pn = (wgid % nig) / 8;
        u.pm = pm; u.pn = pn; u.aux = 0; u.gidx = nullptr;
        u.a = A + (size_t)pm * 256 * D_MODEL * 2; u.b = B + (size_t)pn * 256 * D_MODEL * 2; return true;
    }
};

struct EpiOut {
    static constexpr bool PERM = true;
    const bf16_t* x; const float* mod; bf16_t* x2;
    __device__ __forceinline__ void operator()(const f32x4 (&acc)[2][2][4][2], const pg8::Unit& u, int wr, int wc, int fr, int fq) const {
        const int row0 = u.pm * 256 + wr * 64 + fr, col0 = u.pn * 256 + wc * 32 + 8 * fq;
        const float* gt = mod + (u.pm >> 4) * 12288 + 2 * 2048;
        f32x4 gv[2][2];
#pragma unroll
        for (int bj = 0; bj < 2; ++bj)
#pragma unroll
            for (int n = 0; n < 2; ++n) gv[bj][n] = *(const GAS f32x4*)(gt + col0 + bj * 128 + n * 4);
#pragma unroll
        for (int ai = 0; ai < 2; ++ai)
#pragma unroll
            for (int m = 0; m < 4; ++m) { const size_t off = (size_t)(row0 + ai * 128 + m * 16) * D_MODEL + col0;
#pragma unroll
                for (int bj = 0; bj < 2; ++bj) { const u32x4 xq = *(const GAS u32x4*)(x + off + bj * 128);
                    const f32x4 x0 = {bf2f(xq.x & 0xffffu), bf2f(xq.x >> 16), bf2f(xq.y & 0xffffu), bf2f(xq.y >> 16)}, x1 = {bf2f(xq.z & 0xffffu), bf2f(xq.z >> 16), bf2f(xq.w & 0xffffu), bf2f(xq.w >> 16)};
                    const f32x4 y0 = x0 + gv[bj][0] * acc[ai][bj][m][0], y1 = x1 + gv[bj][1] * acc[ai][bj][m][1];
                    u32x4 w; w.x = pk2(y0[0], y0[1]); w.y = pk2(y0[2], y0[3]); w.z = pk2(y1[0], y1[1]); w.w = pk2(y1[2], y1[3]);
                    *(GAS u32x4*)(x2 + off + bj * 128) = w; } }
    }
};


struct SchedGU {
    const char* HX2; const char* W; const int* IDX; int G, c;
    __device__ __forceinline__ bool next(int i, pg8::Unit& u) const {
        const int L = i * G + c; if (L >= 1536) return false;
        int wt, rt;
        if (G == 256) { const int xcd = c & 7, j = c >> 3; wt = (i * 8 + xcd) * 4 + (j >> 3); rt = j & 7; } else { wt = L >> 3; rt = L & 7; }
        const int e = wt / 12, pn = wt % 12, b = rt >> 1, mt = rt & 1;
        u.pm = (b * NE + e) * 2 + mt; u.pn = pn; u.aux = 0;
        u.a = HX2 + (size_t)b * SEQ * D_MODEL * 2; u.gidx = IDX + (b * NE + e) * CAP + mt * 256;
        u.b = W + ((size_t)e * 2 * FF + (size_t)pn * 256) * D_MODEL * 2; return true;
    }
};
struct EpiGU {
    static constexpr bool PERM = true;
    bf16_t* hid;
    __device__ __forceinline__ void operator()(const f32x4 (&acc)[2][2][4][2], const pg8::Unit& u, int wr, int wc, int fr, int fq) const {
        const int row0 = u.pm * 256 + wr * 64 + fr, col0 = u.pn * 128 + wc * 32 + 8 * fq;
#pragma unroll
        for (int ai = 0; ai < 2; ++ai)
#pragma unroll
            for (int m = 0; m < 4; ++m) { const f32x4 g0 = acc[ai][0][m][0], g1 = acc[ai][0][m][1], u0 = acc[ai][1][m][0], u1 = acc[ai][1][m][1];
                u32x4 w; w.x = pk2(silu_f(g0[0]) * u0[0], silu_f(g0[1]) * u0[1]); w.y = pk2(silu_f(g0[2]) * u0[2], silu_f(g0[3]) * u0[3]);
                w.z = pk2(silu_f(g1[0]) * u1[0], silu_f(g1[1]) * u1[1]); w.w = pk2(silu_f(g1[2]) * u1[2], silu_f(g1[3]) * u1[3]);
                *(GAS u32x4*)(hid + (size_t)(row0 + ai * 128 + m * 16) * FF + col0) = w; }
    }
};
struct SchedDN {
    const char* HID; const char* W; int G, c;
    __device__ __forceinline__ bool next(int i, pg8::Unit& u) const {
        const int L = i * G + c; if (L >= 1024) return false;
        int wt, rt;
        if (G == 256) { const int xcd = c & 7, j = c >> 3; wt = (i * 8 + xcd) * 4 + (j >> 3); rt = j & 7; } else { wt = L >> 3; rt = L & 7; }
        const int e = wt >> 3, pn = wt & 7, b = rt >> 1, mt = rt & 1;
        u.pm = (b * NE + e) * 2 + mt; u.pn = pn; u.aux = 0; u.gidx = nullptr;
        u.a = HID + (size_t)u.pm * 256 * FF * 2; u.b = W + ((size_t)e * D_MODEL + (size_t)pn * 256) * FF * 2; return true;
    }
};
struct EpiDN {
    static constexpr bool PERM = true;
    bf16_t* yb; const float* val;
    __device__ __forceinline__ void operator()(const f32x4 (&acc)[2][2][4][2], const pg8::Unit& u, int wr, int wc, int fr, int fq) const {
        const int row0 = u.pm * 256 + wr * 64 + fr, col0 = u.pn * 256 + wc * 32 + 8 * fq;
#pragma unroll
        for (int ai = 0; ai < 2; ++ai)
#pragma unroll
            for (int m = 0; m < 4; ++m) { const int row = row0 + ai * 128 + m * 16; const float vv = val[row]; bf16_t* rowp = yb + (size_t)row * D_MODEL + col0;
#pragma unroll
                for (int bj = 0; bj < 2; ++bj) { const f32x4 v0 = acc[ai][bj][m][0] * vv, v1 = acc[ai][bj][m][1] * vv;
                    u32x4 w; w.x = pk2(v0[0], v0[1]); w.y = pk2(v0[2], v0[3]); w.z = pk2(v1[0], v1[1]); w.w = pk2(v1[2], v1[3]);
                    *(GAS u32x4*)(rowp + bj * 128) = w; } }
    }
};

__device__ __forceinline__ unsigned block_excl_scan(unsigned v, LAS unsigned* scr, int tid, int lane, int wave, unsigned& total) {
    unsigned s = v;
#pragma unroll
    for (int o = 1; o < 64; o <<= 1) { const unsigned t = __shfl_up(s, o); if (lane >= o) s += t; }
    if (lane == 63) scr[wave] = s;
    __syncthreads();
    unsigned base = 0, tot = 0;
#pragma unroll
    for (int w = 0; w < NWAVES; ++w) { const unsigned x = scr[w]; if (w < wave) base += x; tot += x; }
    __syncthreads();
    total = tot; return base + s - v;
}
__device__ __forceinline__ void topk_unit(LAS unsigned char* L, int unit, const float* AFF, int* IDX, float* VAL, int* SLOT) {
    int tid_o_ = threadIdx.x; asm volatile("" : "+v"(tid_o_)); const int tid = tid_o_, lane = tid & 63, wave = __builtin_amdgcn_readfirstlane(tid >> 6);
    LAS unsigned* HIST = (LAS unsigned*)L; LAS unsigned* SH = HIST + 256; LAS unsigned* SCR = SH + 8;
    const int b = unit >> 4, e = unit & 15;
    unsigned key[8];
    { const u32x4 k0 = *(const GAS u32x4*)(AFF + (size_t)unit * SEQ + tid * 8), k1 = *(const GAS u32x4*)(AFF + (size_t)unit * SEQ + tid * 8 + 4);
        key[0] = k0.x; key[1] = k0.y; key[2] = k0.z; key[3] = k0.w; key[4] = k1.x; key[5] = k1.y; key[6] = k1.z; key[7] = k1.w; }
    unsigned prefix = 0;
#pragma unroll 1
    for (int bit = 31; bit >= 0; --bit) { const unsigned cand = prefix | (1u << bit); unsigned c = 0;
#pragma unroll
        for (int q = 0; q < 8; ++q) c += (unsigned)__popcll(__ballot(key[q] >= cand));
        if (lane == 0) HIST[(bit & 1) * 8 + wave] = c;
        __syncthreads();
        unsigned tot = 0;
#pragma unroll
        for (int w = 0; w < NWAVES; ++w) tot += HIST[(bit & 1) * 8 + w];
        if (tot >= (unsigned)CAP) prefix = cand; }
    unsigned gtc = 0;
#pragma unroll
    for (int q = 0; q < 8; ++q) gtc += (key[q] > prefix) ? 1u : 0u;
    unsigned gtot_; (void)block_excl_scan(gtc, SCR, tid, lane, wave, gtot_);
    const unsigned need = (unsigned)CAP - gtot_;
    const unsigned T = prefix;
    unsigned eq = 0;
#pragma unroll
    for (int q = 0; q < 8; ++q) eq += (key[q] == T) ? 1u : 0u;
    unsigned tot; unsigned eqbase = block_excl_scan(eq, SCR, tid, lane, wave, tot);
    unsigned selmask = 0, cnt = 0;
#pragma unroll
    for (int q = 0; q < 8; ++q) { bool sel = key[q] > T; if (key[q] == T) { sel = eqbase < need; ++eqbase; } if (sel) { selmask |= 1u << q; ++cnt; } }
    unsigned slot = block_excl_scan(cnt, SCR, tid, lane, wave, tot);
#pragma unroll
    for (int q = 0; q < 8; ++q) { const int t = tid * 8 + q; int sl = -1;
        if (selmask & (1u << q)) { sl = (int)slot; ++slot; if (sl < CAP) { IDX[unit * CAP + sl] = t; VAL[unit * CAP + sl] = __uint_as_float(key[q]); } else sl = -1; }
        SLOT[((size_t)b * SEQ + t) * NE + e] = sl; }
    __syncthreads();
}
__global__ void __launch_bounds__(NTHREADS, 2) fwd_kernel(Args args) {
    extern __shared__ __attribute__((aligned(16))) unsigned char lds_raw[];
    LAS unsigned char* L = (LAS unsigned char*)lds_raw;
    volatile LAS unsigned* MISC = (volatile LAS unsigned*)(L + MISC_OFF);
    LAS unsigned* TAB = (LAS unsigned*)(L + TAB_OFF);
    const int tid = threadIdx.x, lane = tid & 63, wave = __builtin_amdgcn_readfirstlane(tid >> 6);
    const int G = gridDim.x, bid = blockIdx.x;
    if (tid < 64) MISC[tid] = 0u;
    __syncthreads();
    unsigned char* ws = args.ws;
    unsigned* ctl = (unsigned*)(ws + WS_CTL);
    XcdBarrier bar = xcd_barrier_post(ctl + CW_BAR, MISC + 8);
    const int gw = bid * NWAVES + wave, NGW = G * NWAVES;
    const int lo = args.ph_lo, hi = args.ph_hi;
#define IN(k) (lo <= (k) && (k) < hi)
#ifndef REPMASK
#define REPMASK 0
#endif
#define PH(k) for (int rp_ = 0; rp_ <= ((REPMASK >> (k)) & 1); ++rp_) if (IN(k))
#define RPB do { if (rp_) xcd_barrier(bar); } while (0)
#define OPQ_IDS int tid_o_ = threadIdx.x; asm volatile("" : "+v"(tid_o_)); const int tid = tid_o_, lane = tid & 63; (void)tid; (void)lane
#ifndef REPSUB
#define REPSUB 0
#endif
#define RS(k) for (int rs_ = 0; rs_ <= ((REPSUB >> (k)) & 1); ++rs_)
#ifdef TPROBE_A
    unsigned long long* TSB = (unsigned long long*)(ws + WS_CTL + 512 * 1024);
#define STAMP(k) do { if (bid == 0 && tid == 0) TSB[k] = __builtin_amdgcn_s_memrealtime(); } while (0)
#else
#define STAMP(k) do { } while (0)
#endif
#define SEAM(k) do { if (IN(k) && IN((k) + 1)) xcd_barrier(bar); STAMP((k) + 1); } while (0)
    STAMP(0);

    float* MOD = (float*)(ws + WS_MOD);
    float* TW = (float*)(ws + WS_TW);
    bf16_t* DA = (bf16_t*)(ws + WS_DA); bf16_t* DB = (bf16_t*)(ws + WS_DB); bf16_t* DC = (bf16_t*)(ws + WS_DC);
    bf16_t* WIN = (bf16_t*)(ws + WS_WIN); bf16_t* WOUT = (bf16_t*)(ws + WS_WOUT);
    bf16_t* PF = (bf16_t*)(ws + WS_PF); bf16_t* PQKV = (bf16_t*)(ws + WS_PQKV); bf16_t* PZ = (bf16_t*)(ws + WS_PZ); float* PAB = (float*)(ws + WS_PAB);
    bf16_t* A2 = (bf16_t*)(ws + WS_A2);
    bf16_t* OF = (bf16_t*)(ws + WS_A2 + (size_t)MTOK * D_MODEL * 2); bf16_t* OB = OF + (size_t)MTOK * GDW;
    bf16_t* HX = (bf16_t*)args.out;
    bf16_t* XB = (bf16_t*)args.out + (size_t)MTOK * D_MODEL;
    bf16_t* YB = (bf16_t*)args.out;
    bf16_t* X2B = (bf16_t*)(ws + WS_A2 + (size_t)MTOK * D_MODEL * 2);

    PH(0) { RPB; OPQ_IDS;
        if (bid < 192) {
            LAS float* SC = (LAS float*)L;
            LAS float* RED = (LAS float*)(L + 5 * 2048 * 4);
            for (int i = tid; i < 5 * 2048; i += NTHREADS) { const int r = i >> 11, k = i & 2047; const float v = r < 4 ? args.in[I_C][r * 2048 + k] : args.in[I_CCTX][k]; SC[i] = silu_f(v); }
            __syncthreads();
            for (int s = bid; s < 192; s += G) {
                const int cg = lane & 15, ksub = lane >> 4;
                const float* wp = args.in[I_WMOD] + (size_t)(wave * 256 + ksub) * 12288 + s * 64 + cg * 4;
                f32x4 a0 = {0.f, 0.f, 0.f, 0.f}, a1 = a0, a2 = a0, a3 = a0, a4 = a0;
                for (int k = 0; k < 256; k += 32) {
                    f32x4 wv[8];
#pragma unroll
                    for (int j = 0; j < 8; ++j) wv[j] = __builtin_nontemporal_load((const GAS f32x4*)(wp + (size_t)(k + 4 * j) * 12288));
#pragma unroll
                    for (int j = 0; j < 8; ++j) { const int kk = wave * 256 + k + 4 * j + ksub;
                        a0 += wv[j] * SC[kk]; a1 += wv[j] * SC[2048 + kk]; a2 += wv[j] * SC[4096 + kk]; a3 += wv[j] * SC[6144 + kk]; a4 += wv[j] * SC[8192 + kk]; }
                }
                LAS float* rp = RED + ((wave * 4 + ksub) * 5) * 64 + cg * 4;
                *(LAS f32x4*)(rp) = a0; *(LAS f32x4*)(rp + 64) = a1; *(LAS f32x4*)(rp + 128) = a2; *(LAS f32x4*)(rp + 192) = a3; *(LAS f32x4*)(rp + 256) = a4;
                __syncthreads();
                if (tid < 320) { const int r = tid >> 6, c = tid & 63; float v = 0.f;
#pragma unroll
                    for (int w = 0; w < 32; ++w) v += RED[(w * 5 + r) * 64 + c];
                    MOD[r * 12288 + s * 64 + c] = v + args.in[I_BMOD][s * 64 + c]; }
                __syncthreads();
            }
        }
        if (bid == G - 1) {
            for (int i = tid; i < 4096; i += NTHREADS) { float s, c; sincosf(6.283185307179586f * (float)i / 4096.f, &s, &c); TW[2 * i] = c; TW[2 * i + 1] = s; }
            for (int i = tid; i < 128 * 64; i += NTHREADS) { const int r = i >> 6, n1 = i & 63, a = r & 63; const int m = (a * n1) & 63; float s, c; sincosf(6.283185307179586f * (float)m / 64.f, &s, &c);
                DA[i] = (bf16_t)f2bf(r < 64 ? c : -s); }
        }
        if (bid == G - 2) {
            for (int i = tid; i < 128 * 128; i += NTHREADS) { const int r = i >> 7, rho = i & 127, k2 = r & 63, n2 = rho >> 1, ri = rho & 1; const int m = (k2 * n2) & 63; float s, c; sincosf(6.283185307179586f * (float)m / 64.f, &s, &c);
                const float v = r < 64 ? (ri == 0 ? c : s) : (ri == 0 ? -s : c); DB[i] = (bf16_t)f2bf(v); }
        }
        if (bid == G - 3) {
            const float scale = 0.0013810679320049757f;
            for (int i = tid; i < 128 * 256; i += NTHREADS) { const int cp = i >> 8, kap = i & 255, ri = kap >> 7, c = kap & 127; const int m = (c * cp) & 127; float s, co; sincosf(6.283185307179586f * (float)m / 128.f, &s, &co);
                DC[i] = (bf16_t)f2bf((ri == 0 ? co : s) * scale); }
        }
        for (size_t i = (size_t)bid * NTHREADS + tid; i < (size_t)(INC_PAD - INC) * D_MODEL / 8; i += (size_t)G * NTHREADS) *(GAS u32x4*)(WIN + (size_t)INC * D_MODEL + i * 8) = (u32x4){0u, 0u, 0u, 0u};
        {
            __syncthreads();
            LAS float* T = (LAS float*)L;
            constexpr int N_IN = 32 * 21, N_OUT = 32 * 8, NIT = N_IN + N_OUT;
            auto mk = [&](int it) { XposeItem x; if (it < N_IN) { x.src = args.in[I_WIN]; x.ldn = INC; x.ncols = INC; x.k0 = 64 * (it / 21); x.n0 = 256 * (it % 21); x.dst = WIN; x.dstK = D_MODEL; x.mode = 0; }
                else { const int r = it - N_IN; x.src = args.in[I_WOUT]; x.ldn = D_MODEL; x.ncols = D_MODEL; x.k0 = 64 * (r / 8); x.n0 = 256 * (r % 8); x.dst = WOUT; x.dstK = D_MODEL; x.mode = 0; } return x; };
            f32x4 r[8];
            if (tid == 0) MISC[18] = atomicAdd(ctl + CW_Q0, 1u);
            __syncthreads();
            int it = (int)MISC[18];
            if (it < NIT) { XposeItem x = mk(it); xpose_load(x, r, tid); }
            for (int qn = 0; it < NIT; ++qn) {
                XposeItem x = mk(it);
                xpose_store_lds(T, r, tid);
                if (tid == 0) MISC[19 + (qn & 1)] = atomicAdd(ctl + CW_Q0, 1u);
                __syncthreads();
                const int nx = (int)MISC[19 + (qn & 1)];
                if (nx < NIT) { XposeItem y = mk(nx); xpose_load(y, r, tid); }
                xpose_emit(x, T, tid);
                __syncthreads();
                it = nx;
            }
        }
    }
    SEAM(0);

    PH(1) { RPB; OPQ_IDS;
        const float* g1 = args.in[I_N1G];
        f32x4 ca[8], cb[8]; int curmr = -1;
        const int PW = (MTOK / 2 + NGW - 1) / NGW;
        for (int k = 0; k < PW; ++k) {
            const int p = gw + k * NGW;
            if (p >= MTOK / 2) continue;
            const int m0 = 2 * p; const int mr = m0 < MTOK ? (m0 >> 12) : 4;
            if (mr != curmr) { curmr = mr; const float* sh = MOD + mr * 12288; const float* sc = sh + 2048;
#pragma unroll
                for (int j = 0; j < 8; ++j) { const f32x4 gg = *((const GAS f32x4*)g1 + lane + 64 * j), s1 = *((const GAS f32x4*)sc + lane + 64 * j); ca[j] = gg * (s1 + 1.f); cb[j] = *((const GAS f32x4*)sh + lane + 64 * j); } }
            const float* src = m0 < MTOK ? args.in[I_X] + (size_t)m0 * D_MODEL : args.in[I_CTX] + (size_t)(m0 - MTOK) * D_MODEL;
            f32x4 v0[8], v1[8]; float s0 = 0.f, s1_ = 0.f;
#pragma unroll
            for (int j = 0; j < 8; ++j) { v0[j] = __builtin_nontemporal_load((const GAS f32x4*)src + lane + 64 * j); v1[j] = __builtin_nontemporal_load((const GAS f32x4*)(src + D_MODEL) + lane + 64 * j); }
#pragma unroll
            for (int j = 0; j < 8; ++j) { s0 += (v0[j].x * v0[j].x + v0[j].y * v0[j].y) + (v0[j].z * v0[j].z + v0[j].w * v0[j].w); s1_ += (v1[j].x * v1[j].x + v1[j].y * v1[j].y) + (v1[j].z * v1[j].z + v1[j].w * v1[j].w); }
#pragma unroll
            for (int o = 1; o < 64; o <<= 1) { s0 += __shfl_xor(s0, o); s1_ += __shfl_xor(s1_, o); }
            const float r0 = __builtin_amdgcn_rsqf(s0 * (1.f / D_MODEL) + EPS), r1 = __builtin_amdgcn_rsqf(s1_ * (1.f / D_MODEL) + EPS);
            GAS u32x2* o0 = (GAS u32x2*)(HX + (size_t)m0 * D_MODEL) + lane; GAS u32x2* o1 = o0 + D_MODEL / 4;
            GAS u32x2* x0 = (GAS u32x2*)(XB + (size_t)m0 * D_MODEL) + lane; GAS u32x2* x1 = x0 + D_MODEL / 4;
#pragma unroll
            for (int j = 0; j < 8; ++j) { const f32x4 y0 = v0[j] * r0 * ca[j] + cb[j], y1 = v1[j] * r1 * ca[j] + cb[j];
                u32x2 w; w.x = pk2(y0.x, y0.y); w.y = pk2(y0.z, y0.w); o0[64 * j] = w; w.x = pk2(y1.x, y1.y); w.y = pk2(y1.z, y1.w); o1[64 * j] = w;
                w.x = pk2(v0[j].x, v0[j].y); w.y = pk2(v0[j].z, v0[j].w); x0[64 * j] = w; w.x = pk2(v1[j].x, v1[j].y); w.y = pk2(v1[j].z, v1[j].w); x1[64 * j] = w; }
        }
        for (int r = gw >> 1; (gw & 1) == 0 && r < MCTX; r += NGW / 2) {
            const float* sh = MOD + 4 * 12288; const float* sc = sh + 2048; const float* src = args.in[I_CTX] + (size_t)r * D_MODEL;
            f32x4 v0[8]; float s0 = 0.f;
#pragma unroll
            for (int j = 0; j < 8; ++j) { v0[j] = *((const GAS f32x4*)src + lane + 64 * j); s0 += (v0[j].x * v0[j].x + v0[j].y * v0[j].y) + (v0[j].z * v0[j].z + v0[j].w * v0[j].w); }
            const float r0 = __builtin_amdgcn_rsqf(wave_sum(s0) * (1.f / D_MODEL) + EPS);
            GAS u32x2* o0 = (GAS u32x2*)((bf16_t*)(ws + WS_HXC) + (size_t)r * D_MODEL) + lane;
#pragma unroll
            for (int j = 0; j < 8; ++j) { const f32x4 gg = *((const GAS f32x4*)g1 + lane + 64 * j), s1 = *((const GAS f32x4*)sc + lane + 64 * j), h1 = *((const GAS f32x4*)sh + lane + 64 * j);
                const f32x4 y0 = v0[j] * r0 * gg * (s1 + 1.f) + h1; u32x2 w; w.x = pk2(y0.x, y0.y); w.y = pk2(y0.z, y0.w); o0[64 * j] = w; }
        }
    }
    SEAM(1);

    PH(2) { RPB; OPQ_IDS;
        SchedIn S{(const char*)HX, (const char*)(ws + WS_HXC), (const char*)WIN, G, bid};
        EpiIn E{PF, PQKV, PZ, PAB};
        pg8::gemm_phase<EpiIn, SchedIn, false>(L, TAB, D_MODEL, S, E);
        { constexpr int NU = 64 * 21 + 4 * 13; const int mine = (NU - bid + G - 1) / G, most = (NU + G - 1) / G;
            if (mine < most) moe_convert(L, MISC, ctl + CW_Q2, args.in[I_WGATE], args.in[I_WUP], args.in[I_WDOWN], (bf16_t*)(ws + WS_WGU), (bf16_t*)(ws + WS_WDN), 11 * (most - mine)); }
    }
    SEAM(2);

    PH(3) { RPB; OPQ_IDS;
        RS(0) gdn_chunk_items(L, bid, G, PQKV, PAB, args.in[I_CONVW], args.in[I_ALOG], args.in[I_DTB], ws + WS_G, ctl + CW_Q2, args.in[I_WGATE], args.in[I_WUP], args.in[I_WDOWN], (bf16_t*)(ws + WS_WGU), (bf16_t*)(ws + WS_WDN));
        __syncthreads();
        constexpr int LDF = 136, LDA_ = 72, LDO = 136;
        LAS bf16_t* DAl = (LAS bf16_t*)L;
        LAS bf16_t* Fi = (LAS bf16_t*)(L + 128 * LDA_ * 2);
        LAS bf16_t* Oi = (LAS bf16_t*)(L + 128 * LDA_ * 2 + 64 * LDF * 2);
        for (int i = tid; i < 128 * 64; i += NTHREADS) DAl[(i >> 6) * LDA_ + (i & 63)] = DA[i];
        LBAR();
        RS(1) for (int it = bid; it < BATCH * 64 * 8; it += G) {
            const int g = it & 7, n2 = (it >> 3) & 63, b = it >> 9;
#pragma unroll
            for (int j = 0; j < 2; ++j) { const int idx = tid + 512 * j, row = idx >> 4, ch = idx & 15;
                const u32x4 v = *(const GAS u32x4*)(PF + (size_t)(b * SEQ + 64 * row + n2) * FW + g * 128 + ch * 8);
                *(LAS u32x4*)(Fi + row * LDF + ch * 8) = v; }
            LBAR();
            const int ct = wave & 3, kt = wave >> 2;
            f32x16 are = Z16, aim = Z16;
            { bf16x8 fb_[4], fr_[4], fi_[4];
#pragma unroll
                for (int ks = 0; ks < 4; ++ks) { fb_[ks] = frag_tr(Fi, LDF, 32 * ct, 16 * ks, lane); fr_[ks] = frag_row(DAl, LDA_, 32 * kt, 16 * ks, lane); fi_[ks] = frag_row(DAl, LDA_, 64 + 32 * kt, 16 * ks, lane); }
                __builtin_amdgcn_sched_barrier(0);
#pragma unroll
                for (int ks = 0; ks < 4; ++ks) { are = MFMA32(fr_[ks], fb_[ks], are); aim = MFMA32(fi_[ks], fb_[ks], aim); } }
#pragma unroll
            for (int r = 0; r < 16; ++r) { const int k1 = 32 * kt + crow(r, lane); const int m = (n2 * k1) & 4095; const float c = TW[2 * m], s = TW[2 * m + 1];
                const float re = are[r] * c + aim[r] * s, im = aim[r] * c - are[r] * s;
                Oi[k1 * LDO + 32 * ct + (lane & 31)] = (bf16_t)f2bf(re); Oi[(64 + k1) * LDO + 32 * ct + (lane & 31)] = (bf16_t)f2bf(im); }
            LBAR();
#pragma unroll
            for (int j = 0; j < 4; ++j) { const int idx = tid + 512 * j, row = idx >> 4, ch = idx & 15, ri = row >> 6, k1 = row & 63;
                const u32x4 v = *(const LAS u32x4*)(Oi + row * LDO + ch * 8);
                *(GAS u32x4*)(YB + ((size_t)((b * 64 + k1) * 64 + n2) * 2 + ri) * FW + g * 128 + ch * 8) = v; }
        }
    }
    if (IN(3)) { constexpr int NI = BATCH * NH * 64 + BATCH * NH * 4; const int mine = (NI - bid + G - 1) / G, most = (NI + G - 1) / G;
        if (mine < most) moe_convert(L, MISC, ctl + CW_Q2, args.in[I_WGATE], args.in[I_WUP], args.in[I_WDOWN], (bf16_t*)(ws + WS_WGU), (bf16_t*)(ws + WS_WDN), 4 * (most - mine)); }
    SEAM(3);

    PH(4) { RPB; OPQ_IDS;
    if (bid < 128) {
        RS(2) for (int su = bid; su < 128; su += G) gdn_scan_half(L, (su & 7) + 8 * (su >> 4), (su >> 3) & 1, ws + WS_G, OF, OB);
    }
    if (bid >= 128 || G <= 128) {
        constexpr int LDB_ = 136, LDT = 136, LDZ = 264, LDO2 = 136;
        LAS bf16_t* DBl = (LAS bf16_t*)L;
        LAS bf16_t* DCl = (LAS bf16_t*)(L + 34816);
        LAS bf16_t* W0 = (LAS bf16_t*)(L + 34816 + 65536);
        for (int i = tid; i < 128 * 128; i += NTHREADS) DBl[(i >> 7) * LDB_ + (i & 127)] = DB[i];
        for (int i = tid; i < 128 * 32; i += NTHREADS) { const int row = i >> 5, ch = i & 31; *(LAS u32x4*)(DCl + row * 256 + ((ch ^ (row & 15)) * 8)) = *(const GAS u32x4*)(DC + row * 256 + ch * 8); }
        LBAR();
        constexpr int NFI = BATCH * 64 * 8;
        u32x4 pre[4];
        auto fetch = [&](int it_) { const int g_ = it_ & 7, k1_ = (it_ >> 3) & 63, b_ = it_ >> 9;
#pragma unroll
            for (int j = 0; j < 4; ++j) { const int idx = tid + 512 * j, row = idx >> 4, ch = idx & 15;
                pre[j] = *(const GAS u32x4*)(YB + ((size_t)(b_ * 64 + k1_) * 128 + row) * FW + g_ * 128 + ch * 8); } };
        if (tid == 0) { MISC[16] = atomicAdd(ctl + CW_Q1, 1u); MISC[17] = atomicAdd(ctl + CW_Q1, 1u); }
        LBAR();
        int it = (int)MISC[16], itn = (int)MISC[17];
        if (it < NFI) fetch(it);
        for (int qn = 0; it < NFI; ++qn) {
            const int g = it & 7, k1 = (it >> 3) & 63, b = it >> 9;
#pragma unroll
            for (int j = 0; j < 4; ++j) { const int idx = tid + 512 * j, row = idx >> 4, ch = idx & 15; *(LAS u32x4*)(W0 + row * LDT + ch * 8) = pre[j]; }
            if (tid == 0) MISC[22 + (qn & 1)] = atomicAdd(ctl + CW_Q1, 1u);
            LBAR();
            if (itn < NFI) fetch(itn);
            const int itnn = (int)MISC[22 + (qn & 1)];
            const int ct = wave & 3, kt = wave >> 2;
            f32x16 zre = Z16, zim = Z16;
#pragma unroll
            for (int kh = 0; kh < 2; ++kh) { bf16x8 fb_[4], fr_[4], fi_[4];
#pragma unroll
                for (int k4 = 0; k4 < 4; ++k4) { const int ks = 4 * kh + k4; fb_[k4] = frag_tr(W0, LDT, 32 * ct, 16 * ks, lane); fr_[k4] = frag_row(DBl, LDB_, 32 * kt, 16 * ks, lane); fi_[k4] = frag_row(DBl, LDB_, 64 + 32 * kt, 16 * ks, lane); }
                __builtin_amdgcn_sched_barrier(0);
#pragma unroll
                for (int k4 = 0; k4 < 4; ++k4) { zre = MFMA32(fr_[k4], fb_[k4], zre); zim = MFMA32(fi_[k4], fb_[k4], zim); }
                __builtin_amdgcn_sched_barrier(0); }
            LBAR();
#pragma unroll
            for (int r = 0; r < 16; ++r) { const int k2 = 32 * kt + crow(r, lane); const int c = 32 * ct + (lane & 31);
                W0[k2 * LDZ + c] = (bf16_t)f2bf(zre[r]); W0[k2 * LDZ + 128 + c] = (bf16_t)f2bf(zim[r]); }
            LBAR();
            f32x16 yo = Z16;
            { const int mt = wave >> 2, nt2 = wave & 3; const int rowc = 32 * nt2 + (lane & 31);
#pragma unroll
                for (int kq = 0; kq < 2; ++kq) { bf16x8 fa_[8], fb_[8];
#pragma unroll
                    for (int k8 = 0; k8 < 8; ++k8) { const int ks = 8 * kq + k8, chunk = 2 * ks + (lane >> 5);
                        fb_[k8] = *(const LAS bf16x8*)(DCl + rowc * 256 + ((chunk ^ (rowc & 15)) * 8)); fa_[k8] = frag_row(W0, LDZ, 32 * mt, 16 * ks, lane); }
                    __builtin_amdgcn_sched_barrier(0);
#pragma unroll
                    for (int k8 = 0; k8 < 8; ++k8) yo = MFMA32(fa_[k8], fb_[k8], yo);
                    __builtin_amdgcn_sched_barrier(0); } }
            LBAR();
            { const int mt = wave >> 2, nt2 = wave & 3;
#pragma unroll
                for (int r = 0; r < 16; ++r) W0[(32 * mt + crow(r, lane)) * LDO2 + 32 * nt2 + (lane & 31)] = (bf16_t)f2bf(yo[r]); }
            LBAR();
#pragma unroll
            for (int j = 0; j < 2; ++j) { const int idx = tid + 512 * j, k2 = idx >> 4, ch = idx & 15;
                *(GAS u32x4*)(A2 + (size_t)(b * SEQ + k1 + 64 * k2) * D_MODEL + g * 128 + ch * 8) = *(const LAS u32x4*)(W0 + k2 * LDO2 + ch * 8); }
            LBAR();
            it = itn; itn = itnn;
        }
    }
    moe_convert(L, MISC, ctl + CW_Q2, args.in[I_WGATE], args.in[I_WUP], args.in[I_WDOWN], (bf16_t*)(ws + WS_WGU), (bf16_t*)(ws + WS_WDN), 1 << 30);
    }
    SEAM(4);

    PH(5) { RPB; OPQ_IDS;
        const float* gnw = args.in[I_GNW];
        f32x4 gn0 = *(const GAS f32x4*)(gnw + ((lane * 8) & 127)), gn1 = *(const GAS f32x4*)(gnw + ((lane * 8) & 127) + 4);
        auto ld2 = [&](u32x4 (&a)[2][2], u32x4 (&bq)[2][2], u32x4 (&zz)[2][2], int m) {
#pragma unroll
            for (int t = 0; t < 2; ++t)
#pragma unroll
                for (int half = 0; half < 2; ++half) { const size_t off = (size_t)(m + t) * GDW + half * 512 + lane * 8;
                    a[t][half] = *(const GAS u32x4*)(OF + off); bq[t][half] = *(const GAS u32x4*)(OB + off); zz[t][half] = *(const GAS u32x4*)(PZ + off); } };
        auto do2 = [&](const u32x4 (&a)[2][2], const u32x4 (&bq)[2][2], const u32x4 (&zz)[2][2], int m) {
#pragma unroll
            for (int t = 0; t < 2; ++t)
#pragma unroll
                for (int half = 0; half < 2; ++half) {
                    const unsigned aw[4] = {a[t][half].x, a[t][half].y, a[t][half].z, a[t][half].w}, bw[4] = {bq[t][half].x, bq[t][half].y, bq[t][half].z, bq[t][half].w}, zw[4] = {zz[t][half].x, zz[t][half].y, zz[t][half].z, zz[t][half].w};
                    float o[8]; float ss = 0.f;
#pragma unroll
                    for (int q = 0; q < 4; ++q) { o[2 * q] = bf2f(aw[q] & 0xffffu) + bf2f(bw[q] & 0xffffu); o[2 * q + 1] = bf2f(aw[q] >> 16) + bf2f(bw[q] >> 16); ss += o[2 * q] * o[2 * q] + o[2 * q + 1] * o[2 * q + 1]; }
                    ss += dpp_xor1(ss); ss += dpp_xor2(ss); ss += __shfl_xor(ss, 4); ss += __shfl_xor(ss, 8);
                    const float rstd = __builtin_amdgcn_rsqf(ss * (1.f / HD) + EPS);
                    const float gp[8] = {gn0.x, gn0.y, gn0.z, gn0.w, gn1.x, gn1.y, gn1.z, gn1.w};
                    float y[8];
#pragma unroll
                    for (int q = 0; q < 4; ++q) { const float z0 = bf2f(zw[q] & 0xffffu), z1 = bf2f(zw[q] >> 16); y[2 * q] = o[2 * q] * rstd * gp[2 * q] * silu_f(z0); y[2 * q + 1] = o[2 * q + 1] * rstd * gp[2 * q + 1] * silu_f(z1); }
                    u32x4 w; w.x = pk2(y[0], y[1]); w.y = pk2(y[2], y[3]); w.z = pk2(y[4], y[5]); w.w = pk2(y[6], y[7]);
                    *(GAS u32x4*)(A2 + (size_t)(m + t) * D_MODEL + 1024 + half * 512 + lane * 8) = w; } };
        { u32x4 a0[2][2], b0[2][2], z0[2][2], a1[2][2], b1[2][2], z1[2][2];
            const int st = 2 * NGW; int m = 2 * gw;
            if (m < MTOK) ld2(a0, b0, z0, m);
            for (; m < MTOK; m += 2 * st) {
                if (m + st < MTOK) ld2(a1, b1, z1, m + st);
                do2(a0, b0, z0, m);
                if (m + 2 * st < MTOK) ld2(a0, b0, z0, m + 2 * st);
                if (m + st < MTOK) do2(a1, b1, z1, m + st);
            }
        }
    }
    SEAM(5);

    PH(6) { RPB; OPQ_IDS;
        SchedOut S{(const char*)A2, (const char*)WOUT, G, bid};
        EpiOut E{XB, MOD, X2B};
        pg8::gemm_phase<EpiOut, SchedOut, false>(L, TAB, D_MODEL, S, E);
    }
    SEAM(6);

    PH(7) { RPB; OPQ_IDS;
        LAS float* WR = (LAS float*)L;
        for (int i = tid; i < D_MODEL * NE; i += NTHREADS) { const int e = i & 15, k = i >> 4; WR[e * 2048 + ((k >> 2) & 1) * 1024 + (k >> 3) * 4 + (k & 3)] = args.in[I_WROUTER][i]; }
        __syncthreads();
        const float* g2 = args.in[I_N2G];
        bf16_t* HX2 = (bf16_t*)(ws + WS_HX2); float* AFF = (float*)(ws + WS_AFF);
        u32x4 pq0[4], pq1[4];
        if (2 * gw < MTOK) {
#pragma unroll
            for (int jc = 0; jc < 4; ++jc) { pq0[jc] = *((const GAS u32x4*)(X2B + (size_t)(2 * gw) * D_MODEL) + lane + 64 * jc); pq1[jc] = *((const GAS u32x4*)(X2B + (size_t)(2 * gw + 1) * D_MODEL) + lane + 64 * jc); } }
        for (int m0 = 2 * gw; m0 < MTOK; m0 += 2 * NGW) {
            const int b = m0 >> 12;
            const float* sh = MOD + b * 12288 + 3 * 2048; const float* sc = sh + 2048;
            f32x4 v[2][8]; float s0 = 0.f, s1 = 0.f;
            u32x4 cq0[4], cq1[4];
#pragma unroll
            for (int jc = 0; jc < 4; ++jc) { cq0[jc] = pq0[jc]; cq1[jc] = pq1[jc]; }
            { const int mn = m0 + 2 * NGW; if (mn < MTOK) {
#pragma unroll
                for (int jc = 0; jc < 4; ++jc) { pq0[jc] = *((const GAS u32x4*)(X2B + (size_t)mn * D_MODEL) + lane + 64 * jc); pq1[jc] = *((const GAS u32x4*)(X2B + (size_t)(mn + 1) * D_MODEL) + lane + 64 * jc); } } }
#pragma unroll
            for (int jc = 0; jc < 4; ++jc) { const u32x4 q0 = cq0[jc], q1 = cq1[jc];
                v[0][2 * jc] = (f32x4){bf2f(q0.x & 0xffffu), bf2f(q0.x >> 16), bf2f(q0.y & 0xffffu), bf2f(q0.y >> 16)}; v[0][2 * jc + 1] = (f32x4){bf2f(q0.z & 0xffffu), bf2f(q0.z >> 16), bf2f(q0.w & 0xffffu), bf2f(q0.w >> 16)};
                v[1][2 * jc] = (f32x4){bf2f(q1.x & 0xffffu), bf2f(q1.x >> 16), bf2f(q1.y & 0xffffu), bf2f(q1.y >> 16)}; v[1][2 * jc + 1] = (f32x4){bf2f(q1.z & 0xffffu), bf2f(q1.z >> 16), bf2f(q1.w & 0xffffu), bf2f(q1.w >> 16)}; }
#pragma unroll
            for (int j = 0; j < 8; ++j) { s0 += (v[0][j].x * v[0][j].x + v[0][j].y * v[0][j].y) + (v[0][j].z * v[0][j].z + v[0][j].w * v[0][j].w); s1 += (v[1][j].x * v[1][j].x + v[1][j].y * v[1][j].y) + (v[1][j].z * v[1][j].z + v[1][j].w * v[1][j].w); }
#pragma unroll
            for (int o = 1; o < 64; o <<= 1) { s0 += __shfl_xor(s0, o); s1 += __shfl_xor(s1, o); }
            const float r0 = __builtin_amdgcn_rsqf(s0 * (1.f / D_MODEL) + EPS), r1 = __builtin_amdgcn_rsqf(s1 * (1.f / D_MODEL) + EPS);
#pragma unroll
            for (int jc = 0; jc < 4; ++jc) { const int c0 = 8 * (lane + 64 * jc); u32x4 w0, w1;
#pragma unroll
                for (int hh = 0; hh < 2; ++hh) { const f32x4 gg = *(const GAS f32x4*)(g2 + c0 + 4 * hh), sc1 = *(const GAS f32x4*)(sc + c0 + 4 * hh) + 1.f, h1 = *(const GAS f32x4*)(sh + c0 + 4 * hh);
                    const f32x4 y0 = v[0][2 * jc + hh] * r0 * gg * sc1 + h1, y1 = v[1][2 * jc + hh] * r1 * gg * sc1 + h1; v[0][2 * jc + hh] = y0; v[1][2 * jc + hh] = y1;
                    if (hh == 0) { w0.x = pk2(y0.x, y0.y); w0.y = pk2(y0.z, y0.w); w1.x = pk2(y1.x, y1.y); w1.y = pk2(y1.z, y1.w); } else { w0.z = pk2(y0.x, y0.y); w0.w = pk2(y0.z, y0.w); w1.z = pk2(y1.x, y1.y); w1.w = pk2(y1.z, y1.w); } }
                *((GAS u32x4*)(HX2 + (size_t)m0 * D_MODEL) + lane + 64 * jc) = w0; *((GAS u32x4*)(HX2 + (size_t)(m0 + 1) * D_MODEL) + lane + 64 * jc) = w1; }
            float a0[16], a1[16];
#pragma unroll
            for (int eg = 0; eg < 4; ++eg) {
#pragma unroll
                for (int q = 0; q < 4; ++q) { const int e = 4 * eg + q; float c0 = 0.f, c1 = 0.f;
#pragma unroll
                    for (int j = 0; j < 8; ++j) { const f32x4 w4 = *(const LAS f32x4*)(WR + e * 2048 + (j & 1) * 1024 + 4 * (lane + 64 * (j >> 1)));
                        c0 += (v[0][j].x * w4.x + v[0][j].y * w4.y) + (v[0][j].z * w4.z + v[0][j].w * w4.w); c1 += (v[1][j].x * w4.x + v[1][j].y * w4.y) + (v[1][j].z * w4.z + v[1][j].w * w4.w); }
                    a0[e] = c0; a1[e] = c1; }
                asm volatile("" ::: "memory"); }
#pragma unroll
            for (int st = 0; st < 4; ++st) { const int msk = 1 << st, n2 = 8 >> st; const bool up = (lane & msk) != 0;
#pragma unroll
                for (int q = 0; q < 8; ++q) if (q < n2) { const float k0 = up ? a0[q + n2] : a0[q], d0 = up ? a0[q] : a0[q + n2], k1 = up ? a1[q + n2] : a1[q], d1 = up ? a1[q] : a1[q + n2];
                    a0[q] = k0 + __shfl_xor(d0, msk); a1[q] = k1 + __shfl_xor(d1, msk); } }
            float l0 = a0[0], l1 = a1[0]; l0 += __shfl_xor(l0, 16); l1 += __shfl_xor(l1, 16); l0 += __shfl_xor(l0, 32); l1 += __shfl_xor(l1, 32);
            float mx0 = l0, mx1 = l1;
#pragma unroll
            for (int o = 1; o < 16; o <<= 1) { mx0 = fmaxf(mx0, __shfl_xor(mx0, o)); mx1 = fmaxf(mx1, __shfl_xor(mx1, o)); }
            const float e0 = expf(l0 - mx0), e1 = expf(l1 - mx1); float dn0 = e0, dn1 = e1;
#pragma unroll
            for (int o = 1; o < 16; o <<= 1) { dn0 += __shfl_xor(dn0, o); dn1 += __shfl_xor(dn1, o); }
            const int eidx = ((lane & 1) << 3) | ((lane & 2) << 1) | ((lane & 4) >> 1) | ((lane & 8) >> 3);
            if (lane < 16) { float* ap = AFF + ((size_t)b * NE + eidx) * SEQ + (m0 & 4095); f32x2 pr = {e0 / dn0, e1 / dn1}; *(GAS f32x2*)ap = pr; }
        }
    }
    SEAM(7);

    PH(8) { RPB; OPQ_IDS;
        for (int u = bid; u < BATCH * NE; u += G) topk_unit(L, u, (const float*)(ws + WS_AFF), (int*)(ws + WS_IDX), (float*)(ws + WS_VAL), (int*)(ws + WS_SLOT));
    }
    SEAM(8);

    PH(9) { RPB; OPQ_IDS;
        SchedGU S{(const char*)(ws + WS_HX2), (const char*)(ws + WS_WGU), (const int*)(ws + WS_IDX), G, bid};
        EpiGU E{(bf16_t*)(ws + WS_HID)};
        pg8::gemm_phase<EpiGU, SchedGU, true>(L, TAB, D_MODEL, S, E);
    }
    SEAM(9);

    PH(10) { RPB; OPQ_IDS;
        SchedDN S{(const char*)(ws + WS_HID), (const char*)(ws + WS_WDN), G, bid};
        EpiDN E{(bf16_t*)(ws + WS_YB), (const float*)(ws + WS_VAL)};
        pg8::gemm_phase<EpiDN, SchedDN, false>(L, TAB, FF, S, E);
    }
    SEAM(10);

    PH(11) { RPB; OPQ_IDS;
        const float* nf = args.in[I_NORMF]; const bf16_t* YB = (const bf16_t*)(ws + WS_YB); const int* SLOT = (const int*)(ws + WS_SLOT);
        f32x4 cg[8], cn[8]; int curb = -1;
        const int RW = (MTOK + NGW - 1) / NGW;
        for (int k = 0; k < RW; ++k) {
            const int m = gw + k * NGW; if (m >= MTOK) break;
            const int b = m >> 12;
            if (b != curb) { curb = b; const float* gt = MOD + b * 12288 + 5 * 2048;
#pragma unroll
                for (int jc = 0; jc < 4; ++jc) { const int c0 = 8 * (lane + 64 * jc); cg[2 * jc] = *(const GAS f32x4*)(gt + c0); cg[2 * jc + 1] = *(const GAS f32x4*)(gt + c0 + 4); cn[2 * jc] = *(const GAS f32x4*)(nf + c0); cn[2 * jc + 1] = *(const GAS f32x4*)(nf + c0 + 4); } }
            f32x4 v[8], y[8];
            u32x4 xq[4];
#pragma unroll
            for (int jc = 0; jc < 4; ++jc) xq[jc] = *((const GAS u32x4*)(X2B + (size_t)m * D_MODEL) + lane + 64 * jc);
            const int myslot = SLOT[(size_t)m * NE + (lane & 15)];
#pragma unroll
            for (int j = 0; j < 8; ++j) y[j] = (f32x4){0.f, 0.f, 0.f, 0.f};
            unsigned emask = (unsigned)(__ballot(myslot >= 0) & 0xffffull);
#pragma unroll 1
            while (emask) {
                int es[4], sl[4];
#pragma unroll
                for (int q = 0; q < 4; ++q) { if (emask) { es[q] = __builtin_ctz(emask); emask &= emask - 1; sl[q] = __builtin_amdgcn_readlane(myslot, es[q]); } else { es[q] = 0; sl[q] = -1; } }
                u32x4 w[4][4];
#pragma unroll
                for (int q = 0; q < 4; ++q) if (sl[q] >= 0) { const GAS u32x4* yr = (const GAS u32x4*)(YB + ((size_t)(b * NE + es[q]) * CAP + sl[q]) * D_MODEL) + lane;
#pragma unroll
                    for (int jc = 0; jc < 4; ++jc) w[q][jc] = yr[64 * jc]; }
#pragma unroll
                for (int q = 0; q < 4; ++q) if (sl[q] >= 0) {
#pragma unroll
                    for (int jc = 0; jc < 4; ++jc) { y[2 * jc].x += bf2f(w[q][jc].x & 0xffffu); y[2 * jc].y += bf2f(w[q][jc].x >> 16); y[2 * jc].z += bf2f(w[q][jc].y & 0xffffu); y[2 * jc].w += bf2f(w[q][jc].y >> 16);
                        y[2 * jc + 1].x += bf2f(w[q][jc].z & 0xffffu); y[2 * jc + 1].y += bf2f(w[q][jc].z >> 16); y[2 * jc + 1].z += bf2f(w[q][jc].w & 0xffffu); y[2 * jc + 1].w += bf2f(w[q][jc].w >> 16); } }
            }
            float s = 0.f;
#pragma unroll
            for (int jc = 0; jc < 4; ++jc) { v[2 * jc] = (f32x4){bf2f(xq[jc].x & 0xffffu), bf2f(xq[jc].x >> 16), bf2f(xq[jc].y & 0xffffu), bf2f(xq[jc].y >> 16)}; v[2 * jc + 1] = (f32x4){bf2f(xq[jc].z & 0xffffu), bf2f(xq[jc].z >> 16), bf2f(xq[jc].w & 0xffffu), bf2f(xq[jc].w >> 16)}; }
#pragma unroll
            for (int j = 0; j < 8; ++j) { v[j] = v[j] + cg[j] * y[j]; s += (v[j].x * v[j].x + v[j].y * v[j].y) + (v[j].z * v[j].z + v[j].w * v[j].w); }
            const float rstd = __builtin_amdgcn_rsqf(wave_sum(s) * (1.f / D_MODEL) + EPS);
            float* orow = args.out + (size_t)m * D_MODEL;
#pragma unroll
            for (int jc = 0; jc < 4; ++jc) { const int c0 = 8 * (lane + 64 * jc); __builtin_nontemporal_store(v[2 * jc] * rstd * cn[2 * jc], (GAS f32x4*)(orow + c0)); __builtin_nontemporal_store(v[2 * jc + 1] * rstd * cn[2 * jc + 1], (GAS f32x4*)(orow + c0 + 4)); }
        }
    }
#ifdef TPROBE_A
    __syncthreads();
    if (bid == 0 && tid == 0) { asm volatile("s_waitcnt vmcnt(0)" ::: "memory"); const unsigned long long te = __builtin_amdgcn_s_memrealtime(); TSB[12] = te;
        const float ta = (float)(TSB[TPROBE_A + 1] - TSB[TPROBE_A]) * 0.1f, tb = (float)(TSB[TPROBE_B + 1] - TSB[TPROBE_B]) * 0.1f;
        args.out[0] = ta; for (int i = 1; i <= 100; ++i) args.out[i] = tb; }
#endif
#undef IN
#undef SEAM
}

constexpr int NPHASES = 12;

extern "C" void kernel_launch(void* const* d_in, const int* in_sizes, int n_in, void* d_out, int out_size, void* d_ws, size_t ws_size, hipStream_t stream) {
    static int grid = 0;
    if (grid == 0) {
        if (n_in != 19 || out_size != MTOK * D_MODEL || ws_size < WS_END) { fprintf(stderr, "kernel_launch: unexpected shapes (n_in %d out %d ws %zu)\n", n_in, out_size, ws_size); grid = -1; return; }
        int dev = 0, cus = 0, per_cu = 0;
        if (hipGetDevice(&dev) != hipSuccess || hipDeviceGetAttribute(&cus, hipDeviceAttributeMultiprocessorCount, dev) != hipSuccess) { grid = -1; return; }
        if (hipFuncSetAttribute((const void*)fwd_kernel, hipFuncAttributeMaxDynamicSharedMemorySize, LDS_BYTES) != hipSuccess) { grid = -1; return; }
        if (hipOccupancyMaxActiveBlocksPerMultiprocessor(&per_cu, (const void*)fwd_kernel, NTHREADS, LDS_BYTES) != hipSuccess || per_cu < 1) { fprintf(stderr, "occupancy query: %d\n", per_cu); grid = -1; return; }
        grid = cus;
    }
    if (grid < 0) return;
    if (hipMemsetAsync((char*)d_ws + WS_CTL, 0, CTL_ZERO_BYTES, stream) != hipSuccess) return;
    Args a{};
    for (int i = 0; i < 19; ++i) a.in[i] = (const float*)d_in[i];
    a.out = (float*)d_out; a.ws = (unsigned char*)d_ws; a.ph_lo = 0; a.ph_hi = NPHASES;
    hipLaunchKernelGGL(fwd_kernel, dim3(grid), dim3(NTHREADS), LDS_BYTES, stream, a);
}
```
